# Optimizing an MI355X kernel written in HIP

```python
import jax, jax.numpy as jnp
from jax import lax
import numpy as np

D_MODEL = 2048
BATCH = 4
SEQ = 4096
DEPTH = 1

MIX_WIDTH = D_MODEL
HEAD_DIM = 64
NSA_WIDTH = MIX_WIDTH // 2
NSA_HEADS = NSA_WIDTH // HEAD_DIM
NSA_KV_HEADS = 4
NSA_GROUP = NSA_HEADS // NSA_KV_HEADS
NSA_KV_WIDTH = NSA_KV_HEADS * HEAD_DIM
CMP_BLOCK = 32
CMP_STRIDE = 16
SEL_BLOCK = 64
N_SELECT = 16
WINDOW = 512
N_GATES = 3
Q_BLOCK = 64
RWKV_WIDTH = MIX_WIDTH - NSA_WIDTH
RWKV_HEADS = RWKV_WIDTH // HEAD_DIM
DECAY_LORA = 96
ICLR_LORA = 96
GATE_LORA = 256
GN_EPS = 64e-5
N_EXPERTS = 32
TOP_K = 4
D_EXPERT = D_MODEL
SWIGLU_ALPHA = 1.702
SWIGLU_LIMIT = 7.0
MOE_BLOCK = 256
PLE_DIM = 256
LN_EPS = 1e-5
DEEPNORM_ALPHA = (2 * DEPTH) ** 0.25
DEEPNORM_BETA = (8 * DEPTH) ** -0.25
NEG_INF = -1e30

NSA_COLS = NSA_WIDTH + 6 * NSA_KV_WIDTH + NSA_HEADS * N_GATES
RWKV_COLS = 3 * RWKV_WIDTH + DECAY_LORA + ICLR_LORA + GATE_LORA
IN_COLS = NSA_COLS + RWKV_COLS
NSA_SPLIT = tuple(NSA_WIDTH + j * NSA_KV_WIDTH for j in range(7))
RWKV_SPLIT = (RWKV_WIDTH, 2 * RWKV_WIDTH, 3 * RWKV_WIDTH, 3 * RWKV_WIDTH + DECAY_LORA, 3 * RWKV_WIDTH + DECAY_LORA + ICLR_LORA)

kernel_name = "hymba_nsa_rwkv7_moe_deepnorm"


def layer_norm(x, g, b):
    xf = x.astype(jnp.float32)
    mean = xf.mean(-1, keepdims=True)
    var = jnp.square(xf - mean).mean(-1, keepdims=True)
    return ((xf - mean) * lax.rsqrt(var + LN_EPS) * g + b).astype(x.dtype)


def masked_softmax(s, mask):
    s = jnp.where(mask, s, NEG_INF)
    e = jnp.where(mask, jnp.exp(s - jnp.max(s, axis=-1, keepdims=True)), 0.0)
    return e / jnp.maximum(e.sum(-1, keepdims=True), 1e-30)


def alibi_slopes(n):
    return jnp.exp2(-8.0 * jnp.arange(1, n + 1, dtype=jnp.float32) / n)


def compress_kv(kv, pe, w1, w2):
    b, t_len, g, d = kv.shape
    ratio = CMP_BLOCK // CMP_STRIDE
    n_chunks = t_len // CMP_STRIDE
    n_cmp = n_chunks - ratio + 1
    chunks = kv.reshape(b, n_chunks, CMP_STRIDE, g, d)
    blocks = jnp.concatenate([chunks[:, r:r + n_cmp] for r in range(ratio)], axis=2)
    blocks = (blocks + pe[:, None, :]).transpose(0, 1, 3, 2, 4).reshape(b, n_cmp, g, CMP_BLOCK * d)
    return jax.nn.gelu(blocks @ w1) @ w2


def nsa_attention(q, k_cmp, v_cmp, k_slc, v_slc, k_win, v_win, gate_logits):
    b, t_len = q.shape[:2]
    n_cmp = k_cmp.shape[1]
    n_slc = t_len // SEL_BLOCK
    n_sel = min(N_SELECT, n_slc)
    scale = HEAD_DIM ** -0.5
    slopes = alibi_slopes(NSA_HEADS).reshape(NSA_KV_HEADS, NSA_GROUP)[:, :, None, None]
    cmp_end = jnp.arange(n_cmp) * CMP_STRIDE + CMP_BLOCK - 1
    cmp_start = cmp_end - CMP_BLOCK + 1
    slc_start = jnp.arange(n_slc) * SEL_BLOCK
    overlap = jnp.clip(jnp.minimum(cmp_end[:, None], slc_start[None, :] + SEL_BLOCK - 1)
                       - jnp.maximum(cmp_start[:, None], slc_start[None, :]) + 1, 0).astype(jnp.float32)

    def to_blocks(a):
        return a.reshape(b, n_slc, SEL_BLOCK, NSA_KV_HEADS, HEAD_DIM).transpose(0, 3, 1, 2, 4).reshape(
            b, NSA_KV_HEADS, n_slc, SEL_BLOCK * HEAD_DIM)

    k_sb, v_sb = to_blocks(k_slc), to_blocks(v_slc)
    pad = ((0, 0), (WINDOW, 0), (0, 0), (0, 0))
    k_wp, v_wp = jnp.pad(k_win, pad), jnp.pad(v_win, pad)
    b_idx = jnp.arange(b)[:, None, None, None]
    g_idx = jnp.arange(NSA_KV_HEADS)[None, :, None, None]
    blk = jnp.arange(n_slc)
    sel_off = jnp.arange(SEL_BLOCK)
    win_off = jnp.arange(WINDOW + Q_BLOCK) - WINDOW

    def attend(s, mask, dist, v, spec):
        s = s.astype(jnp.float32) * scale - slopes * dist
        probs = masked_softmax(s, mask)
        return probs, jnp.einsum(spec, probs.astype(v.dtype), v)

    def block(qi):
        q0 = qi * Q_BLOCK
        tq = q0 + jnp.arange(Q_BLOCK)
        qb = lax.dynamic_slice_in_dim(q, q0, Q_BLOCK, axis=1)
        qb = qb.reshape(b, Q_BLOCK, NSA_KV_HEADS, NSA_GROUP, HEAD_DIM).transpose(0, 2, 3, 1, 4)
        gb = jax.nn.sigmoid(lax.dynamic_slice_in_dim(gate_logits, q0, Q_BLOCK, axis=1).astype(jnp.float32))
        gb = gb.reshape(b, Q_BLOCK, NSA_KV_HEADS, NSA_GROUP, N_GATES).transpose(0, 2, 3, 1, 4)
        d_cmp = tq[:, None] - cmp_end[None, :]
        p_cmp, o_cmp = attend(jnp.einsum('bgrqd,bcgd->bgrqc', qb, k_cmp), d_cmp >= 0, d_cmp, v_cmp,
                              'bgrqc,bcgd->bgrqd')
        imp = jnp.einsum('bgrqc,cj->bgqj', p_cmp, overlap)
        cur = (tq // SEL_BLOCK)[:, None]
        forced = (blk == 0) | (blk == cur) | (blk == cur - 1)
        imp = jnp.where(forced, jnp.inf, jnp.where(blk > cur, -jnp.inf, imp))
        sel = lax.top_k(imp, n_sel)[1]
        k_g = k_sb[b_idx, g_idx, sel].reshape(b, NSA_KV_HEADS, Q_BLOCK, n_sel * SEL_BLOCK, HEAD_DIM)
        v_g = v_sb[b_idx, g_idx, sel].reshape(b, NSA_KV_HEADS, Q_BLOCK, n_sel * SEL_BLOCK, HEAD_DIM)
        pos = (sel[..., None] * SEL_BLOCK + sel_off).reshape(b, NSA_KV_HEADS, Q_BLOCK, n_sel * SEL_BLOCK)
        d_slc = (tq[:, None] - pos)[:, :, None]
        _, o_slc = attend(jnp.einsum('bgrqd,bgqkd->bgrqk', qb, k_g), d_slc >= 0, d_slc, v_g,
                          'bgrqk,bgqkd->bgrqd')
        kw = lax.dynamic_slice_in_dim(k_wp, q0, WINDOW + Q_BLOCK, axis=1)
        vw = lax.dynamic_slice_in_dim(v_wp, q0, WINDOW + Q_BLOCK, axis=1)
        kpos = q0 + win_off
        d_win = tq[:, None] - kpos[None, :]
        m_win = (d_win >= 0) & (d_win < WINDOW) & (kpos >= 0)[None, :]
        _, o_win = attend(jnp.einsum('bgrqd,bkgd->bgrqk', qb, kw), m_win, d_win, vw, 'bgrqk,bkgd->bgrqd')
        o = gb[..., 0:1] * o_cmp + gb[..., 1:2] * o_slc + gb[..., 2:3] * o_win
        return o.transpose(0, 3, 1, 2, 4).reshape(b, Q_BLOCK, NSA_WIDTH).astype(q.dtype)

    out = lax.map(block, jnp.arange(t_len // Q_BLOCK))
    return out.transpose(1, 0, 2, 3).reshape(b, t_len, NSA_WIDTH)


def rwkv_step(state, inp):
    r, w, k, v, a_vec, b_vec = inp
    state = (state * w[:, :, None, :]
             + jnp.einsum('bhvk,bhk->bhv', state, a_vec)[..., None] * b_vec[:, :, None, :]
             + v[..., None] * k[:, :, None, :])
    return state, jnp.einsum('bhvk,bhk->bhv', state, r)


def rwkv7_time_mix(z, mu, w0, w_up, a0, a_up, g_up, k_k, k_a, r_k, ln_g, ln_b):
    b, t_len, _ = z.shape
    f32 = jnp.float32
    z = z + (jnp.pad(z, ((0, 0), (1, 0), (0, 0)))[:, :-1] - z) * mu
    r, k, v, w_lo, a_lo, g_lo = jnp.split(z, RWKV_SPLIT, axis=-1)
    heads = lambda u: u.astype(f32).reshape(b, t_len, RWKV_HEADS, HEAD_DIM)
    w_raw = -jax.nn.softplus(-(w0 + jnp.tanh(w_lo) @ w_up).astype(f32)) - 0.5
    decay = jnp.exp(-jnp.exp(w_raw))
    a = jax.nn.sigmoid((a0 + a_lo @ a_up).astype(f32))
    g = jax.nn.sigmoid(g_lo) @ g_up
    kk = heads(k * k_k)
    kk = kk / jnp.maximum(jnp.linalg.norm(kk, axis=-1, keepdims=True), 1e-12)
    k = k.astype(f32) * (1.0 + (a - 1.0) * k_a)
    r_h, w_h, k_h, v_h, a_h = heads(r), heads(decay), heads(k), heads(v), heads(a)
    seq_major = lambda u: jnp.swapaxes(u, 0, 1)
    state0 = jnp.zeros((b, RWKV_HEADS, HEAD_DIM, HEAD_DIM), f32)
    _, y = lax.scan(rwkv_step, state0, (seq_major(r_h), seq_major(w_h), seq_major(k_h), seq_major(v_h),
                                         seq_major(-kk), seq_major(kk * a_h)))
    y = jnp.swapaxes(y, 0, 1)
    mean = y.mean(-1, keepdims=True)
    var = jnp.square(y - mean).mean(-1, keepdims=True)
    y = ((y - mean) * lax.rsqrt(var + GN_EPS)).reshape(b, t_len, RWKV_WIDTH) * ln_g + ln_b
    bonus = (jnp.sum(r_h * k_h * r_k, axis=-1, keepdims=True) * v_h).reshape(b, t_len, RWKV_WIDTH)
    return ((y + bonus) * g).astype(z.dtype)


def clamped_swiglu(gate, up):
    gate = jnp.minimum(gate, SWIGLU_LIMIT)
    up = jnp.clip(up, -SWIGLU_LIMIT, SWIGLU_LIMIT)
    return gate * jax.nn.sigmoid(SWIGLU_ALPHA * gate) * (up + 1.0)


def moe_ffn(x, router_w, router_b, w_gate, b_gate, w_up, b_up, w_down, b_down):
    b, t_len, d = x.shape
    xt = x.reshape(-1, d)
    n_tok = xt.shape[0]
    logits = (xt @ router_w + router_b).astype(jnp.float32)
    top_logit, top_idx = lax.top_k(logits, TOP_K)
    top_w = jax.nn.softmax(top_logit, axis=-1)
    n_assign = n_tok * TOP_K
    flat_e = top_idx.reshape(-1)
    order = jnp.argsort(flat_e)
    sorted_e = flat_e[order]
    sorted_tok = order // TOP_K
    sorted_w = top_w.reshape(-1)[order]
    counts = jnp.bincount(flat_e, length=N_EXPERTS)
    padded = (counts + MOE_BLOCK - 1) // MOE_BLOCK * MOE_BLOCK
    start_sorted = jnp.cumsum(counts) - counts
    end_padded = jnp.cumsum(padded)
    start_padded = end_padded - padded
    dest = start_padded[sorted_e] + jnp.arange(n_assign) - start_sorted[sorted_e]
    n_blocks = -(-(n_assign + N_EXPERTS * (MOE_BLOCK - 1)) // MOE_BLOCK)
    n_rows = n_blocks * MOE_BLOCK
    row_tok = jnp.zeros((n_rows,), jnp.int32).at[dest].set(sorted_tok)
    row_w = jnp.zeros((n_rows,), jnp.float32).at[dest].set(sorted_w)
    block_e = jnp.minimum(jnp.searchsorted(end_padded, jnp.arange(n_blocks) * MOE_BLOCK, side='right'),
                          N_EXPERTS - 1)

    def expert_block(args):
        tok, e = args
        xb = xt[tok]
        h = clamped_swiglu(xb @ w_gate[e] + b_gate[e], xb @ w_up[e] + b_up[e])
        return h @ w_down[e] + b_down[e]

    out = lax.map(expert_block, (row_tok.reshape(n_blocks, MOE_BLOCK), block_e))
    y = jnp.zeros((n_tok, d), jnp.float32).at[row_tok].add(out.reshape(n_rows, d).astype(jnp.float32) * row_w[:, None])
    return y.astype(x.dtype).reshape(b, t_len, d)


def setup_inputs(seed: int = 0) -> dict:
    key = jax.random.key(seed)
    keys = iter(jax.random.split(key, 48))
    f32 = jnp.float32
    nrm = lambda shape, s: jax.random.normal(next(keys), shape, f32) * s
    L, D, F, E = DEPTH, D_MODEL, D_EXPERT, N_EXPERTS
    kin = CMP_BLOCK * HEAD_DIM
    return {
        "x": nrm((BATCH, SEQ, D), 1.0),
        "p": nrm((L, BATCH, SEQ, PLE_DIM), 1.0),
        "w_in": nrm((L, D, IN_COLS), D ** -0.5),
        "cmp_pe_k": nrm((L, CMP_BLOCK, HEAD_DIM), 0.5),
        "cmp_w1_k": nrm((L, kin, HEAD_DIM), kin ** -0.5),
        "cmp_w2_k": nrm((L, HEAD_DIM, HEAD_DIM), HEAD_DIM ** -0.5),
        "cmp_pe_v": nrm((L, CMP_BLOCK, HEAD_DIM), 0.5),
        "cmp_w1_v": nrm((L, kin, HEAD_DIM), kin ** -0.5),
        "cmp_w2_v": nrm((L, HEAD_DIM, HEAD_DIM), HEAD_DIM ** -0.5),
        "rwkv_mu": jax.random.uniform(next(keys), (L, RWKV_COLS), f32),
        "rwkv_w0": -1.0 + nrm((L, RWKV_WIDTH), 0.5),
        "rwkv_w_up": nrm((L, DECAY_LORA, RWKV_WIDTH), 0.5 * DECAY_LORA ** -0.5),
        "rwkv_a0": nrm((L, RWKV_WIDTH), 0.5),
        "rwkv_a_up": nrm((L, ICLR_LORA, RWKV_WIDTH), 0.5 * ICLR_LORA ** -0.5),
        "rwkv_g_up": nrm((L, GATE_LORA, RWKV_WIDTH), GATE_LORA ** -0.5),
        "rwkv_k_k": 0.85 + nrm((L, RWKV_WIDTH), 0.05),
        "rwkv_k_a": 1.0 + nrm((L, RWKV_WIDTH), 0.05),
        "rwkv_r_k": nrm((L, RWKV_HEADS, HEAD_DIM), 0.1),
        "rwkv_ln_g": 1.0 + nrm((L, RWKV_WIDTH), 0.05),
        "rwkv_ln_b": nrm((L, RWKV_WIDTH), 0.01),
        "w_out": nrm((L, MIX_WIDTH, D), MIX_WIDTH ** -0.5 * DEEPNORM_BETA),
        "ln1_g": 1.0 + nrm((L, D), 0.05),
        "ln1_b": nrm((L, D), 0.01),
        "router_w": nrm((L, D, E), D ** -0.5),
        "router_b": nrm((L, E), 0.01),
        "exp_w_gate": nrm((L, E, D, F), D ** -0.5),
        "exp_b_gate": nrm((L, E, F), 0.01),
        "exp_w_up": nrm((L, E, D, F), D ** -0.5),
        "exp_b_up": nrm((L, E, F), 0.01),
        "exp_w_down": nrm((L, E, F, D), F ** -0.5 * DEEPNORM_BETA),
        "exp_b_down": nrm((L, E, D), 0.01),
        "ln2_g": 1.0 + nrm((L, D), 0.05),
        "ln2_b": nrm((L, D), 0.01),
        "ple_w": nrm((L, PLE_DIM, D), PLE_DIM ** -0.5),
        "ple_gate_w": nrm((L, D, D), D ** -0.5),
    }


def reference(x, p, w_in, cmp_pe_k, cmp_w1_k, cmp_w2_k, cmp_pe_v, cmp_w1_v, cmp_w2_v,
              rwkv_mu, rwkv_w0, rwkv_w_up, rwkv_a0, rwkv_a_up, rwkv_g_up, rwkv_k_k, rwkv_k_a, rwkv_r_k,
              rwkv_ln_g, rwkv_ln_b, w_out, ln1_g, ln1_b, router_w, router_b,
              exp_w_gate, exp_b_gate, exp_w_up, exp_b_up, exp_w_down, exp_b_down,
              ln2_g, ln2_b, ple_w, ple_gate_w):
    b, t_len, _ = x.shape
    kv_heads = lambda u: u.reshape(b, t_len, NSA_KV_HEADS, HEAD_DIM)
    h = x
    for i in range(DEPTH):
        z = h @ w_in[i]
        z_nsa, z_rwkv = z[..., :NSA_COLS], z[..., NSA_COLS:]
        q, kc, vc, ks, vs, kw, vw, gl = jnp.split(z_nsa, NSA_SPLIT, axis=-1)
        k_cmp = compress_kv(kv_heads(kc), cmp_pe_k[i], cmp_w1_k[i], cmp_w2_k[i])
        v_cmp = compress_kv(kv_heads(vc), cmp_pe_v[i], cmp_w1_v[i], cmp_w2_v[i])
        o_nsa = nsa_attention(q.reshape(b, t_len, NSA_HEADS, HEAD_DIM), k_cmp, v_cmp,
                              kv_heads(ks), kv_heads(vs), kv_heads(kw), kv_heads(vw),
                              gl.reshape(b, t_len, NSA_HEADS, N_GATES))
        o_rwkv = rwkv7_time_mix(z_rwkv, rwkv_mu[i], rwkv_w0[i], rwkv_w_up[i], rwkv_a0[i], rwkv_a_up[i],
                                rwkv_g_up[i], rwkv_k_k[i], rwkv_k_a[i], rwkv_r_k[i], rwkv_ln_g[i], rwkv_ln_b[i])
        mix = jnp.concatenate([o_nsa, o_rwkv], axis=-1) @ w_out[i]
        h = layer_norm(DEEPNORM_ALPHA * h + mix, ln1_g[i], ln1_b[i])
        ffn = moe_ffn(h, router_w[i], router_b[i], exp_w_gate[i], exp_b_gate[i], exp_w_up[i], exp_b_up[i],
                      exp_w_down[i], exp_b_down[i])
        h = layer_norm(DEEPNORM_ALPHA * h + ffn, ln2_g[i], ln2_b[i])
        h = h + jax.nn.sigmoid(h @ ple_gate_w[i]) * (p[i] @ ple_w[i])
    return h
```

```cpp
#include <hip/hip_runtime.h>
#include <cstdio>
#include <cstdint>

#ifndef MK_LAUNCH_PER_PHASE
#define MK_LAUNCH_PER_PHASE 1
#endif

#define GAS __attribute__((address_space(1)))
#define LAS __attribute__((address_space(3)))
typedef unsigned short bf16;
typedef float f32x4 __attribute__((ext_vector_type(4)));
typedef unsigned u32x4 __attribute__((ext_vector_type(4)));
typedef unsigned u32x2 __attribute__((ext_vector_type(2)));
#define LDS_WAIT() asm volatile("s_waitcnt lgkmcnt(0)" ::: "memory")

constexpr int NB = 4, T = 4096, D = 2048, M = NB * T;
constexpr int NZ = 6144;
constexpr int ZQ = 0, ZKC = 1024, ZVC = 1280, ZKS = 1536, ZVS = 1792, ZKW = 2048, ZVW = 2304, ZGL = 2560, ZRW = 2608;
constexpr int ZR = 2608, ZK = 3632, ZV = 4656, ZWL = 5680, ZAL = 5776, ZGLO = 5872, INC = 6128;
constexpr int NCMP = 255, NE = 32, MAXBLK = 288, MAXROWS = MAXBLK * 256;
constexpr float LN_EPS = 1e-5f, GN_EPS = 64e-5f, ALPHA = 1.189207115002721f;
constexpr int NPHASE = 14;

constexpr size_t MiB = 1u << 20;
constexpr size_t WS_CTL = 0, CTL_ZERO_BYTES = 1 * MiB;
constexpr size_t WS_HIST = 1 * MiB;
constexpr size_t WS_BLKE = 1 * MiB + 64 * 1024;
constexpr size_t WS_TOPE = 2 * MiB;
constexpr size_t WS_TOPW = WS_TOPE + 256 * 1024;
constexpr size_t WS_SLOT = WS_TOPW + 256 * 1024;
constexpr size_t WS_TOKROW = WS_SLOT + 256 * 1024;
constexpr size_t WS_ROWTOK = 3 * MiB;
constexpr size_t WS_WPL = 4 * MiB;
constexpr size_t WS_WUP = 5 * MiB;
constexpr size_t WS_AUP = WS_WUP + 512 * 1024;
constexpr size_t WS_GUP = 6 * MiB;
constexpr size_t WS_CW1K = 7 * MiB;
constexpr size_t WS_CW1V = 8 * MiB;
constexpr size_t WS_HCMPK = 9 * MiB;
constexpr size_t WS_HCMPV = 10 * MiB;
constexpr size_t WS_KCMP = 11 * MiB;
constexpr size_t WS_VCMP = 11 * MiB + 512 * 1024;
constexpr size_t WS_WIN = 12 * MiB;
constexpr size_t WS_WOUT = 36 * MiB;
constexpr size_t WS_WPG = 44 * MiB;
constexpr size_t WS_PB = 52 * MiB;
constexpr size_t WS_WGU = 60 * MiB;
constexpr size_t WS_WDN = 572 * MiB;
constexpr size_t WS_S = 828 * MiB;
constexpr size_t WS_XB = WS_S;
constexpr size_t WS_Z = WS_S + 64 * MiB;
constexpr size_t WS_ACK = WS_S + 256 * MiB;
constexpr size_t WS_ACV = WS_S + 272 * MiB;
constexpr size_t WS_WL = WS_S + 288 * MiB;
constexpr size_t WS_AL = WS_S + 296 * MiB;
constexpr size_t WS_GLS = WS_S + 304 * MiB;
constexpr size_t WS_DEC = WS_S + 312 * MiB;
constexpr size_t WS_ASIG = WS_S + 376 * MiB;
constexpr size_t WS_G = WS_S + 440 * MiB;
constexpr size_t WS_SC = WS_S + 504 * MiB;
constexpr size_t WS_Y = WS_S + 888 * MiB;
constexpr size_t WS_CAT = WS_S + 952 * MiB;
constexpr size_t WS_H1 = WS_S;
constexpr size_t WS_H1B = WS_S + 128 * MiB;
constexpr size_t WS_HACT = WS_S + 192 * MiB;
constexpr size_t WS_EO = WS_S + 480 * MiB;
constexpr size_t WS_H2B = WS_S + 768 * MiB;
constexpr size_t WS_PL = WS_S + 832 * MiB;
constexpr size_t WS_END = WS_S + 1016 * MiB;
constexpr int CW_BAR = 4096;

constexpr int LDS_BYTES = 147456;
constexpr int LDS_MISC = 131072 + 320;

__device__ __forceinline__ unsigned f2bf(float f) { unsigned u = __float_as_uint(f); return (u + 0x7fffu + ((u >> 16) & 1u)) >> 16; }
__device__ __forceinline__ unsigned pk2(float lo, float hi) { return f2bf(lo) | (f2bf(hi) << 16); }
__device__ __forceinline__ float bf2f(unsigned h) { return __uint_as_float(h << 16); }
__device__ __forceinline__ float bflo(unsigned w) { return __uint_as_float(w << 16); }
__device__ __forceinline__ float bfhi(unsigned w) { return __uint_as_float(w & 0xffff0000u); }
__device__ __forceinline__ float wave_sum(float v) {
#pragma unroll
    for (int o = 1; o < 64; o <<= 1) v += __shfl_xor(v, o);
    return v;
}
__device__ __forceinline__ float wave_max(float v) {
#pragma unroll
    for (int o = 1; o < 64; o <<= 1) v = fmaxf(v, __shfl_xor(v, o));
    return v;
}
__device__ __forceinline__ float sigmoidf_(float x) { return 1.0f / (1.0f + __expf(-x)); }
__device__ __forceinline__ float gelu_tanh(float x) { const float u = 0.7978845608028654f * (x + 0.044715f * x * x * x); return 0.5f * x * (1.0f + tanhf(u)); }

#define XB_TMO      128
#define XB_XCNT(j)  (256  + 64 * (j))
#define XB_XSUB(j)  (1280 + 64 * (j))
#define XB_XGEN(j)  (2304 + 64 * (j))
#define XB_TOP      3328
#define XB_TOPGEN   3392
#define XCD_BAR_WORDS 3456
#define XB_SPIN_CAP (1u << 22)
__device__ __forceinline__ unsigned xb_ld(unsigned* p)              { return __hip_atomic_load(p, __ATOMIC_RELAXED, __HIP_MEMORY_SCOPE_AGENT); }
__device__ __forceinline__ unsigned xb_add(unsigned* p, unsigned v) { return __hip_atomic_fetch_add(p, v, __ATOMIC_RELAXED, __HIP_MEMORY_SCOPE_AGENT); }
__device__ __forceinline__ unsigned xb_xcc_id() { return (unsigned)__builtin_amdgcn_s_getreg((3 << 11) | 20) & 0xFu; }
#define XB_SPIN(cond, bar) do { unsigned _sp = 0; while (cond) { __builtin_amdgcn_s_sleep(1); \
    if ((++_sp & 255u) == 0u) { if (xb_ld(&(bar)[XB_TMO])) break; if (_sp > XB_SPIN_CAP) { atomicAdd(&(bar)[XB_TMO], 1u); break; } } } } while (0)
struct XcdBarrier { unsigned* bar; unsigned x; volatile LAS unsigned* st; };
__device__ __forceinline__ XcdBarrier xcd_barrier_post(unsigned* bar, volatile LAS unsigned* st) {
    XcdBarrier b; b.bar = bar; b.x = xb_xcc_id(); b.st = st;
    if (threadIdx.x == 0) (void)xb_add(&bar[XB_XCNT(b.x)], 1u);
    return b;
}
__device__ __forceinline__ void xcd_barrier_complete(unsigned* bar, unsigned x, unsigned& nloc, unsigned& nx) {
    const unsigned G = gridDim.x * gridDim.y * gridDim.z;
    unsigned sum, cnt, mine, sp = 0u;
    for (;;) {
        sum = 0u; cnt = 0u; mine = 0u;
#pragma unroll
        for (unsigned j = 0; j < 16; ++j) { const unsigned c = xb_ld(&bar[XB_XCNT(j)]); sum += c; cnt += (c > 0u) ? 1u : 0u; mine = (j == x) ? c : mine; }
        if (sum == G) break;
        __builtin_amdgcn_s_sleep(1);
        if ((++sp & 255u) == 0u) { if (xb_ld(&bar[XB_TMO])) break; if (sp > XB_SPIN_CAP) { atomicAdd(&bar[XB_TMO], 1u); break; } }
    }
    nloc = mine > 0u ? mine : 1u; nx = cnt > 0u ? cnt : 1u;
}
__device__ __forceinline__ void xcd_barrier(const XcdBarrier& b) {
    asm volatile("s_waitcnt vmcnt(0)" ::: "memory");
    __syncthreads();
    if (threadIdx.x == 0) {
        unsigned* bar = b.bar;
        __builtin_amdgcn_s_waitcnt(0);
        unsigned nloc = b.st[0], nx = b.st[1];
        if (nloc == 0u) { xcd_barrier_complete(bar, b.x, nloc, nx); b.st[0] = nloc; b.st[1] = nx; }
        const unsigned old = xb_add(&bar[XB_XSUB(b.x)], 1u);
        const unsigned gen = old / nloc;
        if (old + 1u == (gen + 1u) * nloc) {
            __builtin_amdgcn_fence(__ATOMIC_RELEASE, "agent");
            asm volatile("s_waitcnt vmcnt(0)" ::: "memory");
            const unsigned og = xb_add(&bar[XB_TOP], 1u);
            const unsigned tg = og / nx;
            if (og + 1u == (tg + 1u) * nx) xb_add(&bar[XB_TOPGEN], 1u);
            else XB_SPIN(xb_ld(&bar[XB_TOPGEN]) == tg, bar);
            __builtin_amdgcn_fence(__ATOMIC_ACQUIRE, "agent");
            xb_add(&bar[XB_XGEN(b.x)], 1u);
            asm volatile("s_waitcnt vmcnt(0)" ::: "memory");
        } else {
            XB_SPIN(xb_ld(&bar[XB_XGEN(b.x)]) == gen, bar);
            __builtin_amdgcn_fence(__ATOMIC_ACQUIRE, "agent");
            asm volatile("s_waitcnt vmcnt(0)" ::: "memory");
        }
    }
    __syncthreads();
}

struct Args { const float* in[35]; float* out; unsigned char* ws; int ph_lo, ph_hi, li, pad; };
struct Frame {
    LAS unsigned char* lds;
    unsigned char* ws; float* out;
    int tid, lane, wave, bid, G;
};
enum { I_X = 0, I_P, I_WIN, I_PEK, I_W1K, I_W2K, I_PEV, I_W1V, I_W2V, I_MU, I_W0, I_WUP, I_A0, I_AUP, I_GUP, I_KK, I_KA, I_RK, I_LNG, I_LNB, I_WOUT,
       I_LN1G, I_LN1B, I_RW, I_RB, I_EWG, I_EBG, I_EWU, I_EBU, I_EWD, I_EBD, I_LN2G, I_LN2B, I_PLEW, I_PLEG };

struct GemmDesc {
    const bf16* A; int lda; const int* rowidx;
    const bf16* Bt; int ldb;
    int Mrows, N, K;
    const int* block_e; size_t bstride; const int* nblk;
};
template <bool PAIR, class Epi>
__device__ __forceinline__ void ngemm_phase(Frame& F, const GemmDesc& g, const Epi& E) {
    LAS float* As = (LAS float*)F.lds;
    LAS float* Bs = As + 32 * 132;
    LAS float* Bu = Bs + 32 * 132;
    const int tid = F.tid, ty = tid >> 5, tx = tid & 31;
    const int lrow = tid >> 2, lkc = (tid & 3) * 8;
    const int ntm = g.Mrows / 128, ntn = PAIR ? g.N / 256 : g.N / 128;
    const int mlive = g.nblk ? (*g.nblk) * 256 : g.Mrows;
    for (int tile = F.bid; tile < ntm * ntn; tile += F.G) {
        const int tm = tile / ntn, tn = tile % ntn, m0 = tm * 128;
        if (m0 >= mlive) continue;
        const int e = g.block_e ? g.block_e[m0 >> 8] : 0;
        const bf16* Bt = g.Bt + (size_t)e * g.bstride;
        const int arow = g.rowidx ? g.rowidx[m0 + lrow] : (m0 + lrow);
        const bf16* ap = g.A + (size_t)arow * g.lda + lkc;
        const bf16* bp = Bt + (size_t)((PAIR ? tn * 256 : tn * 128) + lrow) * g.ldb + lkc;
        const bf16* bup = bp + (size_t)128 * g.ldb;
        f32x4 acc[8], accu[8];
#pragma unroll
        for (int i = 0; i < 8; ++i) { acc[i] = (f32x4){0.f, 0.f, 0.f, 0.f}; accu[i] = (f32x4){0.f, 0.f, 0.f, 0.f}; }
        for (int k0 = 0; k0 < g.K; k0 += 32) {
            const u32x4 av = *(const u32x4*)(ap + k0), bv = *(const u32x4*)(bp + k0);
            u32x4 uv = (u32x4){0u, 0u, 0u, 0u}; if (PAIR) uv = *(const u32x4*)(bup + k0);
            __syncthreads();
#pragma unroll
            for (int j = 0; j < 4; ++j) {
                As[(lkc + 2 * j) * 132 + lrow] = bflo(av[j]); As[(lkc + 2 * j + 1) * 132 + lrow] = bfhi(av[j]);
                Bs[(lkc + 2 * j) * 132 + lrow] = bflo(bv[j]); Bs[(lkc + 2 * j + 1) * 132 + lrow] = bfhi(bv[j]);
                if (PAIR) { Bu[(lkc + 2 * j) * 132 + lrow] = bflo(uv[j]); Bu[(lkc + 2 * j + 1) * 132 + lrow] = bfhi(uv[j]); }
            }
            __syncthreads();
#pragma unroll 4
            for (int k = 0; k < 32; ++k) {
                const f32x4 a0 = *(const LAS f32x4*)(As + k * 132 + ty * 8), a1 = *(const LAS f32x4*)(As + k * 132 + ty * 8 + 4);
                const f32x4 b = *(const LAS f32x4*)(Bs + k * 132 + tx * 4);
                acc[0] += a0.x * b; acc[1] += a0.y * b; acc[2] += a0.z * b; acc[3] += a0.w * b;
                acc[4] += a1.x * b; acc[5] += a1.y * b; acc[6] += a1.z * b; acc[7] += a1.w * b;
                if (PAIR) { const f32x4 u = *(const LAS f32x4*)(Bu + k * 132 + tx * 4);
                    accu[0] += a0.x * u; accu[1] += a0.y * u; accu[2] += a0.z * u; accu[3] += a0.w * u;
                    accu[4] += a1.x * u; accu[5] += a1.y * u; accu[6] += a1.z * u; accu[7] += a1.w * u; }
            }
        }
        const int col = (PAIR ? tn * 128 : tn * 128) + tx * 4;
#pragma unroll
        for (int i = 0; i < 8; ++i) { const int row = m0 + ty * 8 + i;
            if constexpr (PAIR) E.stp(row, col, acc[i], accu[i], e); else E.st(row, col, acc[i], e); }
    }
    __syncthreads();
}

__device__ __forceinline__ void st_bf16x4(bf16* p, f32x4 v) { u32x2 w; w.x = pk2(v.x, v.y); w.y = pk2(v.z, v.w); *(u32x2*)p = w; }
struct EpiZ { bf16* Z; __device__ __forceinline__ void st(int r, int c, f32x4 v, int) const { st_bf16x4(Z + (size_t)r * NZ + c, v); } };
struct EpiCmp { float* H; __device__ __forceinline__ void st(int r, int c, f32x4 v, int) const { if (c < 64) { f32x4 o; o.x = gelu_tanh(v.x); o.y = gelu_tanh(v.y); o.z = gelu_tanh(v.z); o.w = gelu_tanh(v.w); *(f32x4*)(H + (size_t)r * 64 + c) = o; } } };
struct EpiDecay { float* O; const float* w0;
    __device__ __forceinline__ float f(float x) const { const float y = -x; const float sp = fmaxf(y, 0.f) + log1pf(__expf(-fabsf(y))); return __expf(-__expf(-sp - 0.5f)); }
    __device__ __forceinline__ void st(int r, int c, f32x4 v, int) const { const f32x4 b = *(const f32x4*)(w0 + c); f32x4 o; o.x = f(v.x + b.x); o.y = f(v.y + b.y); o.z = f(v.z + b.z); o.w = f(v.w + b.w); *(f32x4*)(O + (size_t)r * 1024 + c) = o; } };
struct EpiASig { float* O; const float* a0;
    __device__ __forceinline__ void st(int r, int c, f32x4 v, int) const { const f32x4 b = *(const f32x4*)(a0 + c); f32x4 o; o.x = sigmoidf_(v.x + b.x); o.y = sigmoidf_(v.y + b.y); o.z = sigmoidf_(v.z + b.z); o.w = sigmoidf_(v.w + b.w); *(f32x4*)(O + (size_t)r * 1024 + c) = o; } };
struct EpiF32 { float* O; int ld; __device__ __forceinline__ void st(int r, int c, f32x4 v, int) const { *(f32x4*)(O + (size_t)r * ld + c) = v; } };
struct EpiPre1 { float* O; const float* x; __device__ __forceinline__ void st(int r, int c, f32x4 v, int) const { const f32x4 xv = *(const f32x4*)(x + (size_t)r * D + c); *(f32x4*)(O + (size_t)r * D + c) = ALPHA * xv + v; } };
struct EpiSwiglu { bf16* H; const float* bg; const float* bu;
    __device__ __forceinline__ float f(float g, float u) const { g = fminf(g, 7.0f); u = fminf(fmaxf(u, -7.0f), 7.0f); return g * sigmoidf_(1.702f * g) * (u + 1.0f); }
    __device__ __forceinline__ void stp(int r, int c, f32x4 g, f32x4 u, int e) const { const f32x4 b0 = *(const f32x4*)(bg + (size_t)e * D + c), b1 = *(const f32x4*)(bu + (size_t)e * D + c);
        f32x4 o; o.x = f(g.x + b0.x, u.x + b1.x); o.y = f(g.y + b0.y, u.y + b1.y); o.z = f(g.z + b0.z, u.z + b1.z); o.w = f(g.w + b0.w, u.w + b1.w); st_bf16x4(H + (size_t)r * D + c, o); } };
struct EpiDown { bf16* O; const float* bd; __device__ __forceinline__ void st(int r, int c, f32x4 v, int e) const { const f32x4 b = *(const f32x4*)(bd + (size_t)e * D + c); st_bf16x4(O + (size_t)r * D + c, v + b); } };
struct EpiBf16 { bf16* O; int ld; __device__ __forceinline__ void st(int r, int c, f32x4 v, int) const { st_bf16x4(O + (size_t)r * ld + c, v); } };
struct EpiFinal { float* out; const bf16* PL;
    __device__ __forceinline__ void st(int r, int c, f32x4 v, int) const { const size_t o = (size_t)r * D + c; const f32x4 h = *(const f32x4*)(out + o); const u32x2 pw = *(const u32x2*)(PL + o);
        f32x4 q; q.x = h.x + sigmoidf_(v.x) * bflo(pw.x); q.y = h.y + sigmoidf_(v.y) * bfhi(pw.x); q.z = h.z + sigmoidf_(v.z) * bflo(pw.y); q.w = h.w + sigmoidf_(v.w) * bfhi(pw.y); *(f32x4*)(out + o) = q; } };

template <bool PAIR, class Epi> __device__ __forceinline__ void gemm_run(Frame& F, const GemmDesc& g, const Epi& E) { ngemm_phase<PAIR, Epi>(F, g, E); }

__device__ __forceinline__ void transpose_item(const float* W, int K, int N, bf16* WT, int Kp, size_t row0, int k0, int n0, LAS float* scr, int lane) {
    const int n = n0 + (lane & 31);
#pragma unroll 8
    for (int i = 0; i < 32; ++i) { const int kk = 2 * i + (lane >> 5), k = k0 + kk; scr[kk * 33 + (lane & 31)] = (k < K && n < N) ? W[(size_t)k * N + n] : 0.f; }
    LDS_WAIT(); asm volatile("" ::: "memory");
    const int c = lane & 7;
#pragma unroll
    for (int j = 0; j < 4; ++j) { const int nn = (lane >> 3) + 8 * j; const LAS float* s = scr + (8 * c) * 33 + nn;
        u32x4 o; o.x = pk2(s[0 * 33], s[1 * 33]); o.y = pk2(s[2 * 33], s[3 * 33]); o.z = pk2(s[4 * 33], s[5 * 33]); o.w = pk2(s[6 * 33], s[7 * 33]);
        *(u32x4*)(WT + (row0 + nn) * Kp + k0 + 8 * c) = o; }
    LDS_WAIT(); asm volatile("" ::: "memory");
}
__device__ __forceinline__ void p0_prologue(Frame& F, const Args& a) {
    LAS float* scr = (LAS float*)(F.lds + F.wave * 16384);
    unsigned char* ws = F.ws;
    const int gw = F.bid * 8 + F.wave, NGW = F.G * 8;
    constexpr int I0 = 32 * 192, I1 = 32 * 64, I2 = 32 * 64, I3 = 4 * 64, I4 = 4 * 32, I5 = 4 * 32, I6 = 4 * 32, I7 = 32 * 8, I8 = 32 * 8, IE = 32 * 64;
    constexpr int NSIMPLE = I0 + I1 + I2 + I3 + I4 + I5 + I6 + I7 + I8;
    constexpr int NITEMS = NSIMPLE + NE * 3 * IE;
    for (int it = gw; it < NITEMS; it += NGW) {
        int r = it;
#define TR_SIMPLE(cnt, W, K, N, WT, Kp, nblk) if (r < (cnt)) { const int kb = r / (nblk), nb = r % (nblk); transpose_item((W), (K), (N), (bf16*)(WT), (Kp), (size_t)(32 * nb), 64 * kb, 32 * nb, scr, F.lane); continue; } r -= (cnt);
        TR_SIMPLE(I0, a.in[I_WIN], 2048, INC, ws + WS_WIN, 2048, 192)
        TR_SIMPLE(I1, a.in[I_WOUT], 2048, 2048, ws + WS_WOUT, 2048, 64)
        TR_SIMPLE(I2, a.in[I_PLEG], 2048, 2048, ws + WS_WPG, 2048, 64)
        TR_SIMPLE(I3, a.in[I_PLEW], 256, 2048, ws + WS_WPL, 256, 64)
        TR_SIMPLE(I4, a.in[I_WUP], 96, 1024, ws + WS_WUP, 256, 32)
        TR_SIMPLE(I5, a.in[I_AUP], 96, 1024, ws + WS_AUP, 256, 32)
        TR_SIMPLE(I6, a.in[I_GUP], 256, 1024, ws + WS_GUP, 256, 32)
        TR_SIMPLE(I7, a.in[I_W1K], 2048, 64, ws + WS_CW1K, 2048, 8)
        TR_SIMPLE(I8, a.in[I_W1V], 2048, 64, ws + WS_CW1V, 2048, 8)
#undef TR_SIMPLE
        const int e = r / (3 * IE), rr = r % (3 * IE), which = rr / IE, ri = rr % IE, kb = ri / 64, nb = ri % 64, n0 = 32 * nb;
        if (which == 0)      transpose_item(a.in[I_EWG] + (size_t)e * D * D, D, D, (bf16*)(ws + WS_WGU), D, (size_t)e * 4096 + (n0 >> 7) * 256 + (n0 & 127), 64 * kb, n0, scr, F.lane);
        else if (which == 1) transpose_item(a.in[I_EWU] + (size_t)e * D * D, D, D, (bf16*)(ws + WS_WGU), D, (size_t)e * 4096 + (n0 >> 7) * 256 + 128 + (n0 & 127), 64 * kb, n0, scr, F.lane);
        else                 transpose_item(a.in[I_EWD] + (size_t)e * D * D, D, D, (bf16*)(ws + WS_WDN), D, (size_t)e * 2048 + n0, 64 * kb, n0, scr, F.lane);
    }
    const size_t gt = (size_t)F.bid * 512 + F.tid, NT = (size_t)F.G * 512;
    { const float* x = a.in[I_X]; bf16* xb = (bf16*)(ws + WS_XB);
      for (size_t i = gt; i < (size_t)M * D / 8; i += NT) { const f32x4 v0 = *(const f32x4*)(x + i * 8), v1 = *(const f32x4*)(x + i * 8 + 4);
          u32x4 o; o.x = pk2(v0.x, v0.y); o.y = pk2(v0.z, v0.w); o.z = pk2(v1.x, v1.y); o.w = pk2(v1.z, v1.w); *(u32x4*)(xb + i * 8) = o; } }
    { const float* p = a.in[I_P]; bf16* pb = (bf16*)(ws + WS_PB);
      for (size_t i = gt; i < (size_t)M * 256 / 8; i += NT) { const f32x4 v0 = *(const f32x4*)(p + i * 8), v1 = *(const f32x4*)(p + i * 8 + 4);
          u32x4 o; o.x = pk2(v0.x, v0.y); o.y = pk2(v0.z, v0.w); o.z = pk2(v1.x, v1.y); o.w = pk2(v1.z, v1.w); *(u32x4*)(pb + i * 8) = o; } }
    { int* rt = (int*)(ws + WS_ROWTOK); for (size_t i = gt; i < (size_t)MAXROWS; i += NT) rt[i] = 0; }
}

__device__ __forceinline__ void p2_prep(Frame& F, const Args& a) {
    unsigned char* ws = F.ws;
    const bf16* Z = (const bf16*)(ws + WS_Z);
    const int gw = F.bid * 8 + F.wave, NGW = F.G * 8, lane = F.lane;
    for (int it = gw; it < 2 * 4096; it += NGW) {
        const int kv = it >> 12, row = it & 4095, g = row & 3, c = (row >> 2) & 255, b = row >> 10;
        bf16* dst = (bf16*)(ws + (kv ? WS_ACV : WS_ACK)) + (size_t)row * 2048;
        const float* pe = a.in[kv ? I_PEV : I_PEK];
        const int col0 = (kv ? ZVC : ZKC) + g * 64;
        for (int i = 0; i < 32; ++i) {
            float v = 0.f;
            if (c < NCMP) v = bf2f(Z[(size_t)(b * T + 16 * c + i) * NZ + col0 + lane]) + pe[i * 64 + lane];
            dst[i * 64 + lane] = (bf16)f2bf(v);
        }
    }
    const float* mu = a.in[I_MU];
    bf16* WL = (bf16*)(ws + WS_WL); bf16* AL = (bf16*)(ws + WS_AL); bf16* GLS = (bf16*)(ws + WS_GLS);
    for (int m = gw; m < M; m += NGW) {
        const int t = m & (T - 1);
#pragma unroll
        for (int i = 0; i < 7; ++i) {
            const int c = ZWL + lane + 64 * i;
            const float zc = bf2f(Z[(size_t)m * NZ + c]), zp = t ? bf2f(Z[(size_t)(m - 1) * NZ + c]) : 0.f;
            const float zs = zc + (zp - zc) * mu[c - ZRW];
            if (c < ZAL) WL[(size_t)m * 256 + (c - ZWL)] = (bf16)f2bf(tanhf(zs));
            else if (c < ZGLO) AL[(size_t)m * 256 + (c - ZAL)] = (bf16)f2bf(zs);
            else GLS[(size_t)m * 256 + (c - ZGLO)] = (bf16)f2bf(sigmoidf_(zs));
        }
        for (int j = 96 + lane; j < 256; j += 64) { WL[(size_t)m * 256 + j] = 0; AL[(size_t)m * 256 + j] = 0; }
    }
}

__device__ __forceinline__ void p4_prep(Frame& F, const Args& a) {
    unsigned char* ws = F.ws;
    const int gw = F.bid * 8 + F.wave, NGW = F.G * 8, lane = F.lane;
    for (int it = gw; it < 2 * 4096; it += NGW) {
        const int kv = it >> 12, row = it & 4095;
        const float* H = (const float*)(ws + (kv ? WS_HCMPV : WS_HCMPK)) + (size_t)row * 64;
        const float* w2 = a.in[kv ? I_W2V : I_W2K];
        const float hv = H[lane]; float o = 0.f;
#pragma unroll 8
        for (int j = 0; j < 64; ++j) o += __shfl(hv, j) * w2[j * 64 + lane];
        ((bf16*)(ws + (kv ? WS_VCMP : WS_KCMP)))[(size_t)row * 64 + lane] = (bf16)f2bf(o);
    }
    const bf16* Z = (const bf16*)(ws + WS_Z);
    const float* mu = a.in[I_MU]; const float* DEC = (const float*)(ws + WS_DEC); const float* ASIG = (const float*)(ws + WS_ASIG);
    const float* kk_w = a.in[I_KK]; const float* ka_w = a.in[I_KA];
    float* SC = (float*)(ws + WS_SC);
    for (int it = gw; it < M * 16; it += NGW) {
        const int m = it >> 4, h = it & 15, t = m & (T - 1), b = m >> 12, col = h * 64 + lane;
        const size_t zo = (size_t)m * NZ;
        float r, k, v;
        { const int c = ZR + col; const float zc = bf2f(Z[zo + c]), zp = t ? bf2f(Z[zo - NZ + c]) : 0.f; r = zc + (zp - zc) * mu[c - ZRW]; }
        { const int c = ZK + col; const float zc = bf2f(Z[zo + c]), zp = t ? bf2f(Z[zo - NZ + c]) : 0.f; k = zc + (zp - zc) * mu[c - ZRW]; }
        { const int c = ZV + col; const float zc = bf2f(Z[zo + c]), zp = t ? bf2f(Z[zo - NZ + c]) : 0.f; v = zc + (zp - zc) * mu[c - ZRW]; }
        const float av = ASIG[(size_t)m * 1024 + col], w = DEC[(size_t)m * 1024 + col];
        float kk = k * kk_w[col];
        const float nrm = sqrtf(wave_sum(kk * kk));
        kk = kk / fmaxf(nrm, 1e-12f);
        const float k2 = k * (1.0f + (av - 1.0f) * ka_w[col]);
        float* sc = SC + ((size_t)(b * 16 + h) * T + t) * 384;
        sc[lane] = r; sc[64 + lane] = w; sc[128 + lane] = k2; sc[192 + lane] = v; sc[256 + lane] = -kk; sc[320 + lane] = kk * av;
    }
}

__device__ __forceinline__ float dpp_sum16(float x) {
    x += __builtin_bit_cast(float, __builtin_amdgcn_update_dpp(0, __builtin_bit_cast(int, x), 0xB1, 0xF, 0xF, true));
    x += __builtin_bit_cast(float, __builtin_amdgcn_update_dpp(0, __builtin_bit_cast(int, x), 0x4E, 0xF, 0xF, true));
    x += __builtin_bit_cast(float, __builtin_amdgcn_update_dpp(0, __builtin_bit_cast(int, x), 0x141, 0xF, 0xF, true));
    x += __builtin_bit_cast(float, __builtin_amdgcn_update_dpp(0, __builtin_bit_cast(int, x), 0x140, 0xF, 0xF, true));
    return x;
}
__device__ __forceinline__ void p5_scan(Frame& F) {
    constexpr int TC = 32, CHF = TC * 384;
    LAS float* buf = (LAS float*)F.lds;
    const float* SC = (const float*)(F.ws + WS_SC);
    float* Y = (float*)(F.ws + WS_Y);
    const int tid = F.tid, lane = F.lane, wave = F.wave, kq = lane & 15, rl = lane >> 4;
    for (int task = F.bid; task < 256; task += F.G) {
        const int bh = task >> 2, quarter = task & 3, b = bh >> 4, h = bh & 15;
        const int row = (quarter * 4 + wave) * 4 + rl;
        const float* src = SC + (size_t)bh * T * 384;
        __syncthreads();
#pragma unroll
        for (int i = 0; i < 6; ++i) *(LAS f32x4*)(buf + (tid + 512 * i) * 4) = *(const f32x4*)(src + (size_t)(tid + 512 * i) * 4);
        __syncthreads();
        f32x4 S = (f32x4){0.f, 0.f, 0.f, 0.f};
        for (int c = 0; c < T / TC; ++c) {
            f32x4 nx[6];
            const bool more = (c + 1 < T / TC);
            if (more) {
#pragma unroll
                for (int i = 0; i < 6; ++i) nx[i] = *(const f32x4*)(src + (size_t)(c + 1) * CHF + (size_t)(tid + 512 * i) * 4);
            }
            if (wave < 4) {
                const LAS float* cb = buf + (c & 1) * CHF;
#pragma unroll 4
                for (int tt = 0; tt < TC; ++tt) {
                    const LAS float* s = cb + tt * 384;
                    const f32x4 r4 = *(const LAS f32x4*)(s + kq * 4), w4 = *(const LAS f32x4*)(s + 64 + kq * 4), k4 = *(const LAS f32x4*)(s + 128 + kq * 4);
                    const f32x4 a4 = *(const LAS f32x4*)(s + 256 + kq * 4), b4 = *(const LAS f32x4*)(s + 320 + kq * 4);
                    const float vv = s[192 + row];
                    float sa = S.x * a4.x + S.y * a4.y + S.z * a4.z + S.w * a4.w;
                    sa = dpp_sum16(sa);
                    S = S * w4 + sa * b4 + vv * k4;
                    float y = S.x * r4.x + S.y * r4.y + S.z * r4.z + S.w * r4.w;
                    y = dpp_sum16(y);
                    if (kq == 0) Y[((size_t)(b * T) + c * TC + tt) * 1024 + h * 64 + row] = y;
                }
            }
            if (more) {
#pragma unroll
                for (int i = 0; i < 6; ++i) *(LAS f32x4*)(buf + ((c + 1) & 1) * CHF + (tid + 512 * i) * 4) = nx[i];
            }
            __syncthreads();
        }
    }
    __syncthreads();
}

__device__ __forceinline__ void softmax_lds(LAS float* ps, int nk, int lane) {
    float mx = -INFINITY;
    for (int i = lane; i < nk; i += 64) mx = fmaxf(mx, ps[i]);
    mx = wave_max(mx);
    if (mx == -INFINITY) { for (int i = lane; i < nk; i += 64) ps[i] = 0.f; LDS_WAIT(); return; }
    float sum = 0.f;
    for (int i = lane; i < nk; i += 64) { const float e = __expf(ps[i] - mx); ps[i] = e; sum += e; }
    sum = wave_sum(sum);
    const float inv = 1.0f / fmaxf(sum, 1e-30f);
    for (int i = lane; i < nk; i += 64) ps[i] *= inv;
    LDS_WAIT();
}
__device__ __forceinline__ float dot64(const LAS float* q, const bf16* krow) {
    float s = 0.f;
#pragma unroll
    for (int j = 0; j < 8; ++j) { const u32x4 kv = *(const u32x4*)(krow + 8 * j); const f32x4 q0 = *(const LAS f32x4*)(q + 8 * j), q1 = *(const LAS f32x4*)(q + 8 * j + 4);
        s += q0.x * bflo(kv.x) + q0.y * bfhi(kv.x) + q0.z * bflo(kv.y) + q0.w * bfhi(kv.y) + q1.x * bflo(kv.z) + q1.y * bfhi(kv.z) + q1.z * bflo(kv.w) + q1.w * bfhi(kv.w); }
    return s;
}
__device__ __forceinline__ void p5_attn_naive(Frame& F) {
    unsigned char* ws = F.ws;
    const bf16* Z = (const bf16*)(ws + WS_Z);
    const bf16* KC = (const bf16*)(ws + WS_KCMP); const bf16* VC = (const bf16*)(ws + WS_VCMP);
    bf16* CAT = (bf16*)(ws + WS_CAT);
    const int lane = F.lane, gw = F.bid * 8 + F.wave, NGW = F.G * 8;
    LAS float* qs = (LAS float*)(F.lds + F.wave * 5120);
    LAS float* ps = qs + 256;
    for (int it = gw; it < NB * 4 * T; it += NGW) {
        const int t = it & (T - 1), g = (it >> 12) & 3, b = it >> 14, m = b * T + t, cur = t >> 6;
        const size_t zo = (size_t)m * NZ;
#pragma unroll
        for (int r = 0; r < 4; ++r) qs[r * 64 + lane] = bf2f(Z[zo + ZQ + (4 * g + r) * 64 + lane]);
        LDS_WAIT();
        float imp = 0.f, oacc[4];
        const int ncv = t >= 31 ? ((t - 31) >> 4) + 1 : 0;
#pragma unroll
        for (int r = 0; r < 4; ++r) {
            const int h = 4 * g + r; const float slope = exp2f(-0.5f * (float)(h + 1));
#pragma unroll
            for (int ch = 0; ch < 4; ++ch) { const int c = ch * 64 + lane; float s = -INFINITY;
                if (c < ncv) s = dot64(qs + r * 64, KC + ((size_t)(b * 256 + c) * 4 + g) * 64) * 0.125f - slope * (float)(t - (16 * c + 31));
                ps[c] = s; }
            LDS_WAIT();
            softmax_lds(ps, 256, lane);
            float o = 0.f;
            for (int c = 0; c < ncv; ++c) o += ps[c] * bf2f(VC[((size_t)(b * 256 + c) * 4 + g) * 64 + lane]);
            { const int j = lane; float v = 32.0f * (ps[4 * j] + ps[4 * j + 1] + ps[4 * j + 2]);
              if (j > 0) v += 16.0f * ps[4 * j - 1];
              v += 16.0f * ps[4 * j + 3];
              imp += v; }
            oacc[r] = sigmoidf_(bf2f(Z[zo + ZGL + h * 3 + 0])) * o;
            LDS_WAIT();
        }
        float v = imp;
        if (lane == 0 || lane == cur || lane == cur - 1) v = INFINITY; else if (lane > cur) v = -INFINITY;
        int rank = 0;
        for (int jj = 0; jj < 64; ++jj) { const float vv = __shfl(v, jj); rank += (vv > v || (vv == v && jj < lane)) ? 1 : 0; }
        const unsigned long long selmask = __ballot(rank < 16) & (cur >= 63 ? ~0ull : ((1ull << (cur + 1)) - 1ull));
#pragma unroll
        for (int r = 0; r < 4; ++r) {
            const int h = 4 * g + r; const float slope = exp2f(-0.5f * (float)(h + 1));
            int n = 0;
            for (unsigned long long mm = selmask; mm; mm &= mm - 1, ++n) { const int j = __builtin_ctzll(mm); const int pos = 64 * j + lane; float s = -INFINITY;
                if (pos <= t) s = dot64(qs + r * 64, Z + (size_t)(b * T + pos) * NZ + ZKS + g * 64) * 0.125f - slope * (float)(t - pos);
                ps[n * 64 + lane] = s; }
            LDS_WAIT();
            softmax_lds(ps, n * 64, lane);
            float o = 0.f; n = 0;
            for (unsigned long long mm = selmask; mm; mm &= mm - 1, ++n) { const int j = __builtin_ctzll(mm);
                const int lim = (64 * j + 63 <= t) ? 64 : (t - 64 * j + 1);
                const bf16* vb = Z + (size_t)(b * T + 64 * j) * NZ + ZVS + g * 64 + lane;
                for (int i = 0; i < lim; ++i) o += ps[n * 64 + i] * bf2f(vb[(size_t)i * NZ]); }
            oacc[r] += sigmoidf_(bf2f(Z[zo + ZGL + h * 3 + 1])) * o;
            LDS_WAIT();
        }
#pragma unroll
        for (int r = 0; r < 4; ++r) {
            const int h = 4 * g + r; const float slope = exp2f(-0.5f * (float)(h + 1));
#pragma unroll
            for (int ch = 0; ch < 8; ++ch) { const int pos = t - 511 + ch * 64 + lane; float s = -INFINITY;
                if (pos >= 0) s = dot64(qs + r * 64, Z + (size_t)(b * T + pos) * NZ + ZKW + g * 64) * 0.125f - slope * (float)(t - pos);
                ps[ch * 64 + lane] = s; }
            LDS_WAIT();
            softmax_lds(ps, 512, lane);
            float o = 0.f;
            const int i0 = t >= 511 ? 0 : 511 - t;
            const bf16* vb = Z + ZVW + g * 64 + lane;
            for (int i = i0; i < 512; ++i) o += ps[i] * bf2f(vb[(size_t)(b * T + t - 511 + i) * NZ]);
            oacc[r] += sigmoidf_(bf2f(Z[zo + ZGL + h * 3 + 2])) * o;
            CAT[(size_t)m * D + h * 64 + lane] = (bf16)f2bf(oacc[r]);
            LDS_WAIT();
        }
    }
}

__device__ __forceinline__ void p6_rwkv_out(Frame& F, const Args& a) {
    unsigned char* ws = F.ws;
    const float* Y = (const float*)(ws + WS_Y); const float* SC = (const float*)(ws + WS_SC); const float* G = (const float*)(ws + WS_G);
    const float* rk = a.in[I_RK]; const float* lng = a.in[I_LNG]; const float* lnb = a.in[I_LNB];
    bf16* CAT = (bf16*)(ws + WS_CAT);
    const int lane = F.lane, gw = F.bid * 8 + F.wave, NGW = F.G * 8;
    for (int it = gw; it < M * 16; it += NGW) {
        const int m = it >> 4, h = it & 15, t = m & (T - 1), b = m >> 12, col = h * 64 + lane;
        const float y = Y[(size_t)m * 1024 + col];
        const float mean = wave_sum(y) * (1.0f / 64.0f); const float d = y - mean;
        const float var = wave_sum(d * d) * (1.0f / 64.0f);
        const float yn = d * rsqrtf(var + GN_EPS) * lng[col] + lnb[col];
        const float* sc = SC + ((size_t)(b * 16 + h) * T + t) * 384;
        const float r = sc[lane], k2 = sc[128 + lane], v = sc[192 + lane];
        const float bonus = wave_sum(r * k2 * rk[col]) * v;
        CAT[(size_t)m * D + 1024 + col] = (bf16)f2bf((yn + bonus) * G[(size_t)m * 1024 + col]);
    }
}

__device__ __forceinline__ void p8_ln_router(Frame& F, const Args& a) {
    unsigned char* ws = F.ws;
    const float* PRE = F.out; float* H1 = (float*)(ws + WS_H1); bf16* H1B = (bf16*)(ws + WS_H1B);
    const float* g1 = a.in[I_LN1G]; const float* b1 = a.in[I_LN1B]; const float* rw = a.in[I_RW]; const float* rb = a.in[I_RB];
    int* TOPE = (int*)(ws + WS_TOPE); float* TOPW = (float*)(ws + WS_TOPW); int* SLOT = (int*)(ws + WS_SLOT); int* HIST = (int*)(ws + WS_HIST);
    const int lane = F.lane, wave = F.wave, tid = F.tid;
    LAS float* hs = (LAS float*)(F.lds + wave * 8192);
    LAS int* es = (LAS int*)(F.lds + 8 * 8192);
    for (int ch = F.bid; ch < M / 64; ch += F.G) {
        for (int i = 0; i < 8; ++i) {
            const int m = ch * 64 + wave * 8 + i;
            {
                const f32x4* pr = (const f32x4*)(PRE + (size_t)m * D) + lane;
                f32x4 v[8]; float s = 0.f;
#pragma unroll
                for (int j = 0; j < 8; ++j) { v[j] = pr[64 * j]; s += (v[j].x + v[j].y) + (v[j].z + v[j].w); }
                const float mean = wave_sum(s) * (1.0f / D); float s2 = 0.f;
#pragma unroll
                for (int j = 0; j < 8; ++j) { v[j] = v[j] - mean; s2 += (v[j].x * v[j].x + v[j].y * v[j].y) + (v[j].z * v[j].z + v[j].w * v[j].w); }
                const float rstd = rsqrtf(wave_sum(s2) * (1.0f / D) + LN_EPS);
#pragma unroll
                for (int j = 0; j < 8; ++j) {
                    const int c0 = 256 * j + 4 * lane;
                    const f32x4 gg = *(const f32x4*)(g1 + c0), bb = *(const f32x4*)(b1 + c0);
                    const f32x4 hv = v[j] * rstd * gg + bb;
                    *(f32x4*)(H1 + (size_t)m * D + c0) = hv;
                    u32x2 w; w.x = pk2(hv.x, hv.y); w.y = pk2(hv.z, hv.w); *(u32x2*)(H1B + (size_t)m * D + c0) = w;
                    *(LAS f32x4*)(hs + c0) = hv;
                }
            }
            LDS_WAIT(); asm volatile("" ::: "memory");
            float lg;
            {
                const int e = lane & 31, half = lane >> 5;
                const float* wp = rw + (size_t)(half * 1024) * 32 + e;
                const LAS float* hp = hs + half * 1024;
                float a0 = 0.f, a1 = 0.f, a2 = 0.f, a3 = 0.f;
#pragma unroll 4
                for (int i4 = 0; i4 < 256; ++i4) { const f32x4 h4 = *(const LAS f32x4*)(hp + 4 * i4); const float* w = wp + (size_t)i4 * 128;
                    a0 += h4.x * w[0]; a1 += h4.y * w[32]; a2 += h4.z * w[64]; a3 += h4.w * w[96]; }
                float acc = (a0 + a1) + (a2 + a3);
                acc += __shfl_xor(acc, 32);
                lg = (lane < 32) ? acc + rb[lane] : -INFINITY;
            }
            LDS_WAIT(); asm volatile("" ::: "memory");
            float tl[4]; int te[4];
#pragma unroll
            for (int k = 0; k < 4; ++k) { const float mx = wave_max(lg); const unsigned long long bm = __ballot(lg == mx); const int idx = __builtin_ctzll(bm); tl[k] = mx; te[k] = idx; if (lane == idx) lg = -INFINITY; }
            const float e1 = __expf(tl[1] - tl[0]), e2 = __expf(tl[2] - tl[0]), e3 = __expf(tl[3] - tl[0]); const float inv = 1.0f / (1.0f + e1 + e2 + e3);
            if (lane == 0) { *(int4*)(TOPE + (size_t)m * 4) = make_int4(te[0], te[1], te[2], te[3]); *(f32x4*)(TOPW + (size_t)m * 4) = (f32x4){inv, e1 * inv, e2 * inv, e3 * inv};
                es[(wave * 8 + i) * 4 + 0] = te[0]; es[(wave * 8 + i) * 4 + 1] = te[1]; es[(wave * 8 + i) * 4 + 2] = te[2]; es[(wave * 8 + i) * 4 + 3] = te[3]; }
        }
        __syncthreads();
        if (tid < 256) { const int e = es[tid]; int slot = 0; for (int q = 0; q < tid; ++q) slot += (es[q] == e) ? 1 : 0; SLOT[(size_t)ch * 256 + tid] = slot; }
        if (tid >= 256 && tid < 288) { const int e = tid - 256; int cnt = 0; for (int q = 0; q < 256; ++q) cnt += (es[q] == e) ? 1 : 0; HIST[ch * 32 + e] = cnt; }
        __syncthreads();
    }
}

__device__ __forceinline__ void p9_offsets(Frame& F) {
    unsigned char* ws = F.ws;
    const int* HIST = (const int*)(ws + WS_HIST); const int* TOPE = (const int*)(ws + WS_TOPE); const int* SLOT = (const int*)(ws + WS_SLOT);
    int* TOKROW = (int*)(ws + WS_TOKROW); int* ROWTOK = (int*)(ws + WS_ROWTOK); int* BLKE = (int*)(ws + WS_BLKE);
    LAS int* part = (LAS int*)F.lds;
    LAS int* tot = part + 512;
    LAS int* pre = tot + 32;
    LAS int* startp = pre + 32;
    const int tid = F.tid, e = tid & 31, pg = tid >> 5;
    for (int ch = F.bid; ch < M / 64; ch += F.G) {
        __syncthreads();
        { int s = 0; for (int c = pg * 16; c < pg * 16 + 16; ++c) s += HIST[c * 32 + e]; part[pg * 32 + e] = s; }
        __syncthreads();
        if (tid < 32) { int s = 0; for (int q = 0; q < 16; ++q) s += part[q * 32 + tid]; tot[tid] = s; }
        __syncthreads();
        { int s = 0; for (int c = pg * 16; c < pg * 16 + 16; ++c) if (c < ch) s += HIST[c * 32 + e]; part[pg * 32 + e] = s; }
        __syncthreads();
        if (tid < 32) { int s = 0; for (int q = 0; q < 16; ++q) s += part[q * 32 + tid]; pre[tid] = s; }
        if (tid == 32) { int s = 0; for (int q = 0; q < 32; ++q) { startp[q] = s; s += (tot[q] + 255) / 256 * 256; } startp[32] = s; }
        __syncthreads();
        if (tid < 256) { const int m = ch * 64 + (tid >> 2); const int ee = TOPE[(size_t)m * 4 + (tid & 3)]; const int dest = startp[ee] + pre[ee] + SLOT[(size_t)ch * 256 + tid];
            ROWTOK[dest] = m; TOKROW[(size_t)m * 4 + (tid & 3)] = dest; }
        if (ch == 0) {
            const int nblk = startp[32] >> 8;
            if (tid < MAXBLK) { int be = -1; if (tid < nblk) { for (int q = 0; q < 32; ++q) if (startp[q] <= tid * 256 && tid * 256 < startp[q + 1]) be = q; } BLKE[tid] = be < 0 ? 0 : be; }
            if (tid == 0) BLKE[MAXBLK] = nblk;
        }
    }
    __syncthreads();
}

__device__ __forceinline__ void p12_combine_ln2(Frame& F, const Args& a) {
    unsigned char* ws = F.ws;
    const float* H1 = (const float*)(ws + WS_H1); const bf16* EO = (const bf16*)(ws + WS_EO); const int* TOKROW = (const int*)(ws + WS_TOKROW); const float* TOPW = (const float*)(ws + WS_TOPW);
    float* H2 = F.out; bf16* H2B = (bf16*)(ws + WS_H2B);
    const float* g2 = a.in[I_LN2G]; const float* b2 = a.in[I_LN2B];
    const int lane = F.lane, gw = F.bid * 8 + F.wave, NGW = F.G * 8;
    for (int m = gw; m < M; m += NGW) {
        const int4 rows = *(const int4*)(TOKROW + (size_t)m * 4); const f32x4 tw = *(const f32x4*)(TOPW + (size_t)m * 4);
        const int rr[4] = {rows.x, rows.y, rows.z, rows.w};
        f32x4 v[8]; float s = 0.f;
#pragma unroll
        for (int j = 0; j < 8; ++j) {
            const int c0 = 256 * j + 4 * lane;
            f32x4 y = (f32x4){0.f, 0.f, 0.f, 0.f};
#pragma unroll
            for (int k = 0; k < 4; ++k) { const u32x2 w = *(const u32x2*)(EO + (size_t)rr[k] * D + c0); const float wk = tw[k];
                y.x += wk * bflo(w.x); y.y += wk * bfhi(w.x); y.z += wk * bflo(w.y); y.w += wk * bfhi(w.y); }
            v[j] = ALPHA * *(const f32x4*)(H1 + (size_t)m * D + c0) + y;
            s += (v[j].x + v[j].y) + (v[j].z + v[j].w);
        }
        const float mean = wave_sum(s) * (1.0f / D); float s2 = 0.f;
#pragma unroll
        for (int j = 0; j < 8; ++j) { v[j] = v[j] - mean; s2 += (v[j].x * v[j].x + v[j].y * v[j].y) + (v[j].z * v[j].z + v[j].w * v[j].w); }
        const float rstd = rsqrtf(wave_sum(s2) * (1.0f / D) + LN_EPS);
#pragma unroll
        for (int j = 0; j < 8; ++j) { const int c0 = 256 * j + 4 * lane; const f32x4 gg = *(const f32x4*)(g2 + c0), bb = *(const f32x4*)(b2 + c0);
            const f32x4 hv = v[j] * rstd * gg + bb; *(f32x4*)(H2 + (size_t)m * D + c0) = hv;
            u32x2 w; w.x = pk2(hv.x, hv.y); w.y = pk2(hv.z, hv.w); *(u32x2*)(H2B + (size_t)m * D + c0) = w; }
    }
}

__global__ void __launch_bounds__(512, 2) hymba_fwd(Args args) {
    extern __shared__ __attribute__((aligned(16))) unsigned char lds_raw[];
    Frame F;
    F.lds = (LAS unsigned char*)lds_raw; F.ws = args.ws; F.out = args.out;
    F.tid = threadIdx.x; F.lane = F.tid & 63; F.wave = __builtin_amdgcn_readfirstlane(F.tid >> 6); F.bid = blockIdx.x; F.G = gridDim.x;
    unsigned char* ws = args.ws;
    volatile LAS unsigned* MISC = (volatile LAS unsigned*)(F.lds + LDS_MISC);
    if (F.tid < 32) MISC[F.tid] = 0u;
    __syncthreads();
    XcdBarrier bar; bar.bar = (unsigned*)(ws + WS_CTL) + CW_BAR; bar.x = 0; bar.st = nullptr;
    const int lo = args.ph_lo, hi = args.ph_hi;
    const bool one_launch = (hi - lo) > 1;
    if (one_launch) bar = xcd_barrier_post((unsigned*)(ws + WS_CTL) + CW_BAR, MISC + 8);
#ifdef ONLYPH
#define IN(k) ((k) == ONLYPH && lo <= (k) && (k) < hi)
#else
#define IN(k) (lo <= (k) && (k) < hi)
#endif
#define SEAM(k) do { if (IN(k) && IN((k) + 1)) xcd_barrier(bar); } while (0)

    if (IN(0)) { p0_prologue(F, args); } SEAM(0);
    if (IN(1)) { GemmDesc g{(const bf16*)(ws + WS_XB), D, nullptr, (const bf16*)(ws + WS_WIN), D, M, NZ, D, nullptr, 0, nullptr}; EpiZ E{(bf16*)(ws + WS_Z)}; gemm_run<false>(F, g, E); } SEAM(1);
    if (IN(2)) { p2_prep(F, args); } SEAM(2);
    if (IN(3)) {
        { GemmDesc g{(const bf16*)(ws + WS_ACK), D, nullptr, (const bf16*)(ws + WS_CW1K), D, 4096, 256, D, nullptr, 0, nullptr}; EpiCmp E{(float*)(ws + WS_HCMPK)}; gemm_run<false>(F, g, E); }
        { GemmDesc g{(const bf16*)(ws + WS_ACV), D, nullptr, (const bf16*)(ws + WS_CW1V), D, 4096, 256, D, nullptr, 0, nullptr}; EpiCmp E{(float*)(ws + WS_HCMPV)}; gemm_run<false>(F, g, E); }
        { GemmDesc g{(const bf16*)(ws + WS_WL), 256, nullptr, (const bf16*)(ws + WS_WUP), 256, M, 1024, 256, nullptr, 0, nullptr}; EpiDecay E{(float*)(ws + WS_DEC), args.in[I_W0]}; gemm_run<false>(F, g, E); }
        { GemmDesc g{(const bf16*)(ws + WS_AL), 256, nullptr, (const bf16*)(ws + WS_AUP), 256, M, 1024, 256, nullptr, 0, nullptr}; EpiASig E{(float*)(ws + WS_ASIG), args.in[I_A0]}; gemm_run<false>(F, g, E); }
        { GemmDesc g{(const bf16*)(ws + WS_GLS), 256, nullptr, (const bf16*)(ws + WS_GUP), 256, M, 1024, 256, nullptr, 0, nullptr}; EpiF32 E{(float*)(ws + WS_G), 1024}; gemm_run<false>(F, g, E); }
    } SEAM(3);
    if (IN(4)) { p4_prep(F, args); } SEAM(4);
    if (IN(5)) { p5_scan(F); p5_attn_naive(F); } SEAM(5);
    if (IN(6)) { p6_rwkv_out(F, args); } SEAM(6);
    if (IN(7)) { GemmDesc g{(const bf16*)(ws + WS_CAT), D, nullptr, (const bf16*)(ws + WS_WOUT), D, M, D, D, nullptr, 0, nullptr}; EpiPre1 E{F.out, args.in[I_X]}; gemm_run<false>(F, g, E); } SEAM(7);
    if (IN(8)) { p8_ln_router(F, args); } SEAM(8);
    if (IN(9)) { p9_offsets(F); } SEAM(9);
    if (IN(10)) { GemmDesc g{(const bf16*)(ws + WS_H1B), D, (const int*)(ws + WS_ROWTOK), (const bf16*)(ws + WS_WGU), D, MAXROWS, 4096, D, (const int*)(ws + WS_BLKE), (size_t)4096 * D, (const int*)(ws + WS_BLKE) + MAXBLK};
        EpiSwiglu E{(bf16*)(ws + WS_HACT), args.in[I_EBG], args.in[I_EBU]}; gemm_run<true>(F, g, E); } SEAM(10);
    if (IN(11)) {
        { GemmDesc g{(const bf16*)(ws + WS_HACT), D, nullptr, (const bf16*)(ws + WS_WDN), D, MAXROWS, D, D, (const int*)(ws + WS_BLKE), (size_t)D * D, (const int*)(ws + WS_BLKE) + MAXBLK};
          EpiDown E{(bf16*)(ws + WS_EO), args.in[I_EBD]}; gemm_run<false>(F, g, E); }
        { GemmDesc g{(const bf16*)(ws + WS_PB), 256, nullptr, (const bf16*)(ws + WS_WPL), 256, M, D, 256, nullptr, 0, nullptr}; EpiBf16 E{(bf16*)(ws + WS_PL), D}; gemm_run<false>(F, g, E); }
    } SEAM(11);
    if (IN(12)) { p12_combine_ln2(F, args); } SEAM(12);
    if (IN(13)) { GemmDesc g{(const bf16*)(ws + WS_H2B), D, nullptr, (const bf16*)(ws + WS_WPG), D, M, D, D, nullptr, 0, nullptr}; EpiFinal E{F.out, (const bf16*)(ws + WS_PL)}; gemm_run<false>(F, g, E); }
#undef IN
#undef SEAM
}

extern "C" void kernel_launch(void* const* d_in, const int* in_sizes, int n_in, void* d_out, int out_size, void* d_ws, size_t ws_size, hipStream_t stream) {
    static int grid = 0;
    if (grid == 0) {
        if (n_in != 35 || out_size != M * D || ws_size < WS_END) { fprintf(stderr, "kernel_launch: unexpected problem (n_in %d, out %d, ws %zu < %zu)\n", n_in, out_size, ws_size, (size_t)WS_END); grid = -1; return; }
        int dev = 0, cus = 0, per_cu = 0;
        if (hipGetDevice(&dev) != hipSuccess || hipDeviceGetAttribute(&cus, hipDeviceAttributeMultiprocessorCount, dev) != hipSuccess) { grid = -1; return; }
        if (hipFuncSetAttribute((const void*)hymba_fwd, hipFuncAttributeMaxDynamicSharedMemorySize, LDS_BYTES) != hipSuccess) { fprintf(stderr, "kernel_launch: hipFuncSetAttribute failed\n"); grid = -1; return; }
        if (hipOccupancyMaxActiveBlocksPerMultiprocessor(&per_cu, (const void*)hymba_fwd, 512, LDS_BYTES) != hipSuccess || per_cu < 1) fprintf(stderr, "kernel_launch: occupancy query reports %d\n", per_cu);
        (void)hipGetLastError();
        grid = cus;
    }
    if (grid < 0) return;
    if (hipMemsetAsync((char*)d_ws + WS_CTL, 0, CTL_ZERO_BYTES, stream) != hipSuccess) return;
    Args a{};
    for (int i = 0; i < 35; ++i) a.in[i] = (const float*)d_in[i];
    a.out = (float*)d_out; a.ws = (unsigned char*)d_ws;
#if MK_LAUNCH_PER_PHASE
    for (int ph = 0; ph < NPHASE; ++ph) { a.ph_lo = ph; a.ph_hi = ph + 1; a.li = ph; hipLaunchKernelGGL(hymba_fwd, dim3(grid), dim3(512), LDS_BYTES, stream, a); }
#else
    a.ph_lo = 0; a.ph_hi = NPHASE; a.li = 0;
    hipLaunchKernelGGL(hymba_fwd, dim3(grid), dim3(512), LDS_BYTES, stream, a);
#endif
}
```

```cpp
#include <hip/hip_runtime.h>
#include <cstdio>
#include <cstdint>

#ifndef MK_LAUNCH_PER_PHASE
#define MK_LAUNCH_PER_PHASE 0
#endif

#define GAS __attribute__((address_space(1)))
#define LAS __attribute__((address_space(3)))
typedef unsigned short bf16;
typedef float f32x4 __attribute__((ext_vector_type(4)));
typedef unsigned u32x4 __attribute__((ext_vector_type(4)));
typedef unsigned u32x2 __attribute__((ext_vector_type(2)));
#define LDS_WAIT() asm volatile("s_waitcnt lgkmcnt(0)" ::: "memory")

constexpr int NB = 4, T = 4096, D = 2048, M = NB * T;
constexpr int NZ = 6144;
constexpr int ZQ = 0, ZKC = 1024, ZVC = 1280, ZKS = 1536, ZVS = 1792, ZKW = 2048, ZVW = 2304, ZGL = 2560, ZRW = 2608;
constexpr int ZR = 2608, ZK = 3632, ZV = 4656, ZWL = 5680, ZAL = 5776, ZGLO = 5872, INC = 6128;
constexpr int NCMP = 255, NE = 32, MAXBLK = 288, MAXROWS = MAXBLK * 256;
constexpr float LN_EPS = 1e-5f, GN_EPS = 64e-5f, ALPHA = 1.189207115002721f;
constexpr int NPHASE = 14;

constexpr size_t MiB = 1u << 20;
constexpr size_t WS_CTL = 0, CTL_ZERO_BYTES = 1 * MiB;
constexpr size_t WS_HIST = 1 * MiB;
constexpr size_t WS_BLKE = 1 * MiB + 64 * 1024;
constexpr size_t WS_TOPE = 2 * MiB;
constexpr size_t WS_TOPW = WS_TOPE + 256 * 1024;
constexpr size_t WS_SLOT = WS_TOPW + 256 * 1024;
constexpr size_t WS_TOKROW = WS_SLOT + 256 * 1024;
constexpr size_t WS_ROWTOK = 3 * MiB;
constexpr size_t WS_RWT = 3 * MiB + 512 * 1024;
constexpr size_t WS_WPL = 4 * MiB;
constexpr size_t WS_WUP = 5 * MiB;
constexpr size_t WS_AUP = WS_WUP + 512 * 1024;
constexpr size_t WS_GUP = 6 * MiB;
constexpr size_t WS_CW1K = 7 * MiB;
constexpr size_t WS_CW1V = 8 * MiB;
constexpr size_t WS_HCMPK = 9 * MiB;
constexpr size_t WS_HCMPV = 10 * MiB;
constexpr size_t WS_KCMP = 11 * MiB;
constexpr size_t WS_VCMP = 11 * MiB + 512 * 1024;
constexpr size_t WS_WIN = 12 * MiB;
constexpr size_t WS_WOUT = 36 * MiB;
constexpr size_t WS_WPG = 44 * MiB;
constexpr size_t WS_PB = 52 * MiB;
constexpr size_t WS_WGU = 60 * MiB;
constexpr size_t WS_WDN = 572 * MiB;
constexpr size_t WS_S = 828 * MiB;
constexpr size_t WS_XB = WS_S;
constexpr size_t WS_Z = WS_S + 64 * MiB;
constexpr size_t WS_ACK = WS_S + 256 * MiB;
constexpr size_t WS_ACV = WS_S + 272 * MiB;
constexpr size_t WS_WL = WS_S + 288 * MiB;
constexpr size_t WS_AL = WS_S + 296 * MiB;
constexpr size_t WS_GLS = WS_S + 304 * MiB;
constexpr size_t WS_DEC = WS_S + 312 * MiB;
constexpr size_t WS_ASIG = WS_S + 376 * MiB;
constexpr size_t WS_G = WS_S + 440 * MiB;
constexpr size_t WS_SC = WS_S + 504 * MiB;
constexpr size_t WS_Y = WS_S + 888 * MiB;
constexpr size_t WS_CAT = WS_S + 952 * MiB;
constexpr size_t WS_H1 = WS_S;
constexpr size_t WS_H1B = WS_S + 128 * MiB;
constexpr size_t WS_XG = WS_S + 160 * MiB;
constexpr size_t WS_HACT = WS_S + 304 * MiB;
constexpr size_t WS_EO = WS_S + 480 * MiB;
constexpr size_t WS_H2B = WS_S + 768 * MiB;
constexpr size_t WS_PL = WS_S + 832 * MiB;
constexpr size_t WS_END = WS_S + 1016 * MiB;
constexpr int CW_BAR = 4096;

constexpr int LDS_BYTES = 147456;
constexpr int LDS_MISC = 147456 - 128;
constexpr int CW_ATTNQ = 8192;

__device__ __forceinline__ unsigned f2bf(float f) { unsigned u = __float_as_uint(f); return (u + 0x7fffu + ((u >> 16) & 1u)) >> 16; }
typedef __bf16 bf2v_t __attribute__((ext_vector_type(2)));
typedef float f2v_t __attribute__((ext_vector_type(2)));
__device__ __forceinline__ unsigned pk2(float lo, float hi) { f2v_t v; v.x = lo; v.y = hi; return __builtin_bit_cast(unsigned, __builtin_convertvector(v, bf2v_t)); }
__device__ __forceinline__ float bf2f(unsigned h) { return __uint_as_float(h << 16); }
__device__ __forceinline__ float bflo(unsigned w) { return __uint_as_float(w << 16); }
__device__ __forceinline__ float bfhi(unsigned w) { return __uint_as_float(w & 0xffff0000u); }
__device__ __forceinline__ float wave_sum(float v) {
#pragma unroll
    for (int o = 1; o < 64; o <<= 1) v += __shfl_xor(v, o);
    return v;
}
__device__ __forceinline__ float wave_max(float v) {
#pragma unroll
    for (int o = 1; o < 64; o <<= 1) v = fmaxf(v, __shfl_xor(v, o));
    return v;
}
__device__ __forceinline__ unsigned pk_fp8x4(float a, float b, float c, float d) {
    a = __builtin_amdgcn_fmed3f(a, -448.f, 448.f); b = __builtin_amdgcn_fmed3f(b, -448.f, 448.f); c = __builtin_amdgcn_fmed3f(c, -448.f, 448.f); d = __builtin_amdgcn_fmed3f(d, -448.f, 448.f);
    int w = 0; w = __builtin_amdgcn_cvt_pk_fp8_f32(a, b, w, false); w = __builtin_amdgcn_cvt_pk_fp8_f32(c, d, w, true); return (unsigned)w; }
constexpr float FP8_SW = 64.0f, FP8_SA1 = 16.0f, FP8_SA2 = 4.0f;
constexpr int FP8_EW = 127 - 6, FP8_EA1 = 127 - 4, FP8_EA2 = 127 - 2;
__device__ __forceinline__ float sigmoidf_(float x) { return __builtin_amdgcn_rcpf(1.0f + __builtin_amdgcn_exp2f(-1.4426950408889634f * x)); }
__device__ __forceinline__ float gelu_tanh(float x) { const float u = 0.7978845608028654f * (x + 0.044715f * x * x * x); return x * sigmoidf_(2.0f * u); }

#define XB_TMO      128
#define XB_XCNT(j)  (256  + 64 * (j))
#define XB_XSUB(j)  (1280 + 64 * (j))
#define XB_XGEN(j)  (2304 + 64 * (j))
#define XB_TOP      3328
#define XB_TOPGEN   3392
#define XCD_BAR_WORDS 3456
#define XB_SPIN_CAP (1u << 22)
__device__ __forceinline__ unsigned xb_ld(unsigned* p)              { return __hip_atomic_load(p, __ATOMIC_RELAXED, __HIP_MEMORY_SCOPE_AGENT); }
__device__ __forceinline__ unsigned xb_add(unsigned* p, unsigned v) { return __hip_atomic_fetch_add(p, v, __ATOMIC_RELAXED, __HIP_MEMORY_SCOPE_AGENT); }
__device__ __forceinline__ unsigned xb_xcc_id() { return (unsigned)__builtin_amdgcn_s_getreg((3 << 11) | 20) & 0xFu; }
#define XB_SPIN(cond, bar) do { unsigned _sp = 0; while (cond) { __builtin_amdgcn_s_sleep(1); \
    if ((++_sp & 255u) == 0u) { if (xb_ld(&(bar)[XB_TMO])) break; if (_sp > XB_SPIN_CAP) { atomicAdd(&(bar)[XB_TMO], 1u); break; } } } } while (0)
struct XcdBarrier { unsigned* bar; unsigned x; volatile LAS unsigned* st; };
__device__ __forceinline__ XcdBarrier xcd_barrier_post(unsigned* bar, volatile LAS unsigned* st) {
    XcdBarrier b; b.bar = bar; b.x = xb_xcc_id(); b.st = st;
    if (threadIdx.x == 0) (void)xb_add(&bar[XB_XCNT(b.x)], 1u);
    return b;
}
__device__ __forceinline__ void xcd_barrier_complete(unsigned* bar, unsigned x, unsigned& nloc, unsigned& nx) {
    const unsigned G = gridDim.x * gridDim.y * gridDim.z;
    unsigned sum, cnt, mine, sp = 0u;
    for (;;) {
        sum = 0u; cnt = 0u; mine = 0u;
#pragma unroll
        for (unsigned j = 0; j < 16; ++j) { const unsigned c = xb_ld(&bar[XB_XCNT(j)]); sum += c; cnt += (c > 0u) ? 1u : 0u; mine = (j == x) ? c : mine; }
        if (sum == G) break;
        __builtin_amdgcn_s_sleep(1);
        if ((++sp & 255u) == 0u) { if (xb_ld(&bar[XB_TMO])) break; if (sp > XB_SPIN_CAP) { atomicAdd(&bar[XB_TMO], 1u); break; } }
    }
    nloc = mine > 0u ? mine : 1u; nx = cnt > 0u ? cnt : 1u;
}
__device__ __forceinline__ void xcd_barrier(const XcdBarrier& b) {
    asm volatile("s_waitcnt vmcnt(0)" ::: "memory");
    __syncthreads();
    if (threadIdx.x == 0) {
        unsigned* bar = b.bar;
        __builtin_amdgcn_s_waitcnt(0);
        unsigned nloc = b.st[0], nx = b.st[1];
        if (nloc == 0u) { xcd_barrier_complete(bar, b.x, nloc, nx); b.st[0] = nloc; b.st[1] = nx; }
        const unsigned old = xb_add(&bar[XB_XSUB(b.x)], 1u);
        const unsigned gen = old / nloc;
        if (old + 1u == (gen + 1u) * nloc) {
            __builtin_amdgcn_fence(__ATOMIC_RELEASE, "agent");
            asm volatile("s_waitcnt vmcnt(0)" ::: "memory");
            const unsigned og = xb_add(&bar[XB_TOP], 1u);
            const unsigned tg = og / nx;
            if (og + 1u == (tg + 1u) * nx) xb_add(&bar[XB_TOPGEN], 1u);
            else XB_SPIN(xb_ld(&bar[XB_TOPGEN]) == tg, bar);
            __builtin_amdgcn_fence(__ATOMIC_ACQUIRE, "agent");
            xb_add(&bar[XB_XGEN(b.x)], 1u);
            asm volatile("s_waitcnt vmcnt(0)" ::: "memory");
        } else {
            XB_SPIN(xb_ld(&bar[XB_XGEN(b.x)]) == gen, bar);
            __builtin_amdgcn_fence(__ATOMIC_ACQUIRE, "agent");
            asm volatile("s_waitcnt vmcnt(0)" ::: "memory");
        }
    }
    __syncthreads();
}

struct Args { const float* in[35]; float* out; unsigned char* ws; int ph_lo, ph_hi, li, pad; };
struct Frame {
    LAS unsigned char* lds;
    unsigned char* ws; float* out;
    int tid, lane, wave, bid, G;
};
enum { I_X = 0, I_P, I_WIN, I_PEK, I_W1K, I_W2K, I_PEV, I_W1V, I_W2V, I_MU, I_W0, I_WUP, I_A0, I_AUP, I_GUP, I_KK, I_KA, I_RK, I_LNG, I_LNB, I_WOUT,
       I_LN1G, I_LN1B, I_RW, I_RB, I_EWG, I_EBG, I_EWU, I_EBU, I_EWD, I_EBD, I_LN2G, I_LN2B, I_PLEW, I_PLEG };

struct GemmDesc {
    const bf16* A; int lda; const int* rowidx;
    const bf16* Bt; int ldb;
    int Mrows, N, K;
    const int* block_e; size_t bstride; const int* nblk;
    int ea, eb;
};
template <bool PAIR, class Epi>
__device__ __forceinline__ void ngemm_phase(Frame& F, const GemmDesc& g, const Epi& E) {
    LAS float* As = (LAS float*)F.lds;
    LAS float* Bs = As + 32 * 132;
    LAS float* Bu = Bs + 32 * 132;
    const int tid = F.tid, ty = tid >> 5, tx = tid & 31;
    const int lrow = tid >> 2, lkc = (tid & 3) * 8;
    const int ntm = g.Mrows / 128, ntn = PAIR ? g.N / 256 : g.N / 128;
    const int mlive = g.nblk ? (*g.nblk) * 256 : g.Mrows;
    for (int tile = F.bid; tile < ntm * ntn; tile += F.G) {
        const int tm = tile / ntn, tn = tile % ntn, m0 = tm * 128;
        if (m0 >= mlive) continue;
        const int e = g.block_e ? g.block_e[m0 >> 8] : 0;
        const bf16* Bt = g.Bt + (size_t)e * g.bstride;
        const int arow = g.rowidx ? g.rowidx[m0 + lrow] : (m0 + lrow);
        const bf16* ap = g.A + (size_t)arow * g.lda + lkc;
        const bf16* bp = Bt + (size_t)((PAIR ? tn * 256 : tn * 128) + lrow) * g.ldb + lkc;
        const bf16* bup = bp + (size_t)128 * g.ldb;
        f32x4 acc[8], accu[8];
#pragma unroll
        for (int i = 0; i < 8; ++i) { acc[i] = (f32x4){0.f, 0.f, 0.f, 0.f}; accu[i] = (f32x4){0.f, 0.f, 0.f, 0.f}; }
        for (int k0 = 0; k0 < g.K; k0 += 32) {
            const u32x4 av = *(const u32x4*)(ap + k0), bv = *(const u32x4*)(bp + k0);
            u32x4 uv = (u32x4){0u, 0u, 0u, 0u}; if (PAIR) uv = *(const u32x4*)(bup + k0);
            __syncthreads();
#pragma unroll
            for (int j = 0; j < 4; ++j) {
                As[(lkc + 2 * j) * 132 + lrow] = bflo(av[j]); As[(lkc + 2 * j + 1) * 132 + lrow] = bfhi(av[j]);
                Bs[(lkc + 2 * j) * 132 + lrow] = bflo(bv[j]); Bs[(lkc + 2 * j + 1) * 132 + lrow] = bfhi(bv[j]);
                if (PAIR) { Bu[(lkc + 2 * j) * 132 + lrow] = bflo(uv[j]); Bu[(lkc + 2 * j + 1) * 132 + lrow] = bfhi(uv[j]); }
            }
            __syncthreads();
#pragma unroll 4
            for (int k = 0; k < 32; ++k) {
                const f32x4 a0 = *(const LAS f32x4*)(As + k * 132 + ty * 8), a1 = *(const LAS f32x4*)(As + k * 132 + ty * 8 + 4);
                const f32x4 b = *(const LAS f32x4*)(Bs + k * 132 + tx * 4);
                acc[0] += a0.x * b; acc[1] += a0.y * b; acc[2] += a0.z * b; acc[3] += a0.w * b;
                acc[4] += a1.x * b; acc[5] += a1.y * b; acc[6] += a1.z * b; acc[7] += a1.w * b;
                if (PAIR) { const f32x4 u = *(const LAS f32x4*)(Bu + k * 132 + tx * 4);
                    accu[0] += a0.x * u; accu[1] += a0.y * u; accu[2] += a0.z * u; accu[3] += a0.w * u;
                    accu[4] += a1.x * u; accu[5] += a1.y * u; accu[6] += a1.z * u; accu[7] += a1.w * u; }
            }
        }
        const int col = (PAIR ? tn * 128 : tn * 128) + tx * 4;
#pragma unroll
        for (int i = 0; i < 8; ++i) { const int row = m0 + ty * 8 + i;
            if constexpr (PAIR) E.stp(row, col, acc[i], accu[i], e); else E.st(row, col, acc[i], e); }
    }
    __syncthreads();
}

__device__ __forceinline__ void st_bf16x4(bf16* p, f32x4 v) { u32x2 w; w.x = pk2(v.x, v.y); w.y = pk2(v.z, v.w); *(u32x2*)p = w; }
__device__ __forceinline__ void st_bf16x8(bf16* p, f32x4 a, f32x4 b) { u32x4 w; w.x = pk2(a.x, a.y); w.y = pk2(a.z, a.w); w.z = pk2(b.x, b.y); w.w = pk2(b.z, b.w); *(u32x4*)p = w; }
struct EpiZ { static constexpr bool PERM = true; bf16* Z; __device__ __forceinline__ void st(int r, int c, f32x4 v, int) const { st_bf16x4(Z + (size_t)r * NZ + c, v); }
    __device__ __forceinline__ void st8(int r, int c, f32x4 a, f32x4 b, int) const { st_bf16x8(Z + (size_t)r * NZ + c, a, b); } };
struct EpiCmp { float* H; __device__ __forceinline__ void st(int r, int c, f32x4 v, int) const { if (c < 64) { f32x4 o; o.x = gelu_tanh(v.x); o.y = gelu_tanh(v.y); o.z = gelu_tanh(v.z); o.w = gelu_tanh(v.w); *(f32x4*)(H + (size_t)r * 64 + c) = o; } } };
struct EpiDecay { float* O; const float* w0;
    __device__ __forceinline__ float f(float x) const { const float y = -x; const float sp = fmaxf(y, 0.f) + __logf(1.0f + __expf(-fabsf(y))); return __expf(-__expf(-sp - 0.5f)); }
    __device__ __forceinline__ void st(int r, int c, f32x4 v, int) const { const f32x4 b = *(const f32x4*)(w0 + c); f32x4 o; o.x = f(v.x + b.x); o.y = f(v.y + b.y); o.z = f(v.z + b.z); o.w = f(v.w + b.w); *(f32x4*)(O + (size_t)r * 1024 + c) = o; } };
struct EpiASig { float* O; const float* a0;
    __device__ __forceinline__ void st(int r, int c, f32x4 v, int) const { const f32x4 b = *(const f32x4*)(a0 + c); f32x4 o; o.x = sigmoidf_(v.x + b.x); o.y = sigmoidf_(v.y + b.y); o.z = sigmoidf_(v.z + b.z); o.w = sigmoidf_(v.w + b.w); *(f32x4*)(O + (size_t)r * 1024 + c) = o; } };
struct EpiF32 { float* O; int ld; __device__ __forceinline__ void st(int r, int c, f32x4 v, int) const { *(f32x4*)(O + (size_t)r * ld + c) = v; } };
struct EpiPre1 { float* O; const float* x; __device__ __forceinline__ void st(int r, int c, f32x4 v, int) const { const f32x4 xv = *(const f32x4*)(x + (size_t)r * D + c); *(f32x4*)(O + (size_t)r * D + c) = ALPHA * xv + v; } };
struct EpiSwiglu { static constexpr bool PERM = true; unsigned char* H; const float* bg; const float* bu;
    __device__ __forceinline__ float f(float g, float u) const { g = fminf(g, 7.0f); u = fminf(fmaxf(u, -7.0f), 7.0f); return g * sigmoidf_(1.702f * g) * (u + 1.0f); }
    __device__ __forceinline__ void stp(int r, int c, f32x4 g, f32x4 u, int e) const { const f32x4 b0 = *(const f32x4*)(bg + (size_t)e * D + c), b1 = *(const f32x4*)(bu + (size_t)e * D + c);
        f32x4 o; o.x = f(g.x + b0.x, u.x + b1.x); o.y = f(g.y + b0.y, u.y + b1.y); o.z = f(g.z + b0.z, u.z + b1.z); o.w = f(g.w + b0.w, u.w + b1.w); *(unsigned*)(H + (size_t)r * D + c) = pk_fp8x4(o.x * FP8_SA2, o.y * FP8_SA2, o.z * FP8_SA2, o.w * FP8_SA2); }
    __device__ __forceinline__ unsigned q4(int c, f32x4 g, f32x4 u, int e) const { const f32x4 b0 = *(const f32x4*)(bg + (size_t)e * D + c), b1 = *(const f32x4*)(bu + (size_t)e * D + c);
        return pk_fp8x4(f(g.x + b0.x, u.x + b1.x) * FP8_SA2, f(g.y + b0.y, u.y + b1.y) * FP8_SA2, f(g.z + b0.z, u.z + b1.z) * FP8_SA2, f(g.w + b0.w, u.w + b1.w) * FP8_SA2); }
    __device__ __forceinline__ void stp8(int r, int c, f32x4 g0, f32x4 g1, f32x4 u0, f32x4 u1, int e) const { u32x2 w; w.x = q4(c, g0, u0, e); w.y = q4(c + 4, g1, u1, e); *(u32x2*)(H + (size_t)r * D + c) = w; } };
struct EpiDown { static constexpr bool PERM = true; bf16* O; const float* bd; __device__ __forceinline__ void st(int r, int c, f32x4 v, int e) const { const f32x4 b = *(const f32x4*)(bd + (size_t)e * D + c); st_bf16x4(O + (size_t)r * D + c, v + b); }
    __device__ __forceinline__ void st8(int r, int c, f32x4 a, f32x4 b, int e) const { const f32x4 b0 = *(const f32x4*)(bd + (size_t)e * D + c), b1 = *(const f32x4*)(bd + (size_t)e * D + c + 4); st_bf16x8(O + (size_t)r * D + c, a + b0, b + b1); } };
struct EpiBf16 { static constexpr bool PERM = true; bf16* O; int ld; __device__ __forceinline__ void st(int r, int c, f32x4 v, int) const { st_bf16x4(O + (size_t)r * ld + c, v); }
    __device__ __forceinline__ void st8(int r, int c, f32x4 a, f32x4 b, int) const { st_bf16x8(O + (size_t)r * ld + c, a, b); } };
struct EpiFinal { float* out; const bf16* PL;
    __device__ __forceinline__ void st(int r, int c, f32x4 v, int) const { const size_t o = (size_t)r * D + c; const f32x4 h = *(const f32x4*)(out + o); const u32x2 pw = *(const u32x2*)(PL + o);
        f32x4 q; q.x = h.x + sigmoidf_(v.x) * bflo(pw.x); q.y = h.y + sigmoidf_(v.y) * bfhi(pw.x); q.z = h.z + sigmoidf_(v.z) * bflo(pw.y); q.w = h.w + sigmoidf_(v.w) * bfhi(pw.y); *(f32x4*)(out + o) = q; } };


namespace pg8 {
typedef short bf16x8 __attribute__((ext_vector_type(8)));
constexpr int BM = 256, BK = 64, HALF = 128, HTB = HALF * BK * 2, STAGE_BYTES = 8 * HTB, NXCD = 8, WGM = 8;
__device__ __forceinline__ int lds_byte(int r, int c) { const int st = (r >> 4) * 2 + (c >> 5), rr = r & 15, cc = c & 31, ob = rr * 64 + cc * 2; return st * 1024 + (ob ^ (((ob >> 9) & 1) << 5)); }
__device__ __forceinline__ void stage_rc(int b, int& R, int& C) { const int st = b / 1024, sb = b % 1024, swz = sb ^ (((sb >> 9) & 1) << 5); R = (st >> 1) * 16 + swz / 64; C = (st & 1) * 32 + (swz % 64) / 2; }
struct Unit { int pm, pn; };
struct StaticOrder {
    int nM, nN, nwg, G, c;
    __device__ void init(int nM_, int nN_, int G_, int c_) { nM = nM_; nN = nN_; nwg = nM * nN; G = G_; c = c_; }
    __device__ bool next(int i, Unit& u) const {
        const long L = (long)i * G + c; if (L >= nwg) return false;
        int wgid = (int)L; { const int q = nwg / NXCD, r = nwg % NXCD, xcd = wgid % NXCD, off = wgid / NXCD; wgid = (xcd < r ? xcd * (q + 1) : r * (q + 1) + (xcd - r) * q) + off; }
        const int nig = WGM * nN, gid = wgid / nig, fm = gid * WGM, gsz = (nM - fm) < WGM ? (nM - fm) : WGM;
        u.pm = fm + ((wgid % nig) % gsz); u.pn = (wgid % nig) / gsz; return true;
    }
};
template <class E, class = void> struct epi_perm { static constexpr bool value = false; };
template <class E> struct epi_perm<E, decltype((void)E::PERM)> { static constexpr bool value = E::PERM; };
__device__ __forceinline__ int perm32(int rho) { const int n = rho >> 4, i = rho & 15; return 8 * (i >> 2) + 4 * n + (i & 3); }
template <bool PAIR, class Epi>
__device__ __forceinline__ void epilogue(const f32x4 (&acc)[2][2][4][2], const Unit& u, int e, const Epi& E, int wr, int wc, int fr, int fq) {
    const int row0 = u.pm * BM + wr * 64 + fr;
#pragma unroll
    for (int ai = 0; ai < 2; ++ai)
#pragma unroll
        for (int m = 0; m < 4; ++m) { const int row = row0 + ai * HALF + m * 16;
            if constexpr (PAIR) {
                if constexpr (epi_perm<Epi>::value) E.stp8(row, u.pn * HALF + wc * 32 + 8 * fq, acc[ai][0][m][0], acc[ai][0][m][1], acc[ai][1][m][0], acc[ai][1][m][1], e);
                else {
#pragma unroll
                    for (int n = 0; n < 2; ++n) E.stp(row, u.pn * HALF + wc * 32 + n * 16 + 4 * fq, acc[ai][0][m][n], acc[ai][1][m][n], e); }
            } else if constexpr (epi_perm<Epi>::value) {
#pragma unroll
                for (int bj = 0; bj < 2; ++bj) E.st8(row, u.pn * BM + bj * HALF + wc * 32 + 8 * fq, acc[ai][bj][m][0], acc[ai][bj][m][1], e);
            } else {
#pragma unroll
                for (int bj = 0; bj < 2; ++bj)
#pragma unroll
                    for (int n = 0; n < 2; ++n) E.st(row, u.pn * BM + bj * HALF + wc * 32 + n * 16 + 4 * fq, acc[ai][bj][m][n], e);
            } }
}
typedef int i32x8 __attribute__((ext_vector_type(8)));
__device__ __forceinline__ i32x8 cat8(const bf16x8& lo, const bf16x8& hi) { const u32x4 a = __builtin_bit_cast(u32x4, lo), b = __builtin_bit_cast(u32x4, hi); i32x8 r; r[0] = (int)a.x; r[1] = (int)a.y; r[2] = (int)a.z; r[3] = (int)a.w; r[4] = (int)b.x; r[5] = (int)b.y; r[6] = (int)b.z; r[7] = (int)b.w; return r; }
template <bool PAIR, bool FP8, class Epi>
__device__ __forceinline__ void gemm_phase(LAS unsigned char* lds, const GemmDesc& g, const Epi& E, int G, int cid) {
    const int tid = threadIdx.x, wid = __builtin_amdgcn_readfirstlane(tid >> 6), lane = tid & 63, wr = wid >> 2, wc = wid & 3, fr = lane & 15, fq = lane >> 4;
    const unsigned pitchB = FP8 ? (unsigned)g.K : (unsigned)g.K * 2u;
    const int nt = (int)(pitchB / 128u);
    const int sc_a = g.ea, sc_b = g.eb;
    StaticOrder S; S.init(g.nblk ? *g.nblk : g.Mrows / BM, g.N / BM, G, cid);
    unsigned voffA[2], voffB[2];
#pragma unroll
    for (int i = 0; i < 2; ++i) { int R, C; stage_rc(tid * 16 + i * 8192, R, C); const int Rb = epi_perm<Epi>::value ? ((R & ~31) + perm32(R & 31)) : R;
        voffA[i] = (unsigned)R * pitchB + (unsigned)C * 2u; voffB[i] = (unsigned)Rb * pitchB + (unsigned)C * 2u; }
    const size_t kstep = (size_t)(BK * 2);
    const size_t hstep = (size_t)HALF * pitchB;
    const size_t tstep = 2 * hstep;
    const unsigned ldsw = (unsigned)wid * 1024u;
    const int aoff = lds_byte(wr * 64 + fr, fq * 8), boff = lds_byte(wc * 32 + fr, fq * 8);
    const char* gA = (const char*)g.A;
#define PG8_SA(b, h) (((b) * 2 + (h)) * HTB)
#define PG8_SB(b, h) ((4 + (b) * 2 + (h)) * HTB)
#define PG8_STAGE(bufoff, gbase, voff) do { _Pragma("unroll") for (int _i = 0; _i < 2; ++_i) \
        __builtin_amdgcn_global_load_lds((const unsigned*)((const char*)(gbase) + (voff)[_i]), (LAS unsigned*)(lds + (bufoff) + ldsw + _i * 8192), 16, 0, 0); } while (0)
#define PG8_LD8(dst, off) do { const u32x4 lo_ = *(const LAS u32x4*)(lds + (off)), hi_ = *(const LAS u32x4*)(lds + (off) + 1024); \
        dst[0] = (int)lo_.x; dst[1] = (int)lo_.y; dst[2] = (int)lo_.z; dst[3] = (int)lo_.w; dst[4] = (int)hi_.x; dst[5] = (int)hi_.y; dst[6] = (int)hi_.z; dst[7] = (int)hi_.w; } while (0)
#define PG8_LDA(dst, b, h) do { _Pragma("unroll") for (int m = 0; m < 4; ++m) { if constexpr (FP8) PG8_LD8(dst##8[m], PG8_SA(b, h) + aoff + m * 2048); else { _Pragma("unroll") for (int k = 0; k < 2; ++k) dst[m][k] = *(const LAS bf16x8*)(lds + PG8_SA(b, h) + aoff + m * 2048 + k * 1024); } } } while (0)
#define PG8_LDB(dst, b, h) do { _Pragma("unroll") for (int n = 0; n < 2; ++n) { if constexpr (FP8) PG8_LD8(dst##8[n], PG8_SB(b, h) + boff + n * 2048); else { _Pragma("unroll") for (int k = 0; k < 2; ++k) dst[n][k] = *(const LAS bf16x8*)(lds + PG8_SB(b, h) + boff + n * 2048 + k * 1024); } } } while (0)
#define PG8_MMA(ai, bj, At, Bt) do { __builtin_amdgcn_s_setprio(1); _Pragma("unroll") for (int m = 0; m < 4; ++m) _Pragma("unroll") for (int n = 0; n < 2; ++n) { \
        if constexpr (FP8) asm volatile("v_mfma_scale_f32_16x16x128_f8f6f4 %0, %1, %2, %0, %3, %4 op_sel_hi:[0,0,0]" : "+v"(acc[ai][bj][m][n]) : "v"(Bt##8[n]), "v"(At##8[m]), "v"(sc_b), "v"(sc_a));   \
        else { _Pragma("unroll") for (int k = 0; k < 2; ++k) acc[ai][bj][m][n] = __builtin_amdgcn_mfma_f32_16x16x32_bf16(Bt[n][k], At[m][k], acc[ai][bj][m][n], 0, 0, 0); } } __builtin_amdgcn_s_setprio(0); } while (0)
#define PG8_WAIT_V(n) asm volatile("s_waitcnt vmcnt(" #n ")" ::: "memory")
#define PG8_WAIT_L(n) asm volatile("s_waitcnt lgkmcnt(" #n ")" ::: "memory")
#define PG8_BAR __builtin_amdgcn_s_barrier()
#define PG8_SCHED __builtin_amdgcn_sched_barrier(0)
    Unit cur, nxt; int ui = 0;
    if (!S.next(0, cur)) return;
    f32x4 acc[2][2][4][2];
#pragma unroll
    for (int a = 0; a < 2; ++a)
#pragma unroll
        for (int b = 0; b < 2; ++b)
#pragma unroll
            for (int m = 0; m < 4; ++m)
#pragma unroll
                for (int n = 0; n < 2; ++n) acc[a][b][m][n] = (f32x4){0.f, 0.f, 0.f, 0.f};
    bf16x8 At[4][2], B0[2][2], B1[2][2];
    i32x8 At8[4], B08[2], B18[2];
    int ecur = g.block_e ? g.block_e[cur.pm] : 0;
    const char* cA = gA + (size_t)cur.pm * tstep;
    const char* cB = (const char*)g.Bt + (size_t)ecur * g.bstride * (FP8 ? 1 : 2) + (size_t)cur.pn * tstep;
    PG8_STAGE(PG8_SB(0, 0), cB, voffB); PG8_STAGE(PG8_SB(0, 1), cB + hstep, voffB); PG8_STAGE(PG8_SA(0, 0), cA, voffA); PG8_STAGE(PG8_SA(0, 1), cA + hstep, voffA);
    if (wr == 1) PG8_BAR;
    PG8_WAIT_V(2); PG8_BAR;
    PG8_STAGE(PG8_SB(1, 0), cB + kstep, voffB); PG8_STAGE(PG8_SA(1, 0), cA + kstep, voffA); PG8_STAGE(PG8_SB(1, 1), cB + hstep + kstep, voffB);
    PG8_WAIT_V(6); PG8_BAR;
    for (;;) {
        const bool has_next = S.next(ui + 1, nxt);
        int enxt = ecur; const char* nB = cB; const char* nA = cA;
        if (has_next) { enxt = g.block_e ? g.block_e[nxt.pm] : 0; nA = gA + (size_t)nxt.pm * tstep; nB = (const char*)g.Bt + (size_t)enxt * g.bstride * (FP8 ? 1 : 2) + (size_t)nxt.pn * tstep; }
        for (int t = 0; t < nt; t += 2) {
            const bool last = (t == nt - 2);
            const char* a1 = cA + (size_t)(t + 1) * kstep;
            const char* a2 = last ? nA : cA + (size_t)(t + 2) * kstep; const char* b2 = last ? nB : cB + (size_t)(t + 2) * kstep;
            const char* a3 = a2 + kstep; const char* b3 = b2 + kstep;
            PG8_LDB(B0, 0, 0); PG8_LDB(B1, 0, 1); PG8_SCHED; PG8_LDA(At, 0, 0); PG8_STAGE(PG8_SA(1, 1), a1 + hstep, voffA);
            PG8_WAIT_V(8); PG8_WAIT_L(0); PG8_BAR; PG8_MMA(0, 0, At, B0); PG8_MMA(0, 1, At, B1); PG8_BAR; PG8_SCHED;
            PG8_LDA(At, 0, 1); PG8_STAGE(PG8_SB(0, 0), b2, voffB); PG8_STAGE(PG8_SB(0, 1), b2 + hstep, voffB); PG8_STAGE(PG8_SA(0, 0), a2, voffA);
            PG8_WAIT_V(8); PG8_WAIT_L(0); PG8_BAR; PG8_MMA(1, 0, At, B0); PG8_MMA(1, 1, At, B1); PG8_BAR; PG8_SCHED;
            PG8_LDB(B0, 1, 0); PG8_LDB(B1, 1, 1); PG8_SCHED; PG8_LDA(At, 1, 0); PG8_STAGE(PG8_SA(0, 1), a2 + hstep, voffA);
            PG8_WAIT_V(8); PG8_WAIT_L(0); PG8_BAR; PG8_MMA(0, 0, At, B0); PG8_MMA(0, 1, At, B1); PG8_BAR; PG8_SCHED;
            PG8_LDA(At, 1, 1); PG8_STAGE(PG8_SB(1, 0), b3, voffB); PG8_STAGE(PG8_SB(1, 1), b3 + hstep, voffB); PG8_STAGE(PG8_SA(1, 0), a3, voffA);
            PG8_WAIT_V(8); PG8_WAIT_L(0); PG8_BAR; PG8_MMA(1, 0, At, B0); PG8_MMA(1, 1, At, B1); PG8_BAR; PG8_SCHED;
        }
        if constexpr (FP8) asm volatile("s_nop 15\n\ts_nop 15" ::: "memory");
        if (wr == 0) PG8_BAR;
        epilogue<PAIR, Epi>(acc, cur, ecur, E, wr, wc, fr, fq);
        if (!has_next) break;
#pragma unroll
        for (int a = 0; a < 2; ++a)
#pragma unroll
            for (int b = 0; b < 2; ++b)
#pragma unroll
                for (int m = 0; m < 4; ++m)
#pragma unroll
                    for (int n = 0; n < 2; ++n) acc[a][b][m][n] = (f32x4){0.f, 0.f, 0.f, 0.f};
        cur = nxt; cA = nA; cB = nB; ecur = enxt; ++ui;
        if (wr == 1) PG8_BAR;
    }
    PG8_WAIT_V(0);
    PG8_BAR;
#undef PG8_SA
#undef PG8_SB
#undef PG8_STAGE
#undef PG8_LDA
#undef PG8_LD8
#undef PG8_LDB
#undef PG8_MMA
#undef PG8_WAIT_V
#undef PG8_WAIT_L
#undef PG8_BAR
#undef PG8_SCHED
}
}

#ifndef NAIVE_GEMM
#define NAIVE_GEMM 0
#endif
template <class Epi> __device__ __forceinline__ void gemm_run_part(Frame& F, const GemmDesc& g, const Epi& E, int G, int cid) {
    pg8::gemm_phase<false, false, Epi>(F.lds, g, E, G, cid);
    __syncthreads();
}
template <bool PAIR, class Epi, bool FP8 = false> __device__ __forceinline__ void gemm_run(Frame& F, const GemmDesc& g, const Epi& E) {
#if NAIVE_GEMM
    static_assert(!FP8, "the naive GEMM has no fp8 path");
    ngemm_phase<PAIR, Epi>(F, g, E);
#else
    pg8::gemm_phase<PAIR, FP8, Epi>(F.lds, g, E, F.G, F.bid);
    __syncthreads();
#endif
}

__device__ __forceinline__ void transpose_item(const float* W, int K, int N, bf16* WT, int Kp, size_t row0, int k0, int n0, LAS float* scr, int lane) {
    const int n = n0 + (lane & 31);
#pragma unroll 8
    for (int i = 0; i < 32; ++i) { const int kk = 2 * i + (lane >> 5), k = k0 + kk; scr[kk * 33 + (lane & 31)] = (k < K && n < N) ? W[(size_t)k * N + n] : 0.f; }
    LDS_WAIT(); asm volatile("" ::: "memory");
    const int c = lane & 7;
#pragma unroll
    for (int j = 0; j < 4; ++j) { const int nn = (lane >> 3) + 8 * j; const LAS float* s = scr + (8 * c) * 33 + nn;
        u32x4 o; o.x = pk2(s[0 * 33], s[1 * 33]); o.y = pk2(s[2 * 33], s[3 * 33]); o.z = pk2(s[4 * 33], s[5 * 33]); o.w = pk2(s[6 * 33], s[7 * 33]);
        *(u32x4*)(WT + (row0 + nn) * Kp + k0 + 8 * c) = o; }
    LDS_WAIT(); asm volatile("" ::: "memory");
}
__device__ __forceinline__ void p0_prologue(Frame& F, const Args& a) {
    LAS float* scr = (LAS float*)(F.lds + F.wave * 16384);
    unsigned char* ws = F.ws;
    const int gw = F.bid * 8 + F.wave, NGW = F.G * 8;
    constexpr int I0 = 32 * 192, I1 = 32 * 64, I2 = 32 * 64, I3 = 4 * 64, I4 = 4 * 32, I5 = 4 * 32, I6 = 4 * 32, I7 = 32 * 8, I8 = 32 * 8, IE = 32 * 64;
    constexpr int NSIMPLE = I0 + I1 + I2 + I3 + I4 + I5 + I6 + I7 + I8;
    constexpr int NITEMS = NSIMPLE; (void)IE;
    for (int it = gw; it < NITEMS; it += NGW) {
        int r = it;
#define TR_SIMPLE(cnt, W, K, N, WT, Kp, nblk) if (r < (cnt)) { const int kb = r / (nblk), nb = r % (nblk); transpose_item((W), (K), (N), (bf16*)(WT), (Kp), (size_t)(32 * nb), 64 * kb, 32 * nb, scr, F.lane); continue; } r -= (cnt);
        TR_SIMPLE(I0, a.in[I_WIN], 2048, INC, ws + WS_WIN, 2048, 192)
        TR_SIMPLE(I1, a.in[I_WOUT], 2048, 2048, ws + WS_WOUT, 2048, 64)
        TR_SIMPLE(I2, a.in[I_PLEG], 2048, 2048, ws + WS_WPG, 2048, 64)
        TR_SIMPLE(I3, a.in[I_PLEW], 256, 2048, ws + WS_WPL, 256, 64)
        TR_SIMPLE(I4, a.in[I_WUP], 96, 1024, ws + WS_WUP, 256, 32)
        TR_SIMPLE(I5, a.in[I_AUP], 96, 1024, ws + WS_AUP, 256, 32)
        TR_SIMPLE(I6, a.in[I_GUP], 256, 1024, ws + WS_GUP, 256, 32)
        TR_SIMPLE(I7, a.in[I_W1K], 2048, 64, ws + WS_CW1K, 2048, 8)
        TR_SIMPLE(I8, a.in[I_W1V], 2048, 64, ws + WS_CW1V, 2048, 8)
#undef TR_SIMPLE
        (void)r;
    }
    const size_t gt = (size_t)F.bid * 512 + F.tid, NT = (size_t)F.G * 512;
    { const float* x = a.in[I_X]; bf16* xb = (bf16*)(ws + WS_XB);
      for (size_t i = gt; i < (size_t)M * D / 8; i += NT) { const f32x4 v0 = *(const f32x4*)(x + i * 8), v1 = *(const f32x4*)(x + i * 8 + 4);
          u32x4 o; o.x = pk2(v0.x, v0.y); o.y = pk2(v0.z, v0.w); o.z = pk2(v1.x, v1.y); o.w = pk2(v1.z, v1.w); *(u32x4*)(xb + i * 8) = o; } }
    { const float* p = a.in[I_P]; bf16* pb = (bf16*)(ws + WS_PB);
      for (size_t i = gt; i < (size_t)M * 256 / 8; i += NT) { const f32x4 v0 = *(const f32x4*)(p + i * 8), v1 = *(const f32x4*)(p + i * 8 + 4);
          u32x4 o; o.x = pk2(v0.x, v0.y); o.y = pk2(v0.z, v0.w); o.z = pk2(v1.x, v1.y); o.w = pk2(v1.z, v1.w); *(u32x4*)(pb + i * 8) = o; } }
    { int* rt = (int*)(ws + WS_ROWTOK); for (size_t i = gt; i < (size_t)MAXROWS; i += NT) rt[i] = 0; }
    { const float* rw = a.in[I_RW]; bf16* rwt = (bf16*)(ws + WS_RWT);
      for (size_t i = gt; i < (size_t)32 * D; i += NT) { const int e = (int)(i >> 11), k = (int)(i & 2047); const float w = rw[(size_t)k * 32 + e]; const unsigned hi = f2bf(w); rwt[i] = (bf16)hi; rwt[(size_t)32 * D + i] = (bf16)f2bf(w - bf2f(hi)); } }
}

__device__ __forceinline__ void unpack8(const u32x4 w, float (&f)[8]) { f[0] = bflo(w.x); f[1] = bfhi(w.x); f[2] = bflo(w.y); f[3] = bfhi(w.y); f[4] = bflo(w.z); f[5] = bfhi(w.z); f[6] = bflo(w.w); f[7] = bfhi(w.w); }
__device__ __forceinline__ u32x4 pack8(const float (&f)[8]) { u32x4 o; o.x = pk2(f[0], f[1]); o.y = pk2(f[2], f[3]); o.z = pk2(f[4], f[5]); o.w = pk2(f[6], f[7]); return o; }
__device__ __forceinline__ void ld8f(const float* p, float (&f)[8]) { const f32x4 a = *(const f32x4*)p, b = *(const f32x4*)(p + 4); f[0] = a.x; f[1] = a.y; f[2] = a.z; f[3] = a.w; f[4] = b.x; f[5] = b.y; f[6] = b.z; f[7] = b.w; }
__device__ __forceinline__ void st8f(float* p, const float (&f)[8]) { *(f32x4*)p = (f32x4){f[0], f[1], f[2], f[3]}; *(f32x4*)(p + 4) = (f32x4){f[4], f[5], f[6], f[7]}; }
__device__ __forceinline__ float dpp_sum8(float x) {
    x += __builtin_bit_cast(float, __builtin_amdgcn_update_dpp(0, __builtin_bit_cast(int, x), 0xB1, 0xF, 0xF, true));
    x += __builtin_bit_cast(float, __builtin_amdgcn_update_dpp(0, __builtin_bit_cast(int, x), 0x4E, 0xF, 0xF, true));
    x += __builtin_bit_cast(float, __builtin_amdgcn_update_dpp(0, __builtin_bit_cast(int, x), 0x141, 0xF, 0xF, true));
    return x;
}
__device__ __forceinline__ void shift8(const bf16* Z, size_t zo, int c, bool has_prev, const float* mu, float (&o)[8]) {
    float zc[8], zp[8], m8[8];
    unpack8(*(const u32x4*)(Z + zo + c), zc);
    if (has_prev) unpack8(*(const u32x4*)(Z + zo - NZ + c), zp); else {
#pragma unroll
        for (int i = 0; i < 8; ++i) zp[i] = 0.f; }
    ld8f(mu + (c - ZRW), m8);
#pragma unroll
    for (int i = 0; i < 8; ++i) o[i] = zc[i] + (zp[i] - zc[i]) * m8[i];
}

__device__ __forceinline__ void p2_prep(Frame& F, const Args& a) {
    unsigned char* ws = F.ws;
    const bf16* Z = (const bf16*)(ws + WS_Z);
    const int gw = F.bid * 8 + F.wave, NGW = F.G * 8, lane = F.lane;
    for (int it = gw; it < 2 * 4096; it += NGW) {
        const int kv = it >> 12, row = it & 4095, g = row & 3, c = (row >> 2) & 255, b = row >> 10;
        bf16* dst = (bf16*)(ws + (kv ? WS_ACV : WS_ACK)) + (size_t)row * 2048;
        const float* pe = a.in[kv ? I_PEV : I_PEK];
        const int col0 = (kv ? ZVC : ZKC) + g * 64;
#pragma unroll
        for (int q = 0; q < 4; ++q) {
            const int idx = q * 64 + lane, i = idx >> 3, d8 = (idx & 7) * 8;
            u32x4 o = (u32x4){0u, 0u, 0u, 0u};
            if (c < NCMP) { float z8[8], p8[8]; unpack8(*(const u32x4*)(Z + (size_t)(b * T + 16 * c + i) * NZ + col0 + d8), z8); ld8f(pe + i * 64 + d8, p8);
#pragma unroll
                for (int e = 0; e < 8; ++e) z8[e] += p8[e];
                o = pack8(z8); }
            *(u32x4*)(dst + i * 64 + d8) = o;
        }
    }
    const float* mu = a.in[I_MU];
    bf16* WL = (bf16*)(ws + WS_WL); bf16* AL = (bf16*)(ws + WS_AL); bf16* GLS = (bf16*)(ws + WS_GLS);
    for (int m = gw; m < M; m += NGW) {
        const int t = m & (T - 1);
        float zs[8];
#pragma unroll
        for (int e = 0; e < 8; ++e) zs[e] = 0.f;
        if (lane < 56) shift8(Z, (size_t)m * NZ, ZWL + lane * 8, t != 0, mu, zs);
        if (lane < 32) { float o[8];
#pragma unroll
            for (int e = 0; e < 8; ++e) o[e] = lane < 12 ? tanhf(zs[e]) : 0.f;
            *(u32x4*)(WL + (size_t)m * 256 + lane * 8) = pack8(o); }
        if (lane >= 12 && lane < 44) { float o[8];
#pragma unroll
            for (int e = 0; e < 8; ++e) o[e] = lane < 24 ? zs[e] : 0.f;
            *(u32x4*)(AL + (size_t)m * 256 + (lane - 12) * 8) = pack8(o); }
        if (lane >= 24 && lane < 56) { float o[8];
#pragma unroll
            for (int e = 0; e < 8; ++e) o[e] = sigmoidf_(zs[e]);
            *(u32x4*)(GLS + (size_t)m * 256 + (lane - 24) * 8) = pack8(o); }
    }
}

__device__ __forceinline__ void p4_prep(Frame& F, const Args& a) {
    unsigned char* ws = F.ws;
    const int gw = F.bid * 8 + F.wave, NGW = F.G * 8, lane = F.lane;
    for (int it = gw; it < 2 * 4096; it += NGW) {
        const int kv = it >> 12, row = it & 4095;
        const float* H = (const float*)(ws + (kv ? WS_HCMPV : WS_HCMPK)) + (size_t)row * 64;
        const float* w2 = a.in[kv ? I_W2V : I_W2K];
        const float hv = H[lane]; float o = 0.f;
#pragma unroll 8
        for (int j = 0; j < 64; ++j) o += __shfl(hv, j) * w2[j * 64 + lane];
        ((bf16*)(ws + (kv ? WS_VCMP : WS_KCMP)))[(size_t)row * 64 + lane] = (bf16)f2bf(o);
    }
    const bf16* Z = (const bf16*)(ws + WS_Z);
    const float* mu = a.in[I_MU]; const float* DEC = (const float*)(ws + WS_DEC); const float* ASIG = (const float*)(ws + WS_ASIG);
    const float* kk_w = a.in[I_KK]; const float* ka_w = a.in[I_KA];
    float* SC = (float*)(ws + WS_SC);
    for (int it = gw; it < M * 2; it += NGW) {
        const int m = it >> 1, half = it & 1, t = m & (T - 1), b = m >> 12, col = (half * 64 + lane) * 8, h = col >> 6, j8 = col & 63;
        const size_t zo = (size_t)m * NZ;
        float r[8], k[8], v[8], av[8], w[8], kkw[8], kaw[8];
        shift8(Z, zo, ZR + col, t != 0, mu, r); shift8(Z, zo, ZK + col, t != 0, mu, k); shift8(Z, zo, ZV + col, t != 0, mu, v);
        ld8f(ASIG + (size_t)m * 1024 + col, av); ld8f(DEC + (size_t)m * 1024 + col, w); ld8f(kk_w + col, kkw); ld8f(ka_w + col, kaw);
        float kk[8], ss = 0.f;
#pragma unroll
        for (int e = 0; e < 8; ++e) { kk[e] = k[e] * kkw[e]; ss += kk[e] * kk[e]; }
        const float inv = 1.0f / fmaxf(sqrtf(dpp_sum8(ss)), 1e-12f);
        float k2[8], na[8], bb[8];
#pragma unroll
        for (int e = 0; e < 8; ++e) { kk[e] *= inv; k2[e] = k[e] * (1.0f + (av[e] - 1.0f) * kaw[e]); na[e] = -kk[e]; bb[e] = kk[e] * av[e]; }
        float* sc = SC + ((size_t)(b * 16 + h) * T + t) * 384 + j8;
        st8f(sc, r); st8f(sc + 64, w); st8f(sc + 128, k2); st8f(sc + 192, v); st8f(sc + 256, na); st8f(sc + 320, bb);
    }
}

__device__ __forceinline__ float dpp_sum16(float x) {
    x += __builtin_bit_cast(float, __builtin_amdgcn_update_dpp(0, __builtin_bit_cast(int, x), 0xB1, 0xF, 0xF, true));
    x += __builtin_bit_cast(float, __builtin_amdgcn_update_dpp(0, __builtin_bit_cast(int, x), 0x4E, 0xF, 0xF, true));
    x += __builtin_bit_cast(float, __builtin_amdgcn_update_dpp(0, __builtin_bit_cast(int, x), 0x141, 0xF, 0xF, true));
    x += __builtin_bit_cast(float, __builtin_amdgcn_update_dpp(0, __builtin_bit_cast(int, x), 0x140, 0xF, 0xF, true));
    return x;
}
struct CvItem { const float* src; unsigned char* dst; };
__device__ __forceinline__ CvItem cv_decode(const Args& a, unsigned char* ws, int it) {
    const int e = it / 3072, rr = it % 3072, which = rr >> 10, ri = rr & 1023, kb = ri >> 5, nb = ri & 31, n0 = 64 * nb, k0 = 64 * kb;
    CvItem c;
    const float* W = a.in[which == 0 ? I_EWG : (which == 1 ? I_EWU : I_EWD)] + (size_t)e * D * D;
    c.src = W + (size_t)k0 * D + n0;
    const size_t row0 = which == 2 ? (size_t)e * 2048 + n0 : (size_t)e * 4096 + (n0 >> 7) * 256 + (which == 1 ? 128 : 0) + (n0 & 127);
    c.dst = (unsigned char*)(ws + (which == 2 ? WS_WDN : WS_WGU)) + row0 * D + k0;
    return c;
}
__device__ __forceinline__ void cv_load(const CvItem& c, f32x4 (&v)[16], int lane) {
    const int kr = lane >> 4, n4 = (lane & 15) * 4;
#pragma unroll
    for (int i = 0; i < 16; ++i) v[i] = __builtin_nontemporal_load((const f32x4*)(c.src + (size_t)(4 * i + kr) * D + n4));
}
__device__ __forceinline__ void cv_store(const CvItem& cc, const f32x4 (&v)[16], int lane) {
    const int R = lane >> 4, c16 = lane & 15;
    unsigned od[16];
#pragma unroll
    for (int i = 0; i < 16; ++i) {
        unsigned x0 = __float_as_uint(v[i].x), x1 = __float_as_uint(v[i].y), x2 = __float_as_uint(v[i].z), x3 = __float_as_uint(v[i].w);
        { const auto q = __builtin_amdgcn_permlane16_swap(x0, x1, false, false); x0 = q[0]; x1 = q[1]; }
        { const auto q = __builtin_amdgcn_permlane16_swap(x2, x3, false, false); x2 = q[0]; x3 = q[1]; }
        { const auto q = __builtin_amdgcn_permlane32_swap(x0, x2, false, false); x0 = q[0]; x2 = q[1]; }
        { const auto q = __builtin_amdgcn_permlane32_swap(x1, x3, false, false); x1 = q[0]; x3 = q[1]; }
        od[i] = pk_fp8x4(__uint_as_float(x0) * FP8_SW, __uint_as_float(x1) * FP8_SW, __uint_as_float(x2) * FP8_SW, __uint_as_float(x3) * FP8_SW);
    }
    unsigned char* dp = cc.dst + (size_t)(4 * c16 + R) * D;
#pragma unroll
    for (int j = 0; j < 4; ++j) *(u32x4*)(dp + 16 * j) = (u32x4){od[4 * j], od[4 * j + 1], od[4 * j + 2], od[4 * j + 3]};
}
__device__ __forceinline__ void p5_scan_conv(Frame& F, const Args& a, int mode) {
    constexpr int TC = 16, CHF = TC * 384;
    LAS float* buf = (LAS float*)F.lds;
    LAS unsigned* cnt = (LAS unsigned*)(F.lds + 49152);
    const int tid = F.tid, lane = F.lane, wave = F.wave;
    if (tid == 0) *cnt = 0u;
    __syncthreads();
    if (wave < 4) { if (mode & 1) {
        const float* SC = (const float*)(F.ws + WS_SC);
        float* Y = (float*)(F.ws + WS_Y);
        const int kq = lane & 15, rl = lane >> 4;
        unsigned target = 0u;
        __builtin_amdgcn_s_setprio(3);
#define BAR4() do { LDS_WAIT(); asm volatile("" ::: "memory"); target += 4u; if (lane == 0) __hip_atomic_fetch_add(cnt, 1u, __ATOMIC_RELAXED, __HIP_MEMORY_SCOPE_WORKGROUP); \
        while (__hip_atomic_load(cnt, __ATOMIC_RELAXED, __HIP_MEMORY_SCOPE_WORKGROUP) < target) __builtin_amdgcn_s_sleep(1); asm volatile("" ::: "memory"); } while (0)
        for (int task = F.bid; task < 256; task += F.G) {
            const int bh = task >> 2, quarter = task & 3, b = bh >> 4, h = bh & 15;
            const int row = (quarter * 4 + wave) * 4 + rl;
            const float* src = SC + (size_t)bh * T * 384;
            BAR4();
#pragma unroll
            for (int i = 0; i < 6; ++i) *(LAS f32x4*)(buf + (tid + 256 * i) * 4) = *(const f32x4*)(src + (size_t)(tid + 256 * i) * 4);
            BAR4();
            f32x4 S = (f32x4){0.f, 0.f, 0.f, 0.f};
            for (int c = 0; c < T / TC; ++c) {
                f32x4 nx[6];
                const bool more = (c + 1 < T / TC);
                if (more) {
#pragma unroll
                    for (int i = 0; i < 6; ++i) nx[i] = *(const f32x4*)(src + (size_t)(c + 1) * CHF + (size_t)(tid + 256 * i) * 4);
                }
                const LAS float* cb = buf + (c & 1) * CHF;
                f32x4 r4[2], w4[2], k4[2], a4[2], b4[2]; float vv[2];
                r4[0] = *(const LAS f32x4*)(cb + kq * 4); w4[0] = *(const LAS f32x4*)(cb + 64 + kq * 4); k4[0] = *(const LAS f32x4*)(cb + 128 + kq * 4);
                a4[0] = *(const LAS f32x4*)(cb + 256 + kq * 4); b4[0] = *(const LAS f32x4*)(cb + 320 + kq * 4); vv[0] = cb[192 + row];
                float ykeep = 0.f, yprev = 0.f;
#pragma unroll
                for (int tt = 0; tt < TC; ++tt) {
                    const int cu = tt & 1, nx1 = cu ^ 1;
                    if (tt + 1 < TC) { const LAS float* sp = cb + (tt + 1) * 384;
                        r4[nx1] = *(const LAS f32x4*)(sp + kq * 4); w4[nx1] = *(const LAS f32x4*)(sp + 64 + kq * 4); k4[nx1] = *(const LAS f32x4*)(sp + 128 + kq * 4);
                        a4[nx1] = *(const LAS f32x4*)(sp + 256 + kq * 4); b4[nx1] = *(const LAS f32x4*)(sp + 320 + kq * 4); vv[nx1] = sp[192 + row]; }
                    __builtin_amdgcn_sched_barrier(0);
                    float sa = (S.x * a4[cu].x + S.y * a4[cu].y) + (S.z * a4[cu].z + S.w * a4[cu].w);
                    sa = dpp_sum16(sa);
                    if (tt > 0) { const float yr = dpp_sum16(yprev); ykeep = (kq == tt - 1) ? yr : ykeep; }
                    S = S * w4[cu] + sa * b4[cu] + vv[cu] * k4[cu];
                    yprev = (S.x * r4[cu].x + S.y * r4[cu].y) + (S.z * r4[cu].z + S.w * r4[cu].w);
                    __builtin_amdgcn_sched_barrier(0);
                }
                { const float yr = dpp_sum16(yprev); ykeep = (kq == TC - 1) ? yr : ykeep; }
                Y[((size_t)(b * T) + c * TC + kq) * 1024 + h * 64 + row] = ykeep;
                if (more) {
#pragma unroll
                    for (int i = 0; i < 6; ++i) *(LAS f32x4*)(buf + ((c + 1) & 1) * CHF + (tid + 256 * i) * 4) = nx[i];
                }
                BAR4();
            }
        }
#undef BAR4
        __builtin_amdgcn_s_setprio(0);
    } } else if (mode & 2) {
        unsigned char* ws = F.ws;
        const int gw = F.bid * 4 + (wave - 4), NGW = F.G * 4;
        constexpr int NIT = NE * 3 * 1024;
        f32x4 va[16], vb[16];
        int it = gw;
        CvItem ca = cv_decode(a, ws, it < NIT ? it : 0), cb = ca;
        if (it < NIT) cv_load(ca, va, lane);
        for (; it < NIT; it += 2 * NGW) {
            const int it1 = it + NGW, it2 = it + 2 * NGW;
            if (it1 < NIT) { cb = cv_decode(a, ws, it1); cv_load(cb, vb, lane); }
            cv_store(ca, va, lane);
            if (it1 < NIT) {
                if (it2 < NIT) { ca = cv_decode(a, ws, it2); cv_load(ca, va, lane); }
                cv_store(cb, vb, lane);
            }
        }
    }
    __syncthreads();
}

__device__ __forceinline__ void softmax_lds(LAS float* ps, int nk, int lane) {
    float mx = -INFINITY;
    for (int i = lane; i < nk; i += 64) mx = fmaxf(mx, ps[i]);
    mx = wave_max(mx);
    if (mx == -INFINITY) { for (int i = lane; i < nk; i += 64) ps[i] = 0.f; LDS_WAIT(); return; }
    float sum = 0.f;
    for (int i = lane; i < nk; i += 64) { const float e = __expf(ps[i] - mx); ps[i] = e; sum += e; }
    sum = wave_sum(sum);
    const float inv = 1.0f / fmaxf(sum, 1e-30f);
    for (int i = lane; i < nk; i += 64) ps[i] *= inv;
    LDS_WAIT();
}
__device__ __forceinline__ float dot64(const LAS float* q, const bf16* krow) {
    float s = 0.f;
#pragma unroll
    for (int j = 0; j < 8; ++j) { const u32x4 kv = *(const u32x4*)(krow + 8 * j); const f32x4 q0 = *(const LAS f32x4*)(q + 8 * j), q1 = *(const LAS f32x4*)(q + 8 * j + 4);
        s += q0.x * bflo(kv.x) + q0.y * bfhi(kv.x) + q0.z * bflo(kv.y) + q0.w * bfhi(kv.y) + q1.x * bflo(kv.z) + q1.y * bfhi(kv.z) + q1.z * bflo(kv.w) + q1.w * bfhi(kv.w); }
    return s;
}
__device__ __forceinline__ void p5_attn_naive(Frame& F) {
    unsigned char* ws = F.ws;
    const bf16* Z = (const bf16*)(ws + WS_Z);
    const bf16* KC = (const bf16*)(ws + WS_KCMP); const bf16* VC = (const bf16*)(ws + WS_VCMP);
    bf16* CAT = (bf16*)(ws + WS_CAT);
    const int lane = F.lane, gw = F.bid * 8 + F.wave, NGW = F.G * 8;
    LAS float* qs = (LAS float*)(F.lds + F.wave * 5120);
    LAS float* ps = qs + 256;
    for (int it = gw; it < NB * 4 * T; it += NGW) {
        const int t = it & (T - 1), g = (it >> 12) & 3, b = it >> 14, m = b * T + t, cur = t >> 6;
        const size_t zo = (size_t)m * NZ;
#pragma unroll
        for (int r = 0; r < 4; ++r) qs[r * 64 + lane] = bf2f(Z[zo + ZQ + (4 * g + r) * 64 + lane]);
        LDS_WAIT();
        float imp = 0.f, oacc[4];
        const int ncv = t >= 31 ? ((t - 31) >> 4) + 1 : 0;
#pragma unroll
        for (int r = 0; r < 4; ++r) {
            const int h = 4 * g + r; const float slope = exp2f(-0.5f * (float)(h + 1));
#pragma unroll
            for (int ch = 0; ch < 4; ++ch) { const int c = ch * 64 + lane; float s = -INFINITY;
                if (c < ncv) s = dot64(qs + r * 64, KC + ((size_t)(b * 256 + c) * 4 + g) * 64) * 0.125f - slope * (float)(t - (16 * c + 31));
                ps[c] = s; }
            LDS_WAIT();
            softmax_lds(ps, 256, lane);
            float o = 0.f;
            for (int c = 0; c < ncv; ++c) o += ps[c] * bf2f(VC[((size_t)(b * 256 + c) * 4 + g) * 64 + lane]);
            { const int j = lane; float v = 32.0f * (ps[4 * j] + ps[4 * j + 1] + ps[4 * j + 2]);
              if (j > 0) v += 16.0f * ps[4 * j - 1];
              v += 16.0f * ps[4 * j + 3];
              imp += v; }
            oacc[r] = sigmoidf_(bf2f(Z[zo + ZGL + h * 3 + 0])) * o;
            LDS_WAIT();
        }
        float v = imp;
        if (lane == 0 || lane == cur || lane == cur - 1) v = INFINITY; else if (lane > cur) v = -INFINITY;
        int rank = 0;
        for (int jj = 0; jj < 64; ++jj) { const float vv = __shfl(v, jj); rank += (vv > v || (vv == v && jj < lane)) ? 1 : 0; }
        const unsigned long long selmask = __ballot(rank < 16) & (cur >= 63 ? ~0ull : ((1ull << (cur + 1)) - 1ull));
#pragma unroll
        for (int r = 0; r < 4; ++r) {
            const int h = 4 * g + r; const float slope = exp2f(-0.5f * (float)(h + 1));
            int n = 0;
            for (unsigned long long mm = selmask; mm; mm &= mm - 1, ++n) { const int j = __builtin_ctzll(mm); const int pos = 64 * j + lane; float s = -INFINITY;
                if (pos <= t) s = dot64(qs + r * 64, Z + (size_t)(b * T + pos) * NZ + ZKS + g * 64) * 0.125f - slope * (float)(t - pos);
                ps[n * 64 + lane] = s; }
            LDS_WAIT();
            softmax_lds(ps, n * 64, lane);
            float o = 0.f; n = 0;
            for (unsigned long long mm = selmask; mm; mm &= mm - 1, ++n) { const int j = __builtin_ctzll(mm);
                const int lim = (64 * j + 63 <= t) ? 64 : (t - 64 * j + 1);
                const bf16* vb = Z + (size_t)(b * T + 64 * j) * NZ + ZVS + g * 64 + lane;
                for (int i = 0; i < lim; ++i) o += ps[n * 64 + i] * bf2f(vb[(size_t)i * NZ]); }
            oacc[r] += sigmoidf_(bf2f(Z[zo + ZGL + h * 3 + 1])) * o;
            LDS_WAIT();
        }
#pragma unroll
        for (int r = 0; r < 4; ++r) {
            const int h = 4 * g + r; const float slope = exp2f(-0.5f * (float)(h + 1));
#pragma unroll
            for (int ch = 0; ch < 8; ++ch) { const int pos = t - 511 + ch * 64 + lane; float s = -INFINITY;
                if (pos >= 0) s = dot64(qs + r * 64, Z + (size_t)(b * T + pos) * NZ + ZKW + g * 64) * 0.125f - slope * (float)(t - pos);
                ps[ch * 64 + lane] = s; }
            LDS_WAIT();
            softmax_lds(ps, 512, lane);
            float o = 0.f;
            const int i0 = t >= 511 ? 0 : 511 - t;
            const bf16* vb = Z + ZVW + g * 64 + lane;
            for (int i = i0; i < 512; ++i) o += ps[i] * bf2f(vb[(size_t)(b * T + t - 511 + i) * NZ]);
            oacc[r] += sigmoidf_(bf2f(Z[zo + ZGL + h * 3 + 2])) * o;
            CAT[(size_t)m * D + h * 64 + lane] = (bf16)f2bf(oacc[r]);
            LDS_WAIT();
        }
    }
}

namespace nsa {
typedef short bf16x8 __attribute__((ext_vector_type(8)));
typedef float f32x16 __attribute__((ext_vector_type(16)));
typedef __bf16 bf2_t __attribute__((ext_vector_type(2)));
typedef float f2_t __attribute__((ext_vector_type(2)));
__device__ __forceinline__ unsigned pkbf(float a, float b) { f2_t v; v.x = a; v.y = b; return __builtin_bit_cast(unsigned, __builtin_convertvector(v, bf2_t)); }
constexpr int KP = 144, TILE_B = 64 * KP;
constexpr int IMP_LD = 65;
constexpr int L_IMP = 8 * TILE_B;
constexpr int L_INVL = L_IMP + 4 * 64 * IMP_LD * 4;
constexpr int L_SEL = L_INVL + 1024;
constexpr int L_UNI = L_SEL + 512;
constexpr int L_UNIT = L_UNI + 64;
static_assert(L_UNIT + 64 <= LDS_MISC, "attention LDS map");
constexpr float LOG2E = 1.4426950408889634f, SCL = 0.125f * LOG2E, NEGBIG = -1e30f;

struct StageRegs { u32x4 k, v; };
__device__ __forceinline__ void stage_load(StageRegs& r, const bf16* kb, const bf16* vb, size_t pitch, int tid) {
    const int key = tid >> 3, ch = tid & 7;
    r.k = *(const u32x4*)(kb + (size_t)key * pitch + ch * 8);
    r.v = *(const u32x4*)(vb + (size_t)key * pitch + ch * 8);
}
__device__ __forceinline__ void stage_store(const StageRegs& r, LAS unsigned char* lds, int slot, int tid) {
    const int key = tid >> 3, ch = tid & 7;
    *(LAS u32x4*)(lds + slot * TILE_B + key * KP + ch * 16) = r.k;
    const int kl = key & 15, vpos = (key & 48) + (kl & 3) + 4 * (kl >> 3) + 8 * ((kl >> 2) & 1);
    LAS unsigned char* vp = lds + (4 + slot) * TILE_B + (ch * 8) * KP + vpos * 2;
#pragma unroll
    for (int e = 0; e < 8; ++e) { const unsigned w = r.v[e >> 1]; *(LAS unsigned short*)(vp + e * KP) = (unsigned short)((e & 1) ? (w >> 16) : (w & 0xffffu)); }
}
template <int MODE>
__device__ __forceinline__ void tile_core(const LAS unsigned char* Kl, const LAS unsigned char* Vl, const bf16x8 (&qf)[4], const float (&bias)[16], float sl32, f32x16 (&O)[2], float& m, float& l,
                                          float off, bool need_mask, bool use_lo, int lo, int hi, bool lv, int lane, float (&p)[2][16]) {
    const int n = lane & 31, h = lane >> 5;
    f32x16 st[2];
#pragma unroll
    for (int kt = 0; kt < 2; ++kt) {
#pragma unroll
        for (int i = 0; i < 16; ++i) st[kt][i] = 0.f;
#pragma unroll
        for (int s = 0; s < 4; ++s) { const bf16x8 a = *(const LAS bf16x8*)(Kl + (32 * kt + n) * KP + (16 * s + 8 * h) * 2); st[kt] = __builtin_amdgcn_mfma_f32_32x32x16_bf16(a, qf[s], st[kt], 0, 0, 0); }
    }
#pragma unroll
    for (int kt = 0; kt < 2; ++kt)
#pragma unroll
        for (int i = 0; i < 16; ++i) p[kt][i] = fmaf(st[kt][i], SCL, bias[i]);
    if (need_mask) {
#pragma unroll
        for (int kt = 0; kt < 2; ++kt)
#pragma unroll
            for (int i = 0; i < 16; ++i) { const int c = 32 * kt + (i & 3) + 8 * (i >> 2); p[kt][i] = (c <= hi) ? p[kt][i] : -INFINITY; }
        if (use_lo) {
#pragma unroll
            for (int kt = 0; kt < 2; ++kt)
#pragma unroll
                for (int i = 0; i < 16; ++i) { const int c = 32 * kt + (i & 3) + 8 * (i >> 2); p[kt][i] = (c >= lo) ? p[kt][i] : -INFINITY; }
        }
    }
    float mrel;
    if constexpr (MODE != 1) {
        float tm0 = p[0][0], tm1 = p[1][0];
#pragma unroll
        for (int i = 1; i < 16; ++i) { tm0 = fmaxf(tm0, p[0][i]); tm1 = fmaxf(tm1, p[1][i]); }
        float tm = fmaxf(tm0, tm1 + sl32);
        tm = lv ? tm : -INFINITY;
        { const auto sw_ = __builtin_amdgcn_permlane32_swap(__float_as_uint(tm), __float_as_uint(tm), false, false); tm = fmaxf(__uint_as_float(sw_[0]), __uint_as_float(sw_[1])); }
        const float mn = fmaxf(m, tm + off);
        if constexpr (MODE == 0) { m = mn; return; }
        const float alpha = __builtin_amdgcn_exp2f(m - mn);
        m = mn; l *= alpha; O[0] = O[0] * alpha; O[1] = O[1] * alpha;
        mrel = lv ? mn - off : INFINITY;
    } else mrel = m - off;
    float ps = 0.f;
#pragma unroll
    for (int kt = 0; kt < 2; ++kt)
#pragma unroll
        for (int i = 0; i < 16; ++i) { p[kt][i] = __builtin_amdgcn_exp2f(p[kt][i] - (kt ? mrel - sl32 : mrel)); ps += p[kt][i]; }
    l += ps;
#pragma unroll
    for (int g16 = 0; g16 < 4; ++g16) {
        const int kt = g16 >> 1, s8 = (g16 & 1) * 8;
        u32x4 pw; pw.x = pkbf(p[kt][s8 + 0], p[kt][s8 + 1]); pw.y = pkbf(p[kt][s8 + 2], p[kt][s8 + 3]); pw.z = pkbf(p[kt][s8 + 4], p[kt][s8 + 5]); pw.w = pkbf(p[kt][s8 + 6], p[kt][s8 + 7]);
        const bf16x8 pb = __builtin_bit_cast(bf16x8, pw);
#pragma unroll
        for (int dt = 0; dt < 2; ++dt) { const bf16x8 a = *(const LAS bf16x8*)(Vl + (32 * dt + n) * KP + (16 * g16 + 8 * h) * 2); O[dt] = __builtin_amdgcn_mfma_f32_32x32x16_bf16(a, pb, O[dt], 0, 0, 0); }
    }
}
__device__ __forceinline__ void set_bias(float (&bias)[16], float sl, int h) {
#pragma unroll
    for (int i = 0; i < 16; ++i) bias[i] = sl * (float)((i & 3) + 8 * (i >> 2) + 4 * h);
}

__device__ __forceinline__ void attn_phase(Frame& F, int rep) {
    unsigned char* ws = F.ws;
    const bf16* Z = (const bf16*)(ws + WS_Z);
    const bf16* KC = (const bf16*)(ws + WS_KCMP); const bf16* VC = (const bf16*)(ws + WS_VCMP);
    bf16* CAT = (bf16*)(ws + WS_CAT);
    LAS unsigned char* lds = F.lds;
    LAS float* imph = (LAS float*)(lds + L_IMP); LAS float* invl = (LAS float*)(lds + L_INVL);
    LAS unsigned long long* selm = (LAS unsigned long long*)(lds + L_SEL); LAS unsigned long long* unis = (LAS unsigned long long*)(lds + L_UNI);
    unsigned* ctr = (unsigned*)(ws + WS_CTL) + CW_ATTNQ + 64 * rep;
    const int tid = F.tid, lane = F.lane, wave = F.wave, n = lane & 31, h = lane >> 5, r = wave >> 1, th = wave & 1, tq = 32 * th + n;
    for (;;) {
        __syncthreads();
        if (tid == 0) *(LAS int*)(lds + L_UNIT) = (int)atomicAdd(ctr, 1u);
        __syncthreads();
        const int u = *(LAS int*)(lds + L_UNIT);
        if (u >= NB * 4 * 64) break;
        const int qt = 63 - (u >> 4), b = (u >> 2) & 3, g = u & 3, t0 = 64 * qt, head = 4 * g + r, t = t0 + tq;
        const size_t zrow = (size_t)(b * T + t) * NZ;
        bf16x8 qf[4];
#pragma unroll
        for (int s = 0; s < 4; ++s) qf[s] = *(const bf16x8*)(Z + zrow + ZQ + head * 64 + 16 * s + 8 * h);
        const float slope2 = exp2f(-0.5f * (float)(head + 1)) * LOG2E;
        const float g0 = sigmoidf_(bf2f(Z[zrow + ZGL + head * 3 + 0])), g1 = sigmoidf_(bf2f(Z[zrow + ZGL + head * 3 + 1])), g2 = sigmoidf_(bf2f(Z[zrow + ZGL + head * 3 + 2]));
        const int ncmax = (4 * qt + 3) < NCMP ? (4 * qt + 3) : NCMP, ntc = (ncmax + 63) >> 6;
        for (int tau = 0; tau < ntc; ++tau) { StageRegs sr; const size_t ro = ((size_t)(b * 256 + 64 * tau) * 4 + g) * 64; stage_load(sr, KC + ro, VC + ro, 256, tid); stage_store(sr, lds, tau, tid); }
        __syncthreads();
        float bias[16], p[2][16];
        f32x16 O[2];
        set_bias(bias, slope2 * 16.0f, h);
        float sl32 = slope2 * 512.0f;
        const int ncv = t >= 31 ? ((t - 31) >> 4) + 1 : 0;
        float m = NEGBIG, l = 0.f;
#pragma unroll
        for (int i = 0; i < 16; ++i) { O[0][i] = 0.f; O[1][i] = 0.f; }
        for (int tau = 0; tau < ntc; ++tau)
            tile_core<0>(lds + tau * TILE_B, lds + (4 + tau) * TILE_B, qf, bias, sl32, O, m, l, slope2 * (float)(1024 * tau + 31 - t), true, false, 0, ncv - 1 - 64 * tau - 4 * h, true, lane, p);
        float carry = 0.f;
        for (int tau = 0; tau < ntc; ++tau) {
            tile_core<1>(lds + tau * TILE_B, lds + (4 + tau) * TILE_B, qf, bias, sl32, O, m, l, slope2 * (float)(1024 * tau + 31 - t), true, false, 0, ncv - 1 - 64 * tau - 4 * h, true, lane, p);
            float recv[8];
#pragma unroll
            for (int f = 0; f < 8; ++f) recv[f] = __shfl_xor(16.0f * p[f >> 2][4 * (f & 3) + 3], 32);
#pragma unroll
            for (int f = 0; f < 8; ++f) { const int kt = f >> 2, q4 = f & 3;
                const float gsum = 32.0f * (p[kt][4 * q4] + p[kt][4 * q4 + 1] + p[kt][4 * q4 + 2]) + 16.0f * p[kt][4 * q4 + 3];
                const float prev0 = (f == 0) ? carry : recv[f == 0 ? 0 : f - 1];
                const float prev = h ? recv[f] : prev0;
                imph[(r * 64 + tq) * IMP_LD + 16 * tau + 8 * kt + 2 * q4 + h] = gsum + prev; }
            carry = recv[7];
        }
        { const float lt = l + __shfl_xor(l, 32); const float inv = 1.0f / fmaxf(lt, 1e-30f); if (h == 0) invl[r * 64 + tq] = inv; O[0] = O[0] * (inv * g0); O[1] = O[1] * (inv * g0); }
        __syncthreads();
        { unsigned long long uw = 0ull; const unsigned long long vmask = qt >= 63 ? ~0ull : ((1ull << (qt + 1)) - 1ull);
          for (int qq = 0; qq < 8; ++qq) { const int q = 8 * wave + qq;
              float v = 0.f;
#pragma unroll
              for (int rr = 0; rr < 4; ++rr) v += imph[(rr * 64 + q) * IMP_LD + lane] * invl[rr * 64 + q];
              if (lane == 0 || lane == qt || lane == qt - 1) v = INFINITY; else if (lane > qt) v = -INFINITY;
              int rank = 0;
#pragma unroll
              for (int jj = 0; jj < 64; ++jj) { const float vv = __shfl(v, jj); rank += (vv > v || (vv == v && jj < lane)) ? 1 : 0; }
              const unsigned long long mk = __ballot(rank < 16) & vmask;
              if (lane == 0) selm[q] = mk;
              uw |= mk; }
          if (lane == 0) unis[wave] = uw; }
        __syncthreads();
        unsigned long long uni = 0ull;
#pragma unroll
        for (int w8 = 0; w8 < 8; ++w8) uni |= unis[w8];
        uni = __builtin_amdgcn_readfirstlane((unsigned)uni) | ((unsigned long long)__builtin_amdgcn_readfirstlane((unsigned)(uni >> 32)) << 32);
        const unsigned long long selq = selm[tq];
        LAS float* oacc = (LAS float*)(lds + L_IMP) + wave * 2048 + lane;
#pragma unroll
        for (int i = 0; i < 16; ++i) { oacc[i * 64] = O[0][i]; oacc[(16 + i) * 64] = O[1][i]; }
        set_bias(bias, slope2, h); sl32 = slope2 * 32.0f;
        m = NEGBIG; l = 0.f;
#pragma unroll
        for (int i = 0; i < 16; ++i) { O[0][i] = 0.f; O[1][i] = 0.f; }
        {
            unsigned long long mm = uni; int j = __builtin_ctzll(mm); mm &= mm - 1; int cb = 0;
            { StageRegs sr; const bf16* kb = Z + (size_t)(b * T + 64 * j) * NZ + g * 64; stage_load(sr, kb + ZKS, kb + ZVS, NZ, tid); stage_store(sr, lds, 0, tid); }
            __syncthreads();
            for (;;) {
                const bool more = mm != 0ull; int jn = 0; StageRegs sr;
                if (more) { jn = __builtin_ctzll(mm); mm &= mm - 1; const bf16* kb = Z + (size_t)(b * T + 64 * jn) * NZ + g * 64; stage_load(sr, kb + ZKS, kb + ZVS, NZ, tid); }
                const bool lv = (selq >> j) & 1ull; const bool diag = (j == qt);
                tile_core<2>(lds + cb * TILE_B, lds + (4 + cb) * TILE_B, qf, bias, sl32, O, m, l, slope2 * (float)(64 * j - t), diag, false, 0, tq - 4 * h, lv, lane, p);
                if (more) stage_store(sr, lds, cb ^ 1, tid);
                __syncthreads();
                if (!more) break;
                j = jn; cb ^= 1;
            }
        }
        { const float lt = l + __shfl_xor(l, 32); const float inv = 1.0f / fmaxf(lt, 1e-30f) * g1;
#pragma unroll
          for (int i = 0; i < 16; ++i) { oacc[i * 64] += O[0][i] * inv; oacc[(16 + i) * 64] += O[1][i] * inv; } }
        m = NEGBIG; l = 0.f;
#pragma unroll
        for (int i = 0; i < 16; ++i) { O[0][i] = 0.f; O[1][i] = 0.f; }
        {
            int j = qt >= 8 ? qt - 8 : 0; int cb = 0;
            { StageRegs sr; const bf16* kb = Z + (size_t)(b * T + 64 * j) * NZ + g * 64; stage_load(sr, kb + ZKW, kb + ZVW, NZ, tid); stage_store(sr, lds, 0, tid); }
            __syncthreads();
            for (;;) {
                const bool more = j < qt; StageRegs sr;
                if (more) { const bf16* kb = Z + (size_t)(b * T + 64 * (j + 1)) * NZ + g * 64; stage_load(sr, kb + ZKW, kb + ZVW, NZ, tid); }
                const bool left = (j == qt - 8), diag = (j == qt);
                const int lo = (left ? tq + 1 : -1000) - 4 * h, hi = (diag ? tq : 1000) - 4 * h;
                tile_core<2>(lds + cb * TILE_B, lds + (4 + cb) * TILE_B, qf, bias, sl32, O, m, l, slope2 * (float)(64 * j - t), left || diag, left, lo, hi, true, lane, p);
                if (more) stage_store(sr, lds, cb ^ 1, tid);
                __syncthreads();
                if (!more) break;
                ++j; cb ^= 1;
            }
        }
        { const float lt = l + __shfl_xor(l, 32); const float inv = 1.0f / fmaxf(lt, 1e-30f) * g2;
#pragma unroll
          for (int i = 0; i < 16; ++i) { O[0][i] = oacc[i * 64] + O[0][i] * inv; O[1][i] = oacc[(16 + i) * 64] + O[1][i] * inv; } }
        bf16* orow = CAT + (size_t)(b * T + t) * D + head * 64;
#pragma unroll
        for (int dt = 0; dt < 2; ++dt)
#pragma unroll
            for (int q4 = 0; q4 < 4; ++q4) { u32x2 w; w.x = pkbf(O[dt][4 * q4], O[dt][4 * q4 + 1]); w.y = pkbf(O[dt][4 * q4 + 2], O[dt][4 * q4 + 3]); *(u32x2*)(orow + 32 * dt + 8 * q4 + 4 * h) = w; }
    }
    __syncthreads();
}
}

__device__ __forceinline__ void p6_rwkv_out(Frame& F, const Args& a) {
    unsigned char* ws = F.ws;
    const float* Y = (const float*)(ws + WS_Y); const float* SC = (const float*)(ws + WS_SC); const float* G = (const float*)(ws + WS_G);
    const float* rk = a.in[I_RK]; const float* lng = a.in[I_LNG]; const float* lnb = a.in[I_LNB];
    bf16* CAT = (bf16*)(ws + WS_CAT);
    const int lane = F.lane, gw = F.bid * 8 + F.wave, NGW = F.G * 8;
    for (int it = gw; it < M * 2; it += NGW) {
        const int m = it >> 1, half = it & 1, t = m & (T - 1), b = m >> 12, col = (half * 64 + lane) * 8, h = col >> 6, j8 = col & 63;
        float y[8], r[8], k2[8], v[8], gg[8], rk8[8], lg8[8], lb8[8];
        ld8f(Y + (size_t)m * 1024 + col, y);
        const float* sc = SC + ((size_t)(b * 16 + h) * T + t) * 384 + j8;
        ld8f(sc, r); ld8f(sc + 128, k2); ld8f(sc + 192, v); ld8f(G + (size_t)m * 1024 + col, gg); ld8f(rk + col, rk8); ld8f(lng + col, lg8); ld8f(lnb + col, lb8);
        float s1 = 0.f, sb = 0.f;
#pragma unroll
        for (int e = 0; e < 8; ++e) { s1 += y[e]; sb += r[e] * k2[e] * rk8[e]; }
        const float mean = dpp_sum8(s1) * (1.0f / 64.0f), bonus = dpp_sum8(sb);
        float s2 = 0.f;
#pragma unroll
        for (int e = 0; e < 8; ++e) { y[e] -= mean; s2 += y[e] * y[e]; }
        const float rstd = rsqrtf(dpp_sum8(s2) * (1.0f / 64.0f) + GN_EPS);
        float o[8];
#pragma unroll
        for (int e = 0; e < 8; ++e) o[e] = (y[e] * rstd * lg8[e] + lb8[e] + bonus * v[e]) * gg[e];
        *(u32x4*)(CAT + (size_t)m * D + 1024 + col) = pack8(o);
    }
}

__device__ __forceinline__ void p8_ln_router(Frame& F, const Args& a) {
    typedef short bf16x8_t __attribute__((ext_vector_type(8)));
    unsigned char* ws = F.ws;
    const float* PRE = F.out; float* H1 = (float*)(ws + WS_H1); unsigned char* H1Q = (unsigned char*)(ws + WS_H1B);
    const float* g1 = a.in[I_LN1G]; const float* b1 = a.in[I_LN1B]; const float* rb = a.in[I_RB];
    const bf16* RWT = (const bf16*)(ws + WS_RWT);
    int* TOPE = (int*)(ws + WS_TOPE); float* TOPW = (float*)(ws + WS_TOPW); int* SLOT = (int*)(ws + WS_SLOT); int* HIST = (int*)(ws + WS_HIST);
    const int lane = F.lane, wave = F.wave, tid = F.tid;
    LAS float* part = (LAS float*)F.lds;
    LAS int* es = (LAS int*)(F.lds + 2 * 64 * 33 * 4);
    for (int ch = F.bid; ch < M / 64; ch += F.G) {
        for (int i = 0; i < 8; ++i) {
            const int m = ch * 64 + wave * 8 + i;
            float v[4][8]; float s1 = 0.f;
#pragma unroll
            for (int j = 0; j < 4; ++j) { ld8f(PRE + (size_t)m * D + 512 * j + 8 * lane, v[j]);
#pragma unroll
                for (int e = 0; e < 8; ++e) s1 += v[j][e]; }
            const float mean = wave_sum(s1) * (1.0f / D); float s2 = 0.f;
#pragma unroll
            for (int j = 0; j < 4; ++j)
#pragma unroll
                for (int e = 0; e < 8; ++e) { v[j][e] -= mean; s2 += v[j][e] * v[j][e]; }
            const float rstd = rsqrtf(wave_sum(s2) * (1.0f / D) + LN_EPS);
#pragma unroll
            for (int j = 0; j < 4; ++j) { const int c0 = 512 * j + 8 * lane; float g8[8], b8[8], o[8]; ld8f(g1 + c0, g8); ld8f(b1 + c0, b8);
#pragma unroll
                for (int e = 0; e < 8; ++e) o[e] = v[j][e] * rstd * g8[e] + b8[e];
                st8f(H1 + (size_t)m * D + c0, o);
                u32x2 q; q.x = pk_fp8x4(o[0] * FP8_SA1, o[1] * FP8_SA1, o[2] * FP8_SA1, o[3] * FP8_SA1); q.y = pk_fp8x4(o[4] * FP8_SA1, o[5] * FP8_SA1, o[6] * FP8_SA1, o[7] * FP8_SA1);
                *(u32x2*)(H1Q + (size_t)m * D + c0) = q; }
        }
        asm volatile("s_waitcnt vmcnt(0)" ::: "memory");
        __syncthreads();
        {
            const int tb = 16 * (wave & 3), kh = wave >> 2, row = lane & 15, g = lane >> 4;
            f32x4 acc0 = (f32x4){0.f, 0.f, 0.f, 0.f}, acc1 = acc0;
            const float* hp = H1 + (size_t)(ch * 64 + tb + row) * D + kh * 1024 + 8 * g;
            const bf16* w0 = RWT + (size_t)row * D + kh * 1024 + 8 * g;
#pragma unroll 4
            for (int ks = 0; ks < 32; ++ks) {
                float x[8]; ld8f(hp + 32 * ks, x);
                float hi[8], lo[8];
#pragma unroll
                for (int e = 0; e < 8; ++e) { hi[e] = bf2f(f2bf(x[e])); lo[e] = x[e] - hi[e]; }
                const bf16x8_t ah = __builtin_bit_cast(bf16x8_t, pack8(hi)), al = __builtin_bit_cast(bf16x8_t, pack8(lo));
                const bf16x8_t b0h = *(const bf16x8_t*)(w0 + 32 * ks), b1h = *(const bf16x8_t*)(w0 + 16 * D + 32 * ks);
                const bf16x8_t b0l = *(const bf16x8_t*)(w0 + 32 * D + 32 * ks), b1l = *(const bf16x8_t*)(w0 + 48 * D + 32 * ks);
                acc0 = __builtin_amdgcn_mfma_f32_16x16x32_bf16(ah, b0h, acc0, 0, 0, 0); acc1 = __builtin_amdgcn_mfma_f32_16x16x32_bf16(ah, b1h, acc1, 0, 0, 0);
                acc0 = __builtin_amdgcn_mfma_f32_16x16x32_bf16(ah, b0l, acc0, 0, 0, 0); acc1 = __builtin_amdgcn_mfma_f32_16x16x32_bf16(ah, b1l, acc1, 0, 0, 0);
                acc0 = __builtin_amdgcn_mfma_f32_16x16x32_bf16(al, b0h, acc0, 0, 0, 0); acc1 = __builtin_amdgcn_mfma_f32_16x16x32_bf16(al, b1h, acc1, 0, 0, 0);
            }
#pragma unroll
            for (int q = 0; q < 4; ++q) { part[(kh * 64 + tb + 4 * g + q) * 33 + row] = acc0[q]; part[(kh * 64 + tb + 4 * g + q) * 33 + 16 + row] = acc1[q]; }
        }
        __syncthreads();
        for (int i = 0; i < 8; ++i) {
            const int tl_ = wave * 8 + i, m = ch * 64 + tl_;
            float lg = -INFINITY;
            if (lane < 32) lg = part[tl_ * 33 + lane] + part[(64 + tl_) * 33 + lane] + rb[lane];
            float tl[4]; int te[4];
#pragma unroll
            for (int k = 0; k < 4; ++k) { const float mx = wave_max(lg); const unsigned long long bm = __ballot(lg == mx); const int idx = __builtin_ctzll(bm); tl[k] = mx; te[k] = idx; if (lane == idx) lg = -INFINITY; }
            const float e1 = __expf(tl[1] - tl[0]), e2 = __expf(tl[2] - tl[0]), e3 = __expf(tl[3] - tl[0]); const float inv = 1.0f / (1.0f + e1 + e2 + e3);
            if (lane == 0) { *(int4*)(TOPE + (size_t)m * 4) = make_int4(te[0], te[1], te[2], te[3]); *(f32x4*)(TOPW + (size_t)m * 4) = (f32x4){inv, e1 * inv, e2 * inv, e3 * inv};
                es[tl_ * 4 + 0] = te[0]; es[tl_ * 4 + 1] = te[1]; es[tl_ * 4 + 2] = te[2]; es[tl_ * 4 + 3] = te[3]; }
        }
        __syncthreads();
        if (tid < 256) { const int e = es[tid]; int slot = 0; for (int q = 0; q < tid; ++q) slot += (es[q] == e) ? 1 : 0; SLOT[(size_t)ch * 256 + tid] = slot; }
        if (tid >= 256 && tid < 288) { const int e = tid - 256; int cnt = 0; for (int q = 0; q < 256; ++q) cnt += (es[q] == e) ? 1 : 0; HIST[ch * 32 + e] = cnt; }
        __syncthreads();
    }
}

__device__ __forceinline__ void p9_offsets(Frame& F) {
    unsigned char* ws = F.ws;
    const int* HIST = (const int*)(ws + WS_HIST); const int* TOPE = (const int*)(ws + WS_TOPE); const int* SLOT = (const int*)(ws + WS_SLOT);
    int* TOKROW = (int*)(ws + WS_TOKROW); int* ROWTOK = (int*)(ws + WS_ROWTOK); int* BLKE = (int*)(ws + WS_BLKE);
    LAS int* part = (LAS int*)F.lds;
    LAS int* tot = part + 512;
    LAS int* pre = tot + 32;
    LAS int* startp = pre + 32;
    LAS int* dsts = startp + 64;
    const int tid = F.tid, e = tid & 31, pg = tid >> 5;
    for (int ch = F.bid; ch < M / 64; ch += F.G) {
        __syncthreads();
        { int s = 0; for (int c = pg * 16; c < pg * 16 + 16; ++c) s += HIST[c * 32 + e]; part[pg * 32 + e] = s; }
        __syncthreads();
        if (tid < 32) { int s = 0; for (int q = 0; q < 16; ++q) s += part[q * 32 + tid]; tot[tid] = s; }
        __syncthreads();
        { int s = 0; for (int c = pg * 16; c < pg * 16 + 16; ++c) if (c < ch) s += HIST[c * 32 + e]; part[pg * 32 + e] = s; }
        __syncthreads();
        if (tid < 32) { int s = 0; for (int q = 0; q < 16; ++q) s += part[q * 32 + tid]; pre[tid] = s; }
        if (tid == 32) { int s = 0; for (int q = 0; q < 32; ++q) { startp[q] = s; s += (tot[q] + 255) / 256 * 256; } startp[32] = s; }
        __syncthreads();
        if (tid < 256) { const int m = ch * 64 + (tid >> 2); const int ee = TOPE[(size_t)m * 4 + (tid & 3)]; const int dest = startp[ee] + pre[ee] + SLOT[(size_t)ch * 256 + tid];
            ROWTOK[dest] = m; TOKROW[(size_t)m * 4 + (tid & 3)] = dest; dsts[tid] = dest; }
        __syncthreads();
        { const unsigned char* H1Q = (const unsigned char*)(ws + WS_H1B); unsigned char* XG = (unsigned char*)(ws + WS_XG);
          for (int a = F.wave; a < 256; a += 8) { const int m = ch * 64 + (a >> 2); const int dest = dsts[a];
              const u32x4 v0 = *(const u32x4*)(H1Q + (size_t)m * D + F.lane * 32), v1 = *(const u32x4*)(H1Q + (size_t)m * D + F.lane * 32 + 16);
              *(u32x4*)(XG + (size_t)dest * D + F.lane * 32) = v0; *(u32x4*)(XG + (size_t)dest * D + F.lane * 32 + 16) = v1; } }
        if (ch == 0) {
            const int nblk = startp[32] >> 8;
            if (tid < MAXBLK) { int be = -1; if (tid < nblk) { for (int q = 0; q < 32; ++q) if (startp[q] <= tid * 256 && tid * 256 < startp[q + 1]) be = q; } BLKE[tid] = be < 0 ? 0 : be; }
            if (tid == 0) BLKE[MAXBLK] = nblk;
        }
    }
    __syncthreads();
}

__device__ __forceinline__ void p12_combine_ln2(Frame& F, const Args& a) {
    unsigned char* ws = F.ws;
    const float* H1 = (const float*)(ws + WS_H1); const bf16* EO = (const bf16*)(ws + WS_EO); const int* TOKROW = (const int*)(ws + WS_TOKROW); const float* TOPW = (const float*)(ws + WS_TOPW);
    float* H2 = F.out; bf16* H2B = (bf16*)(ws + WS_H2B);
    const float* g2 = a.in[I_LN2G]; const float* b2 = a.in[I_LN2B];
    const int lane = F.lane, gw = F.bid * 8 + F.wave, NGW = F.G * 8;
    for (int m = gw; m < M; m += NGW) {
        const int4 rows = *(const int4*)(TOKROW + (size_t)m * 4); const f32x4 tw = *(const f32x4*)(TOPW + (size_t)m * 4);
        const int rr[4] = {rows.x, rows.y, rows.z, rows.w};
        float v[4][8]; float s = 0.f;
#pragma unroll
        for (int j = 0; j < 4; ++j) {
            const int c0 = 512 * j + 8 * lane;
            float h8[8]; ld8f(H1 + (size_t)m * D + c0, h8);
#pragma unroll
            for (int e = 0; e < 8; ++e) v[j][e] = ALPHA * h8[e];
#pragma unroll
            for (int k = 0; k < 4; ++k) { float e8[8]; unpack8(*(const u32x4*)(EO + (size_t)rr[k] * D + c0), e8); const float wk = tw[k];
#pragma unroll
                for (int e = 0; e < 8; ++e) v[j][e] += wk * e8[e]; }
#pragma unroll
            for (int e = 0; e < 8; ++e) s += v[j][e];
        }
        const float mean = wave_sum(s) * (1.0f / D); float s2 = 0.f;
#pragma unroll
        for (int j = 0; j < 4; ++j)
#pragma unroll
            for (int e = 0; e < 8; ++e) { v[j][e] -= mean; s2 += v[j][e] * v[j][e]; }
        const float rstd = rsqrtf(wave_sum(s2) * (1.0f / D) + LN_EPS);
#pragma unroll
        for (int j = 0; j < 4; ++j) { const int c0 = 512 * j + 8 * lane; float g8[8], b8[8], o[8]; ld8f(g2 + c0, g8); ld8f(b2 + c0, b8);
#pragma unroll
            for (int e = 0; e < 8; ++e) o[e] = v[j][e] * rstd * g8[e] + b8[e];
            st8f(H2 + (size_t)m * D + c0, o); *(u32x4*)(H2B + (size_t)m * D + c0) = pack8(o); }
    }
}

__global__ void __launch_bounds__(512, 2) hymba_fwd(Args args) {
    extern __shared__ __attribute__((aligned(16))) unsigned char lds_raw[];
    Frame F;
    F.lds = (LAS unsigned char*)lds_raw; F.ws = args.ws; F.out = args.out;
    F.tid = threadIdx.x; F.lane = F.tid & 63; F.wave = __builtin_amdgcn_readfirstlane(F.tid >> 6); F.bid = blockIdx.x; F.G = gridDim.x;
    unsigned char* ws = args.ws;
    volatile LAS unsigned* MISC = (volatile LAS unsigned*)(F.lds + LDS_MISC);
    if (F.tid < 32) MISC[F.tid] = 0u;
    __syncthreads();
    XcdBarrier bar; bar.bar = (unsigned*)(ws + WS_CTL) + CW_BAR; bar.x = 0; bar.st = nullptr;
    const int lo = args.ph_lo, hi = args.ph_hi;
    const bool one_launch = (hi - lo) > 1;
    if (one_launch) bar = xcd_barrier_post((unsigned*)(ws + WS_CTL) + CW_BAR, MISC + 8);
#ifdef ONLYPH
#define IN(k) ((k) == ONLYPH && lo <= (k) && (k) < hi)
#else
#define IN(k) (lo <= (k) && (k) < hi)
#endif
#define SEAM(k) do { if (IN(k) && IN((k) + 1)) xcd_barrier(bar); } while (0)
#ifndef PROBE_MASK
#define PROBE_MASK 0ull
#endif
#ifndef PROBE_MODE
#define PROBE_MODE 3
#endif
#define REPS(k) for (int rp_ = 0; rp_ < ((((PROBE_MASK) >> (k)) & 1ull) ? 2 : 1); ++rp_)

    if (IN(0)) REPS(0) { p0_prologue(F, args); } SEAM(0);
    if (IN(1)) REPS(1) { GemmDesc g{(const bf16*)(ws + WS_XB), D, nullptr, (const bf16*)(ws + WS_WIN), D, M, NZ, D, nullptr, 0, nullptr, 127, 127}; EpiZ E{(bf16*)(ws + WS_Z)}; gemm_run<false>(F, g, E); } SEAM(1);
    if (IN(2)) REPS(2) { p2_prep(F, args); } SEAM(2);
    if (IN(3)) {
        GemmDesc gk{(const bf16*)(ws + WS_ACK), D, nullptr, (const bf16*)(ws + WS_CW1K), D, 4096, 256, D, nullptr, 0, nullptr, 127, 127}; EpiCmp Ek{(float*)(ws + WS_HCMPK)};
        GemmDesc gv{(const bf16*)(ws + WS_ACV), D, nullptr, (const bf16*)(ws + WS_CW1V), D, 4096, 256, D, nullptr, 0, nullptr, 127, 127}; EpiCmp Ev{(float*)(ws + WS_HCMPV)};
        GemmDesc gw{(const bf16*)(ws + WS_WL), 256, nullptr, (const bf16*)(ws + WS_WUP), 256, M, 1024, 256, nullptr, 0, nullptr, 127, 127}; EpiDecay Ew{(float*)(ws + WS_DEC), args.in[I_W0]};
        GemmDesc ga{(const bf16*)(ws + WS_AL), 256, nullptr, (const bf16*)(ws + WS_AUP), 256, M, 1024, 256, nullptr, 0, nullptr, 127, 127}; EpiASig Ea{(float*)(ws + WS_ASIG), args.in[I_A0]};
        GemmDesc gg{(const bf16*)(ws + WS_GLS), 256, nullptr, (const bf16*)(ws + WS_GUP), 256, M, 1024, 256, nullptr, 0, nullptr, 127, 127}; EpiF32 Eg{(float*)(ws + WS_G), 1024};
        const bool split = F.G >= 64;
        if (split && F.bid < 16) gemm_run_part(F, gk, Ek, 16, F.bid);
        else if (split && F.bid < 32) gemm_run_part(F, gv, Ev, 16, F.bid - 16);
        else { const int Gp = split ? F.G - 32 : F.G, cp = split ? F.bid - 32 : F.bid;
            if (!split) { gemm_run_part(F, gk, Ek, Gp, cp); gemm_run_part(F, gv, Ev, Gp, cp); }
            gemm_run_part(F, gw, Ew, Gp, cp); gemm_run_part(F, ga, Ea, Gp, cp); gemm_run_part(F, gg, Eg, Gp, cp); }
    } SEAM(3);
    if (IN(4)) REPS(4) { p4_prep(F, args); } SEAM(4);
    #ifndef NAIVE_ATTN
#define NAIVE_ATTN 0
#endif
    if (IN(5)) { REPS(50) p5_scan_conv(F, args, rp_ == 0 ? 3 : PROBE_MODE);
#if NAIVE_ATTN
        p5_attn_naive(F);
#else
        REPS(51) nsa::attn_phase(F, rp_);
#endif
    } SEAM(5);
    if (IN(6)) REPS(6) { p6_rwkv_out(F, args); } SEAM(6);
    if (IN(7)) REPS(7) { GemmDesc g{(const bf16*)(ws + WS_CAT), D, nullptr, (const bf16*)(ws + WS_WOUT), D, M, D, D, nullptr, 0, nullptr, 127, 127}; EpiPre1 E{F.out, args.in[I_X]}; gemm_run<false>(F, g, E); } SEAM(7);
    if (IN(8)) REPS(8) { p8_ln_router(F, args); } SEAM(8);
    if (IN(9)) REPS(9) { p9_offsets(F); } SEAM(9);
    if (IN(10)) REPS(10) { GemmDesc g{(const bf16*)(ws + WS_XG), D, nullptr, (const bf16*)(ws + WS_WGU), D, MAXROWS, 4096, D, (const int*)(ws + WS_BLKE), (size_t)4096 * D, (const int*)(ws + WS_BLKE) + MAXBLK, FP8_EA1, FP8_EW};
        EpiSwiglu E{(unsigned char*)(ws + WS_HACT), args.in[I_EBG], args.in[I_EBU]}; gemm_run<true, EpiSwiglu, true>(F, g, E); } SEAM(10);
    if (IN(11)) REPS(11) {
        { GemmDesc g{(const bf16*)(ws + WS_HACT), D, nullptr, (const bf16*)(ws + WS_WDN), D, MAXROWS, D, D, (const int*)(ws + WS_BLKE), (size_t)D * D, (const int*)(ws + WS_BLKE) + MAXBLK, FP8_EA2, FP8_EW};
          EpiDown E{(bf16*)(ws + WS_EO), args.in[I_EBD]}; gemm_run<false, EpiDown, true>(F, g, E); }
        { GemmDesc g{(const bf16*)(ws + WS_PB), 256, nullptr, (const bf16*)(ws + WS_WPL), 256, M, D, 256, nullptr, 0, nullptr, 127, 127}; EpiBf16 E{(bf16*)(ws + WS_PL), D}; gemm_run<false>(F, g, E); }
    } SEAM(11);
    if (IN(12)) REPS(12) { p12_combine_ln2(F, args); } SEAM(12);
    if (IN(13)) { GemmDesc g{(const bf16*)(ws + WS_H2B), D, nullptr, (const bf16*)(ws + WS_WPG), D, M, D, D, nullptr, 0, nullptr, 127, 127}; EpiFinal E{F.out, (const bf16*)(ws + WS_PL)}; gemm_run<false>(F, g, E); }
#undef IN
#undef SEAM
}

extern "C" void kernel_launch(void* const* d_in, const int* in_sizes, int n_in, void* d_out, int out_size, void* d_ws, size_t ws_size, hipStream_t stream) {
    static int grid = 0;
    if (grid == 0) {
        if (n_in != 35 || out_size != M * D || ws_size < WS_END) { fprintf(stderr, "kernel_launch: unexpected problem (n_in %d, out %d, ws %zu < %zu)\n", n_in, out_size, ws_size, (size_t)WS_END); grid = -1; return; }
        int dev = 0, cus = 0, per_cu = 0;
        if (hipGetDevice(&dev) != hipSuccess || hipDeviceGetAttribute(&cus, hipDeviceAttributeMultiprocessorCount, dev) != hipSuccess) { grid = -1; return; }
        if (hipFuncSetAttribute((const void*)hymba_fwd, hipFuncAttributeMaxDynamicSharedMemorySize, LDS_BYTES) != hipSuccess) { fprintf(stderr, "kernel_launch: hipFuncSetAttribute failed\n"); grid = -1; return; }
        if (hipOccupancyMaxActiveBlocksPerMultiprocessor(&per_cu, (const void*)hymba_fwd, 512, LDS_BYTES) != hipSuccess || per_cu < 1) fprintf(stderr, "kernel_launch: occupancy query reports %d\n", per_cu);
        (void)hipGetLastError();
        grid = cus;
    }
    if (grid < 0) return;
    if (hipMemsetAsync((char*)d_ws + WS_CTL, 0, CTL_ZERO_BYTES, stream) != hipSuccess) return;
    Args a{};
    for (int i = 0; i < 35; ++i) a.in[i] = (const float*)d_in[i];
    a.out = (float*)d_out; a.ws = (unsigned char*)d_ws;
#if MK_LAUNCH_PER_PHASE
    for (int ph = 0; ph < NPHASE; ++ph) { a.ph_lo = ph; a.ph_hi = ph + 1; a.li = ph; hipLaunchKernelGGL(hymba_fwd, dim3(grid), dim3(512), LDS_BYTES, stream, a); }
#else
    a.ph_lo = 0; a.ph_hi = NPHASE; a.li = 0;
    hipLaunchKernelGGL(hymba_fwd, dim3(grid), dim3(512), LDS_BYTES, stream, a);
#endif
}
```

```cpp
#include <hip/hip_runtime.h>
#include <cstdio>
#include <cstdint>

#ifndef MK_LAUNCH_PER_PHASE
#define MK_LAUNCH_PER_PHASE 0
#endif

#define GAS __attribute__((address_space(1)))
#define LAS __attribute__((address_space(3)))
typedef unsigned short bf16;
typedef float f32x4 __attribute__((ext_vector_type(4)));
typedef unsigned u32x4 __attribute__((ext_vector_type(4)));
typedef unsigned u32x2 __attribute__((ext_vector_type(2)));
#define LDS_WAIT() asm volatile("s_waitcnt lgkmcnt(0)" ::: "memory")

constexpr int NB = 4, T = 4096, D = 2048, M = NB * T;
constexpr int NZ = 6144;
constexpr int ZQ = 0, ZKC = 1024, ZVC = 1280, ZKS = 1536, ZVS = 1792, ZKW = 2048, ZVW = 2304, ZGL = 2560, ZRW = 2608;
constexpr int ZR = 2608, ZK = 3632, ZV = 4656, ZWL = 5680, ZAL = 5776, ZGLO = 5872, INC = 6128;
constexpr int NCMP = 255, NE = 32, MAXBLK = 288, MAXROWS = MAXBLK * 256;
constexpr float LN_EPS = 1e-5f, GN_EPS = 64e-5f, ALPHA = 1.189207115002721f;
constexpr int NPHASE = 14;

constexpr size_t MiB = 1u << 20;
constexpr size_t WS_CTL = 0, CTL_ZERO_BYTES = 1 * MiB;
constexpr size_t WS_HIST = 1 * MiB;
constexpr size_t WS_BLKE = 1 * MiB + 64 * 1024;
constexpr size_t WS_TOPE = 2 * MiB;
constexpr size_t WS_TOPW = WS_TOPE + 256 * 1024;
constexpr size_t WS_SLOT = WS_TOPW + 256 * 1024;
constexpr size_t WS_TOKROW = WS_SLOT + 256 * 1024;
constexpr size_t WS_ROWTOK = 3 * MiB;
constexpr size_t WS_RWT = 3 * MiB + 512 * 1024;
constexpr size_t WS_WPL = 4 * MiB;
constexpr size_t WS_WUP = 5 * MiB;
constexpr size_t WS_AUP = WS_WUP + 512 * 1024;
constexpr size_t WS_GUP = 6 * MiB;
constexpr size_t WS_CW1K = 7 * MiB;
constexpr size_t WS_CW1V = 8 * MiB;
constexpr size_t WS_HCMPK = 1844 * MiB;
constexpr size_t WS_HCMPV = 1846 * MiB;
constexpr size_t WS_KCMP = 11 * MiB;
constexpr size_t WS_VCMP = 11 * MiB + 512 * 1024;
constexpr size_t WS_WIN = 12 * MiB;
constexpr size_t WS_WOUT = 36 * MiB;
constexpr size_t WS_WPG = 44 * MiB;
constexpr size_t WS_PB = 52 * MiB;
constexpr size_t WS_WGU = 60 * MiB;
constexpr size_t WS_WDN = 572 * MiB;
constexpr size_t WS_S = 828 * MiB;
constexpr size_t WS_XB = WS_S;
constexpr size_t WS_Z = WS_S + 64 * MiB;
constexpr size_t WS_ACK = WS_S + 256 * MiB;
constexpr size_t WS_ACV = WS_S + 272 * MiB;
constexpr size_t WS_WL = WS_S + 288 * MiB;
constexpr size_t WS_AL = WS_S + 296 * MiB;
constexpr size_t WS_GLS = WS_S + 304 * MiB;
constexpr size_t WS_DEC = WS_S + 312 * MiB;
constexpr size_t WS_ASIG = WS_S + 376 * MiB;
constexpr size_t WS_G = WS_S + 440 * MiB;
constexpr size_t WS_SC = WS_S + 504 * MiB;
constexpr size_t WS_Y = WS_S + 888 * MiB;
constexpr size_t WS_CAT = WS_S + 952 * MiB;
constexpr size_t WS_H1 = WS_S;
constexpr size_t WS_H1B = WS_S + 128 * MiB;
constexpr size_t WS_XG = WS_S + 160 * MiB;
constexpr size_t WS_HACT = WS_S + 304 * MiB;
constexpr size_t WS_EO = WS_S + 480 * MiB;
constexpr size_t WS_H2B = WS_S + 768 * MiB;
constexpr size_t WS_PL = WS_S + 832 * MiB;
constexpr size_t WS_END = 1848 * MiB;
static_assert(WS_S + 1016 * MiB <= WS_HCMPK, "d_ws map");
constexpr int CW_BAR = 4096;

constexpr int LDS_BYTES = 147456;
constexpr int LDS_MISC = 147456 - 128;
constexpr int CW_ATTNQ = 8192;

__device__ __forceinline__ unsigned f2bf(float f) { unsigned u = __float_as_uint(f); return (u + 0x7fffu + ((u >> 16) & 1u)) >> 16; }
typedef __bf16 bf2v_t __attribute__((ext_vector_type(2)));
typedef float f2v_t __attribute__((ext_vector_type(2)));
__device__ __forceinline__ unsigned pk2(float lo, float hi) { f2v_t v; v.x = lo; v.y = hi; return __builtin_bit_cast(unsigned, __builtin_convertvector(v, bf2v_t)); }
__device__ __forceinline__ float bf2f(unsigned h) { return __uint_as_float(h << 16); }
__device__ __forceinline__ float bflo(unsigned w) { return __uint_as_float(w << 16); }
__device__ __forceinline__ float bfhi(unsigned w) { return __uint_as_float(w & 0xffff0000u); }
#define DPPF(x, ctrl) __builtin_bit_cast(float, __builtin_amdgcn_update_dpp(0, __builtin_bit_cast(int, (x)), (ctrl), 0xF, 0xF, true))
__device__ __forceinline__ float wave_sum(float v) {
    v += DPPF(v, 0xB1); v += DPPF(v, 0x4E); v += DPPF(v, 0x141); v += DPPF(v, 0x140);
    { const auto q = __builtin_amdgcn_permlane16_swap(__float_as_uint(v), __float_as_uint(v), false, false); v = __uint_as_float(q[0]) + __uint_as_float(q[1]); }
    { const auto q = __builtin_amdgcn_permlane32_swap(__float_as_uint(v), __float_as_uint(v), false, false); v = __uint_as_float(q[0]) + __uint_as_float(q[1]); }
    return v;
}
__device__ __forceinline__ float wave_max(float v) {
    v = fmaxf(v, DPPF(v, 0xB1)); v = fmaxf(v, DPPF(v, 0x4E)); v = fmaxf(v, DPPF(v, 0x141)); v = fmaxf(v, DPPF(v, 0x140));
    { const auto q = __builtin_amdgcn_permlane16_swap(__float_as_uint(v), __float_as_uint(v), false, false); v = fmaxf(__uint_as_float(q[0]), __uint_as_float(q[1])); }
    { const auto q = __builtin_amdgcn_permlane32_swap(__float_as_uint(v), __float_as_uint(v), false, false); v = fmaxf(__uint_as_float(q[0]), __uint_as_float(q[1])); }
    return v;
}
__device__ __forceinline__ unsigned pk_fp8x4(float a, float b, float c, float d) {
    a = __builtin_amdgcn_fmed3f(a, -448.f, 448.f); b = __builtin_amdgcn_fmed3f(b, -448.f, 448.f); c = __builtin_amdgcn_fmed3f(c, -448.f, 448.f); d = __builtin_amdgcn_fmed3f(d, -448.f, 448.f);
    int w = 0; w = __builtin_amdgcn_cvt_pk_fp8_f32(a, b, w, false); w = __builtin_amdgcn_cvt_pk_fp8_f32(c, d, w, true); return (unsigned)w; }
constexpr float FP8_SW = 64.0f, FP8_SA1 = 16.0f, FP8_SA2 = 4.0f;
constexpr int FP8_EW = 127 - 6, FP8_EA1 = 127 - 4, FP8_EA2 = 127 - 2;
__device__ __forceinline__ float sigmoidf_(float x) { return __builtin_amdgcn_rcpf(1.0f + __builtin_amdgcn_exp2f(-1.4426950408889634f * x)); }
__device__ __forceinline__ float gelu_tanh(float x) { const float u = 0.7978845608028654f * (x + 0.044715f * x * x * x); return x * sigmoidf_(2.0f * u); }

#define XB_TMO      128
#define XB_XCNT(j)  (256  + 64 * (j))
#define XB_XSUB(j)  (1280 + 64 * (j))
#define XB_XGEN(j)  (2304 + 64 * (j))
#define XB_TOP      3328
#define XB_TOPGEN   3392
#define XCD_BAR_WORDS 3456
#define XB_SPIN_CAP (1u << 22)
__device__ __forceinline__ unsigned xb_ld(unsigned* p)              { return __hip_atomic_load(p, __ATOMIC_RELAXED, __HIP_MEMORY_SCOPE_AGENT); }
__device__ __forceinline__ unsigned xb_add(unsigned* p, unsigned v) { return __hip_atomic_fetch_add(p, v, __ATOMIC_RELAXED, __HIP_MEMORY_SCOPE_AGENT); }
__device__ __forceinline__ unsigned xb_xcc_id() { return (unsigned)__builtin_amdgcn_s_getreg((3 << 11) | 20) & 0xFu; }
#define XB_SPIN(cond, bar) do { unsigned _sp = 0; while (cond) { __builtin_amdgcn_s_sleep(1); \
    if ((++_sp & 255u) == 0u) { if (xb_ld(&(bar)[XB_TMO])) break; if (_sp > XB_SPIN_CAP) { atomicAdd(&(bar)[XB_TMO], 1u); break; } } } } while (0)
struct XcdBarrier { unsigned* bar; unsigned x; volatile LAS unsigned* st; };
__device__ __forceinline__ XcdBarrier xcd_barrier_post(unsigned* bar, volatile LAS unsigned* st) {
    XcdBarrier b; b.bar = bar; b.x = xb_xcc_id(); b.st = st;
    if (threadIdx.x == 0) (void)xb_add(&bar[XB_XCNT(b.x)], 1u);
    return b;
}
__device__ __forceinline__ void xcd_barrier_complete(unsigned* bar, unsigned x, unsigned& nloc, unsigned& nx) {
    const unsigned G = gridDim.x * gridDim.y * gridDim.z;
    unsigned sum, cnt, mine, sp = 0u;
    for (;;) {
        sum = 0u; cnt = 0u; mine = 0u;
#pragma unroll
        for (unsigned j = 0; j < 16; ++j) { const unsigned c = xb_ld(&bar[XB_XCNT(j)]); sum += c; cnt += (c > 0u) ? 1u : 0u; mine = (j == x) ? c : mine; }
        if (sum == G) break;
        __builtin_amdgcn_s_sleep(1);
        if ((++sp & 255u) == 0u) { if (xb_ld(&bar[XB_TMO])) break; if (sp > XB_SPIN_CAP) { atomicAdd(&bar[XB_TMO], 1u); break; } }
    }
    nloc = mine > 0u ? mine : 1u; nx = cnt > 0u ? cnt : 1u;
}
__device__ __forceinline__ void xcd_barrier(const XcdBarrier& b) {
    asm volatile("s_waitcnt vmcnt(0)" ::: "memory");
    __syncthreads();
    if (threadIdx.x == 0) {
        unsigned* bar = b.bar;
        __builtin_amdgcn_s_waitcnt(0);
        unsigned nloc = b.st[0], nx = b.st[1];
        if (nloc == 0u) { xcd_barrier_complete(bar, b.x, nloc, nx); b.st[0] = nloc; b.st[1] = nx; }
        const unsigned old = xb_add(&bar[XB_XSUB(b.x)], 1u);
        const unsigned gen = old / nloc;
        if (old + 1u == (gen + 1u) * nloc) {
            __builtin_amdgcn_fence(__ATOMIC_RELEASE, "agent");
            asm volatile("s_waitcnt vmcnt(0)" ::: "memory");
            const unsigned og = xb_add(&bar[XB_TOP], 1u);
            const unsigned tg = og / nx;
            if (og + 1u == (tg + 1u) * nx) xb_add(&bar[XB_TOPGEN], 1u);
            else XB_SPIN(xb_ld(&bar[XB_TOPGEN]) == tg, bar);
            __builtin_amdgcn_fence(__ATOMIC_ACQUIRE, "agent");
            xb_add(&bar[XB_XGEN(b.x)], 1u);
            asm volatile("s_waitcnt vmcnt(0)" ::: "memory");
        } else {
            XB_SPIN(xb_ld(&bar[XB_XGEN(b.x)]) == gen, bar);
            __builtin_amdgcn_fence(__ATOMIC_ACQUIRE, "agent");
            asm volatile("s_waitcnt vmcnt(0)" ::: "memory");
        }
    }
    __syncthreads();
}

struct Args { const float* in[35]; float* out; unsigned char* ws; int ph_lo, ph_hi, li, pad; };
struct Frame {
    LAS unsigned char* lds;
    unsigned char* ws; float* out;
    int tid, lane, wave, bid, G;
};
enum { I_X = 0, I_P, I_WIN, I_PEK, I_W1K, I_W2K, I_PEV, I_W1V, I_W2V, I_MU, I_W0, I_WUP, I_A0, I_AUP, I_GUP, I_KK, I_KA, I_RK, I_LNG, I_LNB, I_WOUT,
       I_LN1G, I_LN1B, I_RW, I_RB, I_EWG, I_EBG, I_EWU, I_EBU, I_EWD, I_EBD, I_LN2G, I_LN2B, I_PLEW, I_PLEG };

struct GemmDesc {
    const bf16* A; int lda; const int* rowidx;
    const bf16* Bt; int ldb;
    int Mrows, N, K;
    const int* block_e; size_t bstride; const int* nblk;
    int ea, eb;
    int kext;
};
template <bool PAIR, class Epi>
__device__ __forceinline__ void ngemm_phase(Frame& F, const GemmDesc& g, const Epi& E) {
    LAS float* As = (LAS float*)F.lds;
    LAS float* Bs = As + 32 * 132;
    LAS float* Bu = Bs + 32 * 132;
    const int tid = F.tid, ty = tid >> 5, tx = tid & 31;
    const int lrow = tid >> 2, lkc = (tid & 3) * 8;
    const int ntm = g.Mrows / 128, ntn = PAIR ? g.N / 256 : g.N / 128;
    const int mlive = g.nblk ? (*g.nblk) * 256 : g.Mrows;
    for (int tile = F.bid; tile < ntm * ntn; tile += F.G) {
        const int tm = tile / ntn, tn = tile % ntn, m0 = tm * 128;
        if (m0 >= mlive) continue;
        const int e = g.block_e ? g.block_e[m0 >> 8] : 0;
        const bf16* Bt = g.Bt + (size_t)e * g.bstride;
        const int arow = g.rowidx ? g.rowidx[m0 + lrow] : (m0 + lrow);
        const bf16* ap = g.A + (size_t)arow * g.lda + lkc;
        const bf16* bp = Bt + (size_t)((PAIR ? tn * 256 : tn * 128) + lrow) * g.ldb + lkc;
        const bf16* bup = bp + (size_t)128 * g.ldb;
        f32x4 acc[8], accu[8];
#pragma unroll
        for (int i = 0; i < 8; ++i) { acc[i] = (f32x4){0.f, 0.f, 0.f, 0.f}; accu[i] = (f32x4){0.f, 0.f, 0.f, 0.f}; }
        for (int k0 = 0; k0 < g.K; k0 += 32) {
            const u32x4 av = *(const u32x4*)(ap + k0), bv = *(const u32x4*)(bp + k0);
            u32x4 uv = (u32x4){0u, 0u, 0u, 0u}; if (PAIR) uv = *(const u32x4*)(bup + k0);
            __syncthreads();
#pragma unroll
            for (int j = 0; j < 4; ++j) {
                As[(lkc + 2 * j) * 132 + lrow] = bflo(av[j]); As[(lkc + 2 * j + 1) * 132 + lrow] = bfhi(av[j]);
                Bs[(lkc + 2 * j) * 132 + lrow] = bflo(bv[j]); Bs[(lkc + 2 * j + 1) * 132 + lrow] = bfhi(bv[j]);
                if (PAIR) { Bu[(lkc + 2 * j) * 132 + lrow] = bflo(uv[j]); Bu[(lkc + 2 * j + 1) * 132 + lrow] = bfhi(uv[j]); }
            }
            __syncthreads();
#pragma unroll 4
            for (int k = 0; k < 32; ++k) {
                const f32x4 a0 = *(const LAS f32x4*)(As + k * 132 + ty * 8), a1 = *(const LAS f32x4*)(As + k * 132 + ty * 8 + 4);
                const f32x4 b = *(const LAS f32x4*)(Bs + k * 132 + tx * 4);
                acc[0] += a0.x * b; acc[1] += a0.y * b; acc[2] += a0.z * b; acc[3] += a0.w * b;
                acc[4] += a1.x * b; acc[5] += a1.y * b; acc[6] += a1.z * b; acc[7] += a1.w * b;
                if (PAIR) { const f32x4 u = *(const LAS f32x4*)(Bu + k * 132 + tx * 4);
                    accu[0] += a0.x * u; accu[1] += a0.y * u; accu[2] += a0.z * u; accu[3] += a0.w * u;
                    accu[4] += a1.x * u; accu[5] += a1.y * u; accu[6] += a1.z * u; accu[7] += a1.w * u; }
            }
        }
        const int col = (PAIR ? tn * 128 : tn * 128) + tx * 4;
#pragma unroll
        for (int i = 0; i < 8; ++i) { const int row = m0 + ty * 8 + i;
            if constexpr (PAIR) E.stp(row, col, acc[i], accu[i], e); else E.st(row, col, acc[i], e); }
    }
    __syncthreads();
}

__device__ __forceinline__ void st_bf16x4(bf16* p, f32x4 v) { u32x2 w; w.x = pk2(v.x, v.y); w.y = pk2(v.z, v.w); *(u32x2*)p = w; }
__device__ __forceinline__ void st_bf16x8(bf16* p, f32x4 a, f32x4 b) { u32x4 w; w.x = pk2(a.x, a.y); w.y = pk2(a.z, a.w); w.z = pk2(b.x, b.y); w.w = pk2(b.z, b.w); *(u32x4*)p = w; }
struct EpiZ { static constexpr bool PERM = true; bf16* Z; __device__ __forceinline__ void st(int r, int c, f32x4 v, int) const { st_bf16x4(Z + (size_t)r * NZ + c, v); }
    __device__ __forceinline__ void st8(int r, int c, f32x4 a, f32x4 b, int) const { st_bf16x8(Z + (size_t)r * NZ + c, a, b); } };
struct EpiCmp { float* H; __device__ __forceinline__ void st(int r, int c, f32x4 v, int) const { if (c < 64) { f32x4 o; o.x = gelu_tanh(v.x); o.y = gelu_tanh(v.y); o.z = gelu_tanh(v.z); o.w = gelu_tanh(v.w); *(f32x4*)(H + (size_t)r * 64 + c) = o; } } };
struct EpiCmpPart { float* H; __device__ __forceinline__ void st(int r, int c, f32x4 v, int) const { if (c < 64) *(f32x4*)(H + (size_t)r * 64 + c) = v; } };
struct EpiDecay { float* O; const float* w0;
    __device__ __forceinline__ float f(float x) const { const float y = -x; const float sp = fmaxf(y, 0.f) + __logf(1.0f + __expf(-fabsf(y))); return __expf(-__expf(-sp - 0.5f)); }
    __device__ __forceinline__ void st(int r, int c, f32x4 v, int) const { const f32x4 b = *(const f32x4*)(w0 + c); f32x4 o; o.x = f(v.x + b.x); o.y = f(v.y + b.y); o.z = f(v.z + b.z); o.w = f(v.w + b.w); *(f32x4*)(O + (size_t)r * 1024 + c) = o; } };
struct EpiASig { float* O; const float* a0;
    __device__ __forceinline__ void st(int r, int c, f32x4 v, int) const { const f32x4 b = *(const f32x4*)(a0 + c); f32x4 o; o.x = sigmoidf_(v.x + b.x); o.y = sigmoidf_(v.y + b.y); o.z = sigmoidf_(v.z + b.z); o.w = sigmoidf_(v.w + b.w); *(f32x4*)(O + (size_t)r * 1024 + c) = o; } };
struct EpiLora { static constexpr bool PERM = true; float* DEC; float* ASIG; bf16* G; const float* w0; const float* a0;
    __device__ __forceinline__ float fd(float x) const { const float y = -x; const float sp = fmaxf(y, 0.f) + __logf(1.0f + __expf(-fabsf(y))); return __expf(-__expf(-sp - 0.5f)); }
    __device__ __forceinline__ void st8(int r, int c, f32x4 a, f32x4 b, int e) const { const int m = r - e * M;
        if (e == 0) { const f32x4 b0 = *(const f32x4*)(w0 + c), b1 = *(const f32x4*)(w0 + c + 4); f32x4 o0, o1; o0.x = fd(a.x + b0.x); o0.y = fd(a.y + b0.y); o0.z = fd(a.z + b0.z); o0.w = fd(a.w + b0.w); o1.x = fd(b.x + b1.x); o1.y = fd(b.y + b1.y); o1.z = fd(b.z + b1.z); o1.w = fd(b.w + b1.w);
            *(f32x4*)(DEC + (size_t)m * 1024 + c) = o0; *(f32x4*)(DEC + (size_t)m * 1024 + c + 4) = o1; }
        else if (e == 1) { const f32x4 b0 = *(const f32x4*)(a0 + c), b1 = *(const f32x4*)(a0 + c + 4); f32x4 o0, o1; o0.x = sigmoidf_(a.x + b0.x); o0.y = sigmoidf_(a.y + b0.y); o0.z = sigmoidf_(a.z + b0.z); o0.w = sigmoidf_(a.w + b0.w); o1.x = sigmoidf_(b.x + b1.x); o1.y = sigmoidf_(b.y + b1.y); o1.z = sigmoidf_(b.z + b1.z); o1.w = sigmoidf_(b.w + b1.w);
            *(f32x4*)(ASIG + (size_t)m * 1024 + c) = o0; *(f32x4*)(ASIG + (size_t)m * 1024 + c + 4) = o1; }
        else st_bf16x8(G + (size_t)m * 1024 + c, a, b); }
    __device__ __forceinline__ void st(int, int, f32x4, int) const {} };
struct EpiF32 { float* O; int ld; __device__ __forceinline__ void st(int r, int c, f32x4 v, int) const { *(f32x4*)(O + (size_t)r * ld + c) = v; } };
struct EpiPre1 { float* O; const float* x; __device__ __forceinline__ void st(int r, int c, f32x4 v, int) const { const f32x4 xv = *(const f32x4*)(x + (size_t)r * D + c); *(f32x4*)(O + (size_t)r * D + c) = ALPHA * xv + v; } };
struct EpiSwiglu { static constexpr bool PERM = true; unsigned char* H; const float* bg; const float* bu;
    __device__ __forceinline__ float f(float g, float u) const { g = fminf(g, 7.0f); u = fminf(fmaxf(u, -7.0f), 7.0f); return g * sigmoidf_(1.702f * g) * (u + 1.0f); }
    __device__ __forceinline__ void stp(int r, int c, f32x4 g, f32x4 u, int e) const { const f32x4 b0 = *(const f32x4*)(bg + (size_t)e * D + c), b1 = *(const f32x4*)(bu + (size_t)e * D + c);
        f32x4 o; o.x = f(g.x + b0.x, u.x + b1.x); o.y = f(g.y + b0.y, u.y + b1.y); o.z = f(g.z + b0.z, u.z + b1.z); o.w = f(g.w + b0.w, u.w + b1.w); *(unsigned*)(H + (size_t)r * D + c) = pk_fp8x4(o.x * FP8_SA2, o.y * FP8_SA2, o.z * FP8_SA2, o.w * FP8_SA2); }
    __device__ __forceinline__ unsigned q4(int c, f32x4 g, f32x4 u, int e) const { const f32x4 b0 = *(const f32x4*)(bg + (size_t)e * D + c), b1 = *(const f32x4*)(bu + (size_t)e * D + c);
        return pk_fp8x4(f(g.x + b0.x, u.x + b1.x) * FP8_SA2, f(g.y + b0.y, u.y + b1.y) * FP8_SA2, f(g.z + b0.z, u.z + b1.z) * FP8_SA2, f(g.w + b0.w, u.w + b1.w) * FP8_SA2); }
    __device__ __forceinline__ void stp8(int r, int c, f32x4 g0, f32x4 g1, f32x4 u0, f32x4 u1, int e) const { u32x2 w; w.x = q4(c, g0, u0, e); w.y = q4(c + 4, g1, u1, e); *(u32x2*)(H + (size_t)r * D + c) = w; } };
struct EpiDown { static constexpr bool PERM = true; bf16* O; const float* bd; __device__ __forceinline__ void st(int r, int c, f32x4 v, int e) const { const f32x4 b = *(const f32x4*)(bd + (size_t)e * D + c); st_bf16x4(O + (size_t)r * D + c, v + b); }
    __device__ __forceinline__ void st8(int r, int c, f32x4 a, f32x4 b, int e) const { const f32x4 b0 = *(const f32x4*)(bd + (size_t)e * D + c), b1 = *(const f32x4*)(bd + (size_t)e * D + c + 4); st_bf16x8(O + (size_t)r * D + c, a + b0, b + b1); } };
struct EpiBf16 { static constexpr bool PERM = true; bf16* O; int ld; __device__ __forceinline__ void st(int r, int c, f32x4 v, int) const { st_bf16x4(O + (size_t)r * ld + c, v); }
    __device__ __forceinline__ void st8(int r, int c, f32x4 a, f32x4 b, int) const { st_bf16x8(O + (size_t)r * ld + c, a, b); } };
struct EpiFinal { float* out; const bf16* PL;
    __device__ __forceinline__ void st(int r, int c, f32x4 v, int) const { const size_t o = (size_t)r * D + c; const f32x4 h = *(const f32x4*)(out + o); const u32x2 pw = *(const u32x2*)(PL + o);
        f32x4 q; q.x = h.x + sigmoidf_(v.x) * bflo(pw.x); q.y = h.y + sigmoidf_(v.y) * bfhi(pw.x); q.z = h.z + sigmoidf_(v.z) * bflo(pw.y); q.w = h.w + sigmoidf_(v.w) * bfhi(pw.y); *(f32x4*)(out + o) = q; } };


namespace pg8 {
typedef short bf16x8 __attribute__((ext_vector_type(8)));
constexpr int BM = 256, BK = 64, HALF = 128, HTB = HALF * BK * 2, STAGE_BYTES = 8 * HTB, NXCD = 8, WGM = 8;
__device__ __forceinline__ int lds_byte(int r, int c) { const int st = (r >> 4) * 2 + (c >> 5), rr = r & 15, cc = c & 31, ob = rr * 64 + cc * 2; return st * 1024 + (ob ^ (((ob >> 9) & 1) << 5)); }
__device__ __forceinline__ void stage_rc(int b, int& R, int& C) { const int st = b / 1024, sb = b % 1024, swz = sb ^ (((sb >> 9) & 1) << 5); R = (st >> 1) * 16 + swz / 64; C = (st & 1) * 32 + (swz % 64) / 2; }
struct Unit { int pm, pn; };
struct StaticOrder {
    int nM, nN, nwg, G, c;
    __device__ void init(int nM_, int nN_, int G_, int c_) { nM = nM_; nN = nN_; nwg = nM * nN; G = G_; c = c_; }
    __device__ bool next(int i, Unit& u) const {
        const long L = (long)i * G + c; if (L >= nwg) return false;
        int wgid = (int)L; { const int q = nwg / NXCD, r = nwg % NXCD, xcd = wgid % NXCD, off = wgid / NXCD; wgid = (xcd < r ? xcd * (q + 1) : r * (q + 1) + (xcd - r) * q) + off; }
        const int nig = WGM * nN, gid = wgid / nig, fm = gid * WGM, gsz = (nM - fm) < WGM ? (nM - fm) : WGM;
        u.pm = fm + ((wgid % nig) % gsz); u.pn = (wgid % nig) / gsz; return true;
    }
};
template <class E, class = void> struct epi_perm { static constexpr bool value = false; };
template <class E> struct epi_perm<E, decltype((void)E::PERM)> { static constexpr bool value = E::PERM; };
__device__ __forceinline__ int perm32(int rho) { const int n = rho >> 4, i = rho & 15; return 8 * (i >> 2) + 4 * n + (i & 3); }
template <bool PAIR, class Epi>
__device__ __forceinline__ void epilogue(const f32x4 (&acc)[2][2][4][2], const Unit& u, int e, const Epi& E, int wr, int wc, int fr, int fq) {
    const int row0 = u.pm * BM + wr * 64 + fr;
#pragma unroll
    for (int ai = 0; ai < 2; ++ai)
#pragma unroll
        for (int m = 0; m < 4; ++m) { const int row = row0 + ai * HALF + m * 16;
            if constexpr (PAIR) {
                if constexpr (epi_perm<Epi>::value) E.stp8(row, u.pn * HALF + wc * 32 + 8 * fq, acc[ai][0][m][0], acc[ai][0][m][1], acc[ai][1][m][0], acc[ai][1][m][1], e);
                else {
#pragma unroll
                    for (int n = 0; n < 2; ++n) E.stp(row, u.pn * HALF + wc * 32 + n * 16 + 4 * fq, acc[ai][0][m][n], acc[ai][1][m][n], e); }
            } else if constexpr (epi_perm<Epi>::value) {
#pragma unroll
                for (int bj = 0; bj < 2; ++bj) E.st8(row, u.pn * BM + bj * HALF + wc * 32 + 8 * fq, acc[ai][bj][m][0], acc[ai][bj][m][1], e);
            } else {
#pragma unroll
                for (int bj = 0; bj < 2; ++bj)
#pragma unroll
                    for (int n = 0; n < 2; ++n) E.st(row, u.pn * BM + bj * HALF + wc * 32 + n * 16 + 4 * fq, acc[ai][bj][m][n], e);
            } }
}
typedef int i32x8 __attribute__((ext_vector_type(8)));
__device__ __forceinline__ i32x8 cat8(const bf16x8& lo, const bf16x8& hi) { const u32x4 a = __builtin_bit_cast(u32x4, lo), b = __builtin_bit_cast(u32x4, hi); i32x8 r; r[0] = (int)a.x; r[1] = (int)a.y; r[2] = (int)a.z; r[3] = (int)a.w; r[4] = (int)b.x; r[5] = (int)b.y; r[6] = (int)b.z; r[7] = (int)b.w; return r; }
template <bool PAIR, bool FP8, class Epi>
__device__ __forceinline__ void gemm_phase(LAS unsigned char* lds, const GemmDesc& g, const Epi& E, int G, int cid) {
    const int tid = threadIdx.x, wid = __builtin_amdgcn_readfirstlane(tid >> 6), lane = tid & 63, wr = wid >> 2, wc = wid & 3, fr = lane & 15, fq = lane >> 4;
    const unsigned pitchB = FP8 ? (unsigned)g.K : (unsigned)g.K * 2u;
    const int nt = g.kext ? (int)((FP8 ? (unsigned)g.kext : (unsigned)g.kext * 2u) / 128u) : (int)(pitchB / 128u);
    const int sc_a = g.ea, sc_b = g.eb;
    StaticOrder S; S.init(g.nblk ? *g.nblk : g.Mrows / BM, g.N / BM, G, cid);
    unsigned voffA[2], voffB[2];
#pragma unroll
    for (int i = 0; i < 2; ++i) { int R, C; stage_rc(tid * 16 + i * 8192, R, C); const int Rb = epi_perm<Epi>::value ? ((R & ~31) + perm32(R & 31)) : R;
        voffA[i] = (unsigned)R * pitchB + (unsigned)C * 2u; voffB[i] = (unsigned)Rb * pitchB + (unsigned)C * 2u; }
    const size_t kstep = (size_t)(BK * 2);
    const size_t hstep = (size_t)HALF * pitchB;
    const size_t tstep = 2 * hstep;
    const unsigned ldsw = (unsigned)wid * 1024u;
    const int aoff = lds_byte(wr * 64 + fr, fq * 8), boff = lds_byte(wc * 32 + fr, fq * 8);
    const char* gA = (const char*)g.A;
#define PG8_SA(b, h) (((b) * 2 + (h)) * HTB)
#define PG8_SB(b, h) ((4 + (b) * 2 + (h)) * HTB)
#define PG8_STAGE(bufoff, gbase, voff) do { _Pragma("unroll") for (int _i = 0; _i < 2; ++_i) \
        __builtin_amdgcn_global_load_lds((const unsigned*)((const char*)(gbase) + (voff)[_i]), (LAS unsigned*)(lds + (bufoff) + ldsw + _i * 8192), 16, 0, 0); } while (0)
#define PG8_LD8(dst, off) do { const u32x4 lo_ = *(const LAS u32x4*)(lds + (off)), hi_ = *(const LAS u32x4*)(lds + (off) + 1024); \
        dst[0] = (int)lo_.x; dst[1] = (int)lo_.y; dst[2] = (int)lo_.z; dst[3] = (int)lo_.w; dst[4] = (int)hi_.x; dst[5] = (int)hi_.y; dst[6] = (int)hi_.z; dst[7] = (int)hi_.w; } while (0)
#define PG8_LDA(dst, b, h) do { _Pragma("unroll") for (int m = 0; m < 4; ++m) { if constexpr (FP8) PG8_LD8(dst##8[m], PG8_SA(b, h) + aoff + m * 2048); else { _Pragma("unroll") for (int k = 0; k < 2; ++k) dst[m][k] = *(const LAS bf16x8*)(lds + PG8_SA(b, h) + aoff + m * 2048 + k * 1024); } } } while (0)
#define PG8_LDB(dst, b, h) do { _Pragma("unroll") for (int n = 0; n < 2; ++n) { if constexpr (FP8) PG8_LD8(dst##8[n], PG8_SB(b, h) + boff + n * 2048); else { _Pragma("unroll") for (int k = 0; k < 2; ++k) dst[n][k] = *(const LAS bf16x8*)(lds + PG8_SB(b, h) + boff + n * 2048 + k * 1024); } } } while (0)
#define PG8_MMA(ai, bj, At, Bt) do { __builtin_amdgcn_s_setprio(1); _Pragma("unroll") for (int m = 0; m < 4; ++m) _Pragma("unroll") for (int n = 0; n < 2; ++n) { \
        if constexpr (FP8) asm volatile("v_mfma_scale_f32_16x16x128_f8f6f4 %0, %1, %2, %0, %3, %4 op_sel_hi:[0,0,0]" : "+v"(acc[ai][bj][m][n]) : "v"(Bt##8[n]), "v"(At##8[m]), "v"(sc_b), "v"(sc_a));   \
        else { _Pragma("unroll") for (int k = 0; k < 2; ++k) acc[ai][bj][m][n] = __builtin_amdgcn_mfma_f32_16x16x32_bf16(Bt[n][k], At[m][k], acc[ai][bj][m][n], 0, 0, 0); } } __builtin_amdgcn_s_setprio(0); } while (0)
#define PG8_WAIT_V(n) asm volatile("s_waitcnt vmcnt(" #n ")" ::: "memory")
#define PG8_WAIT_L(n) asm volatile("s_waitcnt lgkmcnt(" #n ")" ::: "memory")
#define PG8_BAR __builtin_amdgcn_s_barrier()
#define PG8_SCHED __builtin_amdgcn_sched_barrier(0)
    Unit cur, nxt; int ui = 0;
    if (!S.next(0, cur)) return;
    f32x4 acc[2][2][4][2];
#pragma unroll
    for (int a = 0; a < 2; ++a)
#pragma unroll
        for (int b = 0; b < 2; ++b)
#pragma unroll
            for (int m = 0; m < 4; ++m)
#pragma unroll
                for (int n = 0; n < 2; ++n) acc[a][b][m][n] = (f32x4){0.f, 0.f, 0.f, 0.f};
    bf16x8 At[4][2], B0[2][2], B1[2][2];
    i32x8 At8[4], B08[2], B18[2];
    int ecur = g.block_e ? g.block_e[cur.pm] : 0;
    const char* cA = gA + (size_t)cur.pm * tstep;
    const char* cB = (const char*)g.Bt + (size_t)ecur * g.bstride * (FP8 ? 1 : 2) + (size_t)cur.pn * tstep;
    PG8_STAGE(PG8_SB(0, 0), cB, voffB); PG8_STAGE(PG8_SB(0, 1), cB + hstep, voffB); PG8_STAGE(PG8_SA(0, 0), cA, voffA); PG8_STAGE(PG8_SA(0, 1), cA + hstep, voffA);
    if (wr == 1) PG8_BAR;
    PG8_WAIT_V(2); PG8_BAR;
    PG8_STAGE(PG8_SB(1, 0), cB + kstep, voffB); PG8_STAGE(PG8_SA(1, 0), cA + kstep, voffA); PG8_STAGE(PG8_SB(1, 1), cB + hstep + kstep, voffB);
    PG8_WAIT_V(6); PG8_BAR;
    for (;;) {
        const bool has_next = S.next(ui + 1, nxt);
        int enxt = ecur; const char* nB = cB; const char* nA = cA;
        if (has_next) { enxt = g.block_e ? g.block_e[nxt.pm] : 0; nA = gA + (size_t)nxt.pm * tstep; nB = (const char*)g.Bt + (size_t)enxt * g.bstride * (FP8 ? 1 : 2) + (size_t)nxt.pn * tstep; }
        for (int t = 0; t < nt; t += 2) {
            const bool last = (t == nt - 2);
            const char* a1 = cA + (size_t)(t + 1) * kstep;
            const char* a2 = last ? nA : cA + (size_t)(t + 2) * kstep; const char* b2 = last ? nB : cB + (size_t)(t + 2) * kstep;
            const char* a3 = a2 + kstep; const char* b3 = b2 + kstep;
            PG8_LDB(B0, 0, 0); PG8_LDB(B1, 0, 1); PG8_SCHED; PG8_LDA(At, 0, 0); PG8_STAGE(PG8_SA(1, 1), a1 + hstep, voffA);
            PG8_WAIT_V(8); PG8_WAIT_L(0); PG8_BAR; PG8_MMA(0, 0, At, B0); PG8_MMA(0, 1, At, B1); PG8_BAR; PG8_SCHED;
            PG8_LDA(At, 0, 1); PG8_STAGE(PG8_SB(0, 0), b2, voffB); PG8_STAGE(PG8_SB(0, 1), b2 + hstep, voffB); PG8_STAGE(PG8_SA(0, 0), a2, voffA);
            PG8_WAIT_V(8); PG8_WAIT_L(0); PG8_BAR; PG8_MMA(1, 0, At, B0); PG8_MMA(1, 1, At, B1); PG8_BAR; PG8_SCHED;
            PG8_LDB(B0, 1, 0); PG8_LDB(B1, 1, 1); PG8_SCHED; PG8_LDA(At, 1, 0); PG8_STAGE(PG8_SA(0, 1), a2 + hstep, voffA);
            PG8_WAIT_V(8); PG8_WAIT_L(0); PG8_BAR; PG8_MMA(0, 0, At, B0); PG8_MMA(0, 1, At, B1); PG8_BAR; PG8_SCHED;
            PG8_LDA(At, 1, 1); PG8_STAGE(PG8_SB(1, 0), b3, voffB); PG8_STAGE(PG8_SB(1, 1), b3 + hstep, voffB); PG8_STAGE(PG8_SA(1, 0), a3, voffA);
            PG8_WAIT_V(8); PG8_WAIT_L(0); PG8_BAR; PG8_MMA(1, 0, At, B0); PG8_MMA(1, 1, At, B1); PG8_BAR; PG8_SCHED;
        }
        if constexpr (FP8) asm volatile("s_nop 15\n\ts_nop 15" ::: "memory");
        if (wr == 0) PG8_BAR;
        epilogue<PAIR, Epi>(acc, cur, ecur, E, wr, wc, fr, fq);
        if (!has_next) break;
#pragma unroll
        for (int a = 0; a < 2; ++a)
#pragma unroll
            for (int b = 0; b < 2; ++b)
#pragma unroll
                for (int m = 0; m < 4; ++m)
#pragma unroll
                    for (int n = 0; n < 2; ++n) acc[a][b][m][n] = (f32x4){0.f, 0.f, 0.f, 0.f};
        cur = nxt; cA = nA; cB = nB; ecur = enxt; ++ui;
        if (wr == 1) PG8_BAR;
    }
    PG8_WAIT_V(0);
    PG8_BAR;
#undef PG8_SA
#undef PG8_SB
#undef PG8_STAGE
#undef PG8_LDA
#undef PG8_LD8
#undef PG8_LDB
#undef PG8_MMA
#undef PG8_WAIT_V
#undef PG8_WAIT_L
#undef PG8_BAR
#undef PG8_SCHED
}
}

#ifndef NAIVE_GEMM
#define NAIVE_GEMM 0
#endif
template <class Epi> __device__ __forceinline__ void gemm_run_part(Frame& F, const GemmDesc& g, const Epi& E, int G, int cid) {
    pg8::gemm_phase<false, false, Epi>(F.lds, g, E, G, cid);
    __syncthreads();
}
template <bool PAIR, class Epi, bool FP8 = false> __device__ __forceinline__ void gemm_run(Frame& F, const GemmDesc& g, const Epi& E) {
#if NAIVE_GEMM
    static_assert(!FP8, "the naive GEMM has no fp8 path");
    ngemm_phase<PAIR, Epi>(F, g, E);
#else
    pg8::gemm_phase<PAIR, FP8, Epi>(F.lds, g, E, F.G, F.bid);
    __syncthreads();
#endif
}

__device__ __forceinline__ void transpose_item(const float* W, int K, int N, bf16* WT, int Kp, size_t row0, int k0, int n0, LAS float* scr, int lane) {
    const int n = n0 + (lane & 31);
#pragma unroll 8
    for (int i = 0; i < 32; ++i) { const int kk = 2 * i + (lane >> 5), k = k0 + kk; scr[kk * 33 + (lane & 31)] = (k < K && n < N) ? W[(size_t)k * N + n] : 0.f; }
    LDS_WAIT(); asm volatile("" ::: "memory");
    const int c = lane & 7;
#pragma unroll
    for (int j = 0; j < 4; ++j) { const int nn = (lane >> 3) + 8 * j; const LAS float* s = scr + (8 * c) * 33 + nn;
        u32x4 o; o.x = pk2(s[0 * 33], s[1 * 33]); o.y = pk2(s[2 * 33], s[3 * 33]); o.z = pk2(s[4 * 33], s[5 * 33]); o.w = pk2(s[6 * 33], s[7 * 33]);
        *(u32x4*)(WT + (row0 + nn) * Kp + k0 + 8 * c) = o; }
    LDS_WAIT(); asm volatile("" ::: "memory");
}
__device__ __forceinline__ void tb_load(const float* W, int N, int k0, int n0, f32x4 (&v)[16], int lane) {
    const int kr = lane >> 4, n4 = n0 + (lane & 15) * 4; const bool ok = n4 < N;
#pragma unroll
    for (int i = 0; i < 16; ++i) v[i] = ok ? __builtin_nontemporal_load((const f32x4*)(W + (size_t)(k0 + 4 * i + kr) * N + n4)) : (f32x4){0.f, 0.f, 0.f, 0.f};
}
__device__ __forceinline__ void tb_store(bf16* WT, int Kp, int k0, int n0, const f32x4 (&v)[16], int lane) {
    const int R = lane >> 4, c16 = lane & 15;
    unsigned od[32];
#pragma unroll
    for (int i = 0; i < 16; ++i) {
        unsigned x0 = __float_as_uint(v[i].x), x1 = __float_as_uint(v[i].y), x2 = __float_as_uint(v[i].z), x3 = __float_as_uint(v[i].w);
        { const auto q = __builtin_amdgcn_permlane16_swap(x0, x1, false, false); x0 = q[0]; x1 = q[1]; }
        { const auto q = __builtin_amdgcn_permlane16_swap(x2, x3, false, false); x2 = q[0]; x3 = q[1]; }
        { const auto q = __builtin_amdgcn_permlane32_swap(x0, x2, false, false); x0 = q[0]; x2 = q[1]; }
        { const auto q = __builtin_amdgcn_permlane32_swap(x1, x3, false, false); x1 = q[0]; x3 = q[1]; }
        od[2 * i] = pk2(__uint_as_float(x0), __uint_as_float(x1)); od[2 * i + 1] = pk2(__uint_as_float(x2), __uint_as_float(x3));
    }
    bf16* dp = WT + (size_t)(n0 + 4 * c16 + R) * Kp + k0;
#pragma unroll
    for (int j = 0; j < 8; ++j) *(u32x4*)(dp + 8 * j) = (u32x4){od[4 * j], od[4 * j + 1], od[4 * j + 2], od[4 * j + 3]};
}
__device__ __forceinline__ void p0_prologue(Frame& F, const Args& a) {
    LAS float* scr = (LAS float*)(F.lds + F.wave * 16384);
    unsigned char* ws = F.ws;
    const int gw = F.bid * 8 + F.wave, NGW = F.G * 8;
    {
        constexpr int NB0 = 96 * 32, NB1 = 32 * 32, NBIG = NB0 + 2 * NB1;
        f32x4 va[16];
        for (int it = gw; it < NBIG; it += NGW) {
            const float* W; bf16* WT; int N, r = it;
            if (r < NB0) { W = a.in[I_WIN]; WT = (bf16*)(ws + WS_WIN); N = INC; }
            else if (r < NB0 + NB1) { r -= NB0; W = a.in[I_WOUT]; WT = (bf16*)(ws + WS_WOUT); N = D; }
            else { r -= NB0 + NB1; W = a.in[I_PLEG]; WT = (bf16*)(ws + WS_WPG); N = D; }
            const int kb = r & 31, nb = r >> 5;
            tb_load(W, N, 64 * kb, 64 * nb, va, F.lane); tb_store(WT, D, 64 * kb, 64 * nb, va, F.lane);
        }
    }
    constexpr int I3 = 4 * 64, I4 = 4 * 32, I5 = 4 * 32, I6 = 4 * 32, I7 = 32 * 8, I8 = 32 * 8;
    constexpr int NITEMS = I3 + I4 + I5 + I6 + I7 + I8;
    for (int it = gw; it < NITEMS; it += NGW) {
        int r = it;
#define TR_SIMPLE(cnt, W, K, N, WT, Kp, nblk) if (r < (cnt)) { const int kb = r / (nblk), nb = r % (nblk); transpose_item((W), (K), (N), (bf16*)(WT), (Kp), (size_t)(32 * nb), 64 * kb, 32 * nb, scr, F.lane); continue; } r -= (cnt);
        TR_SIMPLE(I3, a.in[I_PLEW], 256, 2048, ws + WS_WPL, 256, 64)
        TR_SIMPLE(I4, a.in[I_WUP], 96, 1024, ws + WS_WUP, 256, 32)
        TR_SIMPLE(I5, a.in[I_AUP], 96, 1024, ws + WS_AUP, 256, 32)
        TR_SIMPLE(I6, a.in[I_GUP], 256, 1024, ws + WS_GUP, 256, 32)
        TR_SIMPLE(I7, a.in[I_W1K], 2048, 64, ws + WS_CW1K, 2048, 8)
        TR_SIMPLE(I8, a.in[I_W1V], 2048, 64, ws + WS_CW1V, 2048, 8)
#undef TR_SIMPLE
        (void)r;
    }
    const size_t gt = (size_t)F.bid * 512 + F.tid, NT = (size_t)F.G * 512;
    { const float* x = a.in[I_X]; bf16* xb = (bf16*)(ws + WS_XB);
      constexpr size_t NV = (size_t)M * D / 8;
      for (size_t i = gt; i < NV; i += 4 * NT) {
          f32x4 v0[4], v1[4];
#pragma unroll
          for (int q = 0; q < 4; ++q) { const size_t j = i + q * NT; if (j < NV) { v0[q] = __builtin_nontemporal_load((const f32x4*)(x + j * 8)); v1[q] = __builtin_nontemporal_load((const f32x4*)(x + j * 8 + 4)); } }
#pragma unroll
          for (int q = 0; q < 4; ++q) { const size_t j = i + q * NT; if (j < NV) { u32x4 o; o.x = pk2(v0[q].x, v0[q].y); o.y = pk2(v0[q].z, v0[q].w); o.z = pk2(v1[q].x, v1[q].y); o.w = pk2(v1[q].z, v1[q].w); *(u32x4*)(xb + j * 8) = o; } } } }
    { const float* p = a.in[I_P]; bf16* pb = (bf16*)(ws + WS_PB);
      for (size_t i = gt; i < (size_t)M * 256 / 8; i += NT) { const f32x4 v0 = *(const f32x4*)(p + i * 8), v1 = *(const f32x4*)(p + i * 8 + 4);
          u32x4 o; o.x = pk2(v0.x, v0.y); o.y = pk2(v0.z, v0.w); o.z = pk2(v1.x, v1.y); o.w = pk2(v1.z, v1.w); *(u32x4*)(pb + i * 8) = o; } }
    { int* rt = (int*)(ws + WS_ROWTOK); for (size_t i = gt; i < (size_t)MAXROWS; i += NT) rt[i] = 0; }
    if (gt < 192) ((int*)(ws + WS_BLKE + 4096))[gt] = (int)(gt >> 6);
    { const float* rw = a.in[I_RW]; bf16* rwt = (bf16*)(ws + WS_RWT);
      for (size_t i = gt; i < (size_t)32 * D; i += NT) { const int e = (int)(i >> 11), k = (int)(i & 2047); const float w = rw[(size_t)k * 32 + e]; const unsigned hi = f2bf(w); rwt[i] = (bf16)hi; rwt[(size_t)32 * D + i] = (bf16)f2bf(w - bf2f(hi)); } }
}

__device__ __forceinline__ void unpack8(const u32x4 w, float (&f)[8]) { f[0] = bflo(w.x); f[1] = bfhi(w.x); f[2] = bflo(w.y); f[3] = bfhi(w.y); f[4] = bflo(w.z); f[5] = bfhi(w.z); f[6] = bflo(w.w); f[7] = bfhi(w.w); }
__device__ __forceinline__ u32x4 pack8(const float (&f)[8]) { u32x4 o; o.x = pk2(f[0], f[1]); o.y = pk2(f[2], f[3]); o.z = pk2(f[4], f[5]); o.w = pk2(f[6], f[7]); return o; }
__device__ __forceinline__ void ld8f(const float* p, float (&f)[8]) { const f32x4 a = *(const f32x4*)p, b = *(const f32x4*)(p + 4); f[0] = a.x; f[1] = a.y; f[2] = a.z; f[3] = a.w; f[4] = b.x; f[5] = b.y; f[6] = b.z; f[7] = b.w; }
__device__ __forceinline__ void st8f(float* p, const float (&f)[8]) { *(f32x4*)p = (f32x4){f[0], f[1], f[2], f[3]}; *(f32x4*)(p + 4) = (f32x4){f[4], f[5], f[6], f[7]}; }
__device__ __forceinline__ float dpp_sum8(float x) {
    x += __builtin_bit_cast(float, __builtin_amdgcn_update_dpp(0, __builtin_bit_cast(int, x), 0xB1, 0xF, 0xF, true));
    x += __builtin_bit_cast(float, __builtin_amdgcn_update_dpp(0, __builtin_bit_cast(int, x), 0x4E, 0xF, 0xF, true));
    x += __builtin_bit_cast(float, __builtin_amdgcn_update_dpp(0, __builtin_bit_cast(int, x), 0x141, 0xF, 0xF, true));
    return x;
}
__device__ __forceinline__ void shift8(const bf16* Z, size_t zo, int c, bool has_prev, const float* mu, float (&o)[8]) {
    float zc[8], zp[8], m8[8];
    unpack8(*(const u32x4*)(Z + zo + c), zc);
    if (has_prev) unpack8(*(const u32x4*)(Z + zo - NZ + c), zp); else {
#pragma unroll
        for (int i = 0; i < 8; ++i) zp[i] = 0.f; }
    ld8f(mu + (c - ZRW), m8);
#pragma unroll
    for (int i = 0; i < 8; ++i) o[i] = zc[i] + (zp[i] - zc[i]) * m8[i];
}

__device__ __forceinline__ void p2_prep(Frame& F, const Args& a) {
    unsigned char* ws = F.ws;
    const bf16* Z = (const bf16*)(ws + WS_Z);
    const int gw = F.bid * 8 + F.wave, NGW = F.G * 8, lane = F.lane;
    for (int it = gw; it < 2 * 4096; it += NGW) {
        const int kv = it >> 12, row = it & 4095, g = row & 3, c = (row >> 2) & 255, b = row >> 10;
        bf16* dst = (bf16*)(ws + (kv ? WS_ACV : WS_ACK)) + (size_t)row * 2048;
        const float* pe = a.in[kv ? I_PEV : I_PEK];
        const int col0 = (kv ? ZVC : ZKC) + g * 64;
#pragma unroll
        for (int q = 0; q < 4; ++q) {
            const int idx = q * 64 + lane, i = idx >> 3, d8 = (idx & 7) * 8;
            u32x4 o = (u32x4){0u, 0u, 0u, 0u};
            if (c < NCMP) { float z8[8], p8[8]; unpack8(*(const u32x4*)(Z + (size_t)(b * T + 16 * c + i) * NZ + col0 + d8), z8); ld8f(pe + i * 64 + d8, p8);
#pragma unroll
                for (int e = 0; e < 8; ++e) z8[e] += p8[e];
                o = pack8(z8); }
            *(u32x4*)(dst + i * 64 + d8) = o;
        }
    }
    const float* mu = a.in[I_MU];
    bf16* WL = (bf16*)(ws + WS_WL); bf16* AL = (bf16*)(ws + WS_AL); bf16* GLS = (bf16*)(ws + WS_GLS);
    for (int m = gw; m < M; m += NGW) {
        const int t = m & (T - 1);
        float zs[8];
#pragma unroll
        for (int e = 0; e < 8; ++e) zs[e] = 0.f;
        if (lane < 56) shift8(Z, (size_t)m * NZ, ZWL + lane * 8, t != 0, mu, zs);
        if (lane < 32) { float o[8];
#pragma unroll
            for (int e = 0; e < 8; ++e) o[e] = lane < 12 ? tanhf(zs[e]) : 0.f;
            *(u32x4*)(WL + (size_t)m * 256 + lane * 8) = pack8(o); }
        if (lane >= 12 && lane < 44) { float o[8];
#pragma unroll
            for (int e = 0; e < 8; ++e) o[e] = lane < 24 ? zs[e] : 0.f;
            *(u32x4*)(AL + (size_t)m * 256 + (lane - 12) * 8) = pack8(o); }
        if (lane >= 24 && lane < 56) { float o[8];
#pragma unroll
            for (int e = 0; e < 8; ++e) o[e] = sigmoidf_(zs[e]);
            *(u32x4*)(GLS + (size_t)m * 256 + (lane - 24) * 8) = pack8(o); }
    }
}

__device__ __forceinline__ void p4_prep(Frame& F, const Args& a) {
    unsigned char* ws = F.ws;
    const int gw = F.bid * 8 + F.wave, NGW = F.G * 8, lane = F.lane;
    for (int it = gw; it < 2 * 4096; it += NGW) {
        const int kv = it >> 12, row = it & 4095;
        const float* H = (const float*)(ws + (kv ? WS_HCMPV : WS_HCMPK)) + (size_t)row * 64;
        const float* w2 = a.in[kv ? I_W2V : I_W2K];
        const float hv = gelu_tanh(H[lane] + H[(size_t)4096 * 64 + lane]); float o = 0.f;
#pragma unroll 8
        for (int j = 0; j < 64; ++j) o += __shfl(hv, j) * w2[j * 64 + lane];
        ((bf16*)(ws + (kv ? WS_VCMP : WS_KCMP)))[(size_t)row * 64 + lane] = (bf16)f2bf(o);
    }
    const bf16* Z = (const bf16*)(ws + WS_Z);
    const float* mu = a.in[I_MU]; const float* DEC = (const float*)(ws + WS_DEC); const float* ASIG = (const float*)(ws + WS_ASIG);
    const float* kk_w = a.in[I_KK]; const float* ka_w = a.in[I_KA];
    float* SC = (float*)(ws + WS_SC);
    for (int it = gw; it < M * 2; it += NGW) {
        const int m = it >> 1, half = it & 1, t = m & (T - 1), b = m >> 12, col = (half * 64 + lane) * 8, h = col >> 6, j8 = col & 63;
        const size_t zo = (size_t)m * NZ;
        float r[8], k[8], v[8], av[8], w[8], kkw[8], kaw[8];
        shift8(Z, zo, ZR + col, t != 0, mu, r); shift8(Z, zo, ZK + col, t != 0, mu, k); shift8(Z, zo, ZV + col, t != 0, mu, v);
        ld8f(ASIG + (size_t)m * 1024 + col, av); ld8f(DEC + (size_t)m * 1024 + col, w); ld8f(kk_w + col, kkw); ld8f(ka_w + col, kaw);
        float kk[8], ss = 0.f;
#pragma unroll
        for (int e = 0; e < 8; ++e) { kk[e] = k[e] * kkw[e]; ss += kk[e] * kk[e]; }
        const float inv = 1.0f / fmaxf(sqrtf(dpp_sum8(ss)), 1e-12f);
        float k2[8], na[8], bb[8];
#pragma unroll
        for (int e = 0; e < 8; ++e) { kk[e] *= inv; k2[e] = k[e] * (1.0f + (av[e] - 1.0f) * kaw[e]); na[e] = -kk[e]; bb[e] = kk[e] * av[e]; }
        float* sc = SC + ((size_t)(b * 16 + h) * T + t) * 384 + j8;
        st8f(sc, r); st8f(sc + 64, w); st8f(sc + 128, k2); st8f(sc + 192, v); st8f(sc + 256, na); st8f(sc + 320, bb);
        { float rk8[8], sb = 0.f; ld8f(a.in[I_RK] + col, rk8);
#pragma unroll
          for (int e = 0; e < 8; ++e) sb += r[e] * k2[e] * rk8[e];
          const float bonus = dpp_sum8(sb); float bv[8];
#pragma unroll
          for (int e = 0; e < 8; ++e) bv[e] = bonus * v[e];
          *(u32x4*)((bf16*)(ws + WS_ACK) + (size_t)m * 1024 + col) = pack8(bv); }
    }
}

__device__ __forceinline__ float dpp_sum16(float x) {
    x += __builtin_bit_cast(float, __builtin_amdgcn_update_dpp(0, __builtin_bit_cast(int, x), 0xB1, 0xF, 0xF, true));
    x += __builtin_bit_cast(float, __builtin_amdgcn_update_dpp(0, __builtin_bit_cast(int, x), 0x4E, 0xF, 0xF, true));
    x += __builtin_bit_cast(float, __builtin_amdgcn_update_dpp(0, __builtin_bit_cast(int, x), 0x141, 0xF, 0xF, true));
    x += __builtin_bit_cast(float, __builtin_amdgcn_update_dpp(0, __builtin_bit_cast(int, x), 0x140, 0xF, 0xF, true));
    return x;
}
struct CvItem { const float* src; unsigned char* dst; };
__device__ __forceinline__ CvItem cv_decode(const Args& a, unsigned char* ws, int it) {
    const int e = it / 3072, rr = it % 3072, which = rr >> 10, ri = rr & 1023, kb = ri & 31, nb = ri >> 5, n0 = 64 * nb, k0 = 64 * kb;
    CvItem c;
    const float* W = a.in[which == 0 ? I_EWG : (which == 1 ? I_EWU : I_EWD)] + (size_t)e * D * D;
    c.src = W + (size_t)k0 * D + n0;
    const size_t row0 = which == 2 ? (size_t)e * 2048 + n0 : (size_t)e * 4096 + (n0 >> 7) * 256 + (which == 1 ? 128 : 0) + (n0 & 127);
    c.dst = (unsigned char*)(ws + (which == 2 ? WS_WDN : WS_WGU)) + row0 * D + k0;
    return c;
}
__device__ __forceinline__ void cv_load(const CvItem& c, f32x4 (&v)[16], int lane) {
    const int kr = lane >> 4, n4 = (lane & 15) * 4;
#pragma unroll
    for (int i = 0; i < 16; ++i) v[i] = __builtin_nontemporal_load((const f32x4*)(c.src + (size_t)(4 * i + kr) * D + n4));
}
__device__ __forceinline__ void cv_store(const CvItem& cc, const f32x4 (&v)[16], int lane) {
    const int R = lane >> 4, c16 = lane & 15;
    unsigned od[16];
#pragma unroll
    for (int i = 0; i < 16; ++i) {
        unsigned x0 = __float_as_uint(v[i].x), x1 = __float_as_uint(v[i].y), x2 = __float_as_uint(v[i].z), x3 = __float_as_uint(v[i].w);
        { const auto q = __builtin_amdgcn_permlane16_swap(x0, x1, false, false); x0 = q[0]; x1 = q[1]; }
        { const auto q = __builtin_amdgcn_permlane16_swap(x2, x3, false, false); x2 = q[0]; x3 = q[1]; }
        { const auto q = __builtin_amdgcn_permlane32_swap(x0, x2, false, false); x0 = q[0]; x2 = q[1]; }
        { const auto q = __builtin_amdgcn_permlane32_swap(x1, x3, false, false); x1 = q[0]; x3 = q[1]; }
        od[i] = pk_fp8x4(__uint_as_float(x0) * FP8_SW, __uint_as_float(x1) * FP8_SW, __uint_as_float(x2) * FP8_SW, __uint_as_float(x3) * FP8_SW);
    }
    unsigned char* dp = cc.dst + (size_t)(4 * c16 + R) * D;
#pragma unroll
    for (int j = 0; j < 4; ++j) *(u32x4*)(dp + 16 * j) = (u32x4){od[4 * j], od[4 * j + 1], od[4 * j + 2], od[4 * j + 3]};
}
__device__ __forceinline__ void p5_scan_conv(Frame& F, const Args& a, int mode) {
#ifndef SCAN_TC
#define SCAN_TC 32
#endif
    constexpr int TC = SCAN_TC, CHF = TC * 384, NLD = CHF / 1024;
    LAS float* buf = (LAS float*)F.lds;
    LAS unsigned* cnt = (LAS unsigned*)(F.lds + 2 * CHF * 4);
    const int tid = F.tid, lane = F.lane, wave = F.wave;
    if (tid == 0) *cnt = 0u;
    __syncthreads();
    if (wave < 4) { if (mode & 1) {
        const float* SC = (const float*)(F.ws + WS_SC);
        float* Y = (float*)(F.ws + WS_Y);
        const int kq = lane & 15, rl = lane >> 4;
        unsigned target = 0u;
        __builtin_amdgcn_s_setprio(3);
#define BAR4() do { LDS_WAIT(); asm volatile("" ::: "memory"); target += 4u; if (lane == 0) __hip_atomic_fetch_add(cnt, 1u, __ATOMIC_RELAXED, __HIP_MEMORY_SCOPE_WORKGROUP); \
        while (__hip_atomic_load(cnt, __ATOMIC_RELAXED, __HIP_MEMORY_SCOPE_WORKGROUP) < target) __builtin_amdgcn_s_sleep(1); asm volatile("" ::: "memory"); } while (0)
        for (int task = F.bid; task < 256; task += F.G) {
            const int bh = task >> 2, quarter = task & 3, b = bh >> 4, h = bh & 15;
            const int row = (quarter * 4 + wave) * 4 + rl;
            const float* src = SC + (size_t)bh * T * 384;
            BAR4();
#pragma unroll
            for (int i = 0; i < NLD; ++i) *(LAS f32x4*)(buf + (tid + 256 * i) * 4) = *(const f32x4*)(src + (size_t)(tid + 256 * i) * 4);
            BAR4();
            f32x4 S = (f32x4){0.f, 0.f, 0.f, 0.f};
            for (int c = 0; c < T / TC; ++c) {
                f32x4 nx[NLD];
                const bool more = (c + 1 < T / TC);
                if (more) {
#pragma unroll
                    for (int i = 0; i < NLD; ++i) nx[i] = *(const f32x4*)(src + (size_t)(c + 1) * CHF + (size_t)(tid + 256 * i) * 4);
                }
                const LAS float* cb = buf + (c & 1) * CHF;
                f32x4 r4[2], w4[2], k4[2], a4[2], b4[2]; float vv[2];
                r4[0] = *(const LAS f32x4*)(cb + kq * 4); w4[0] = *(const LAS f32x4*)(cb + 64 + kq * 4); k4[0] = *(const LAS f32x4*)(cb + 128 + kq * 4);
                a4[0] = *(const LAS f32x4*)(cb + 256 + kq * 4); b4[0] = *(const LAS f32x4*)(cb + 320 + kq * 4); vv[0] = cb[192 + row];
                float ykeep[TC / 16], yprev = 0.f;
#pragma unroll
                for (int q = 0; q < TC / 16; ++q) ykeep[q] = 0.f;
#pragma unroll
                for (int tt = 0; tt < TC; ++tt) {
                    const int cu = tt & 1, nx1 = cu ^ 1;
                    if (tt + 1 < TC) { const LAS float* sp = cb + (tt + 1) * 384;
                        r4[nx1] = *(const LAS f32x4*)(sp + kq * 4); w4[nx1] = *(const LAS f32x4*)(sp + 64 + kq * 4); k4[nx1] = *(const LAS f32x4*)(sp + 128 + kq * 4);
                        a4[nx1] = *(const LAS f32x4*)(sp + 256 + kq * 4); b4[nx1] = *(const LAS f32x4*)(sp + 320 + kq * 4); vv[nx1] = sp[192 + row]; }
                    __builtin_amdgcn_sched_barrier(0);
                    float sa = (S.x * a4[cu].x + S.y * a4[cu].y) + (S.z * a4[cu].z + S.w * a4[cu].w);
                    sa = dpp_sum16(sa);
                    if (tt > 0) { const float yr = dpp_sum16(yprev); ykeep[(tt - 1) >> 4] = (kq == ((tt - 1) & 15)) ? yr : ykeep[(tt - 1) >> 4]; }
                    S = S * w4[cu] + sa * b4[cu] + vv[cu] * k4[cu];
                    yprev = (S.x * r4[cu].x + S.y * r4[cu].y) + (S.z * r4[cu].z + S.w * r4[cu].w);
                    __builtin_amdgcn_sched_barrier(0);
                }
                { const float yr = dpp_sum16(yprev); ykeep[(TC - 1) >> 4] = (kq == ((TC - 1) & 15)) ? yr : ykeep[(TC - 1) >> 4]; }
#pragma unroll
                for (int q = 0; q < TC / 16; ++q) Y[((size_t)(b * T) + c * TC + 16 * q + kq) * 1024 + h * 64 + row] = ykeep[q];
                if (more) {
#pragma unroll
                    for (int i = 0; i < NLD; ++i) *(LAS f32x4*)(buf + ((c + 1) & 1) * CHF + (tid + 256 * i) * 4) = nx[i];
                }
                BAR4();
            }
        }
#undef BAR4
        __builtin_amdgcn_s_setprio(0);
    } } else if (mode & 2) {
        unsigned char* ws = F.ws;
        const int gw = F.bid * 4 + (wave - 4), NGW = F.G * 4;
        constexpr int NIT = NE * 3 * 1024;
        f32x4 va[16], vb[16];
        int it = gw;
        CvItem ca = cv_decode(a, ws, it < NIT ? it : 0), cb = ca;
        if (it < NIT) cv_load(ca, va, lane);
        for (; it < NIT; it += 2 * NGW) {
            const int it1 = it + NGW, it2 = it + 2 * NGW;
            if (it1 < NIT) { cb = cv_decode(a, ws, it1); cv_load(cb, vb, lane); }
            cv_store(ca, va, lane);
            if (it1 < NIT) {
                if (it2 < NIT) { ca = cv_decode(a, ws, it2); cv_load(ca, va, lane); }
                cv_store(cb, vb, lane);
            }
        }
    }
    __syncthreads();
}

__device__ __forceinline__ void softmax_lds(LAS float* ps, int nk, int lane) {
    float mx = -INFINITY;
    for (int i = lane; i < nk; i += 64) mx = fmaxf(mx, ps[i]);
    mx = wave_max(mx);
    if (mx == -INFINITY) { for (int i = lane; i < nk; i += 64) ps[i] = 0.f; LDS_WAIT(); return; }
    float sum = 0.f;
    for (int i = lane; i < nk; i += 64) { const float e = __expf(ps[i] - mx); ps[i] = e; sum += e; }
    sum = wave_sum(sum);
    const float inv = 1.0f / fmaxf(sum, 1e-30f);
    for (int i = lane; i < nk; i += 64) ps[i] *= inv;
    LDS_WAIT();
}
__device__ __forceinline__ float dot64(const LAS float* q, const bf16* krow) {
    float s = 0.f;
#pragma unroll
    for (int j = 0; j < 8; ++j) { const u32x4 kv = *(const u32x4*)(krow + 8 * j); const f32x4 q0 = *(const LAS f32x4*)(q + 8 * j), q1 = *(const LAS f32x4*)(q + 8 * j + 4);
        s += q0.x * bflo(kv.x) + q0.y * bfhi(kv.x) + q0.z * bflo(kv.y) + q0.w * bfhi(kv.y) + q1.x * bflo(kv.z) + q1.y * bfhi(kv.z) + q1.z * bflo(kv.w) + q1.w * bfhi(kv.w); }
    return s;
}
__device__ __forceinline__ void p5_attn_naive(Frame& F) {
    unsigned char* ws = F.ws;
    const bf16* Z = (const bf16*)(ws + WS_Z);
    const bf16* KC = (const bf16*)(ws + WS_KCMP); const bf16* VC = (const bf16*)(ws + WS_VCMP);
    bf16* CAT = (bf16*)(ws + WS_CAT);
    const int lane = F.lane, gw = F.bid * 8 + F.wave, NGW = F.G * 8;
    LAS float* qs = (LAS float*)(F.lds + F.wave * 5120);
    LAS float* ps = qs + 256;
    for (int it = gw; it < NB * 4 * T; it += NGW) {
        const int t = it & (T - 1), g = (it >> 12) & 3, b = it >> 14, m = b * T + t, cur = t >> 6;
        const size_t zo = (size_t)m * NZ;
#pragma unroll
        for (int r = 0; r < 4; ++r) qs[r * 64 + lane] = bf2f(Z[zo + ZQ + (4 * g + r) * 64 + lane]);
        LDS_WAIT();
        float imp = 0.f, oacc[4];
        const int ncv = t >= 31 ? ((t - 31) >> 4) + 1 : 0;
#pragma unroll
        for (int r = 0; r < 4; ++r) {
            const int h = 4 * g + r; const float slope = exp2f(-0.5f * (float)(h + 1));
#pragma unroll
            for (int ch = 0; ch < 4; ++ch) { const int c = ch * 64 + lane; float s = -INFINITY;
                if (c < ncv) s = dot64(qs + r * 64, KC + ((size_t)(b * 256 + c) * 4 + g) * 64) * 0.125f - slope * (float)(t - (16 * c + 31));
                ps[c] = s; }
            LDS_WAIT();
            softmax_lds(ps, 256, lane);
            float o = 0.f;
            for (int c = 0; c < ncv; ++c) o += ps[c] * bf2f(VC[((size_t)(b * 256 + c) * 4 + g) * 64 + lane]);
            { const int j = lane; float v = 32.0f * (ps[4 * j] + ps[4 * j + 1] + ps[4 * j + 2]);
              if (j > 0) v += 16.0f * ps[4 * j - 1];
              v += 16.0f * ps[4 * j + 3];
              imp += v; }
            oacc[r] = sigmoidf_(bf2f(Z[zo + ZGL + h * 3 + 0])) * o;
            LDS_WAIT();
        }
        float v = imp;
        if (lane == 0 || lane == cur || lane == cur - 1) v = INFINITY; else if (lane > cur) v = -INFINITY;
        int rank = 0;
        for (int jj = 0; jj < 64; ++jj) { const float vv = __shfl(v, jj); rank += (vv > v || (vv == v && jj < lane)) ? 1 : 0; }
        const unsigned long long selmask = __ballot(rank < 16) & (cur >= 63 ? ~0ull : ((1ull << (cur + 1)) - 1ull));
#pragma unroll
        for (int r = 0; r < 4; ++r) {
            const int h = 4 * g + r; const float slope = exp2f(-0.5f * (float)(h + 1));
            int n = 0;
            for (unsigned long long mm = selmask; mm; mm &= mm - 1, ++n) { const int j = __builtin_ctzll(mm); const int pos = 64 * j + lane; float s = -INFINITY;
                if (pos <= t) s = dot64(qs + r * 64, Z + (size_t)(b * T + pos) * NZ + ZKS + g * 64) * 0.125f - slope * (float)(t - pos);
                ps[n * 64 + lane] = s; }
            LDS_WAIT();
            softmax_lds(ps, n * 64, lane);
            float o = 0.f; n = 0;
            for (unsigned long long mm = selmask; mm; mm &= mm - 1, ++n) { const int j = __builtin_ctzll(mm);
                const int lim = (64 * j + 63 <= t) ? 64 : (t - 64 * j + 1);
                const bf16* vb = Z + (size_t)(b * T + 64 * j) * NZ + ZVS + g * 64 + lane;
                for (int i = 0; i < lim; ++i) o += ps[n * 64 + i] * bf2f(vb[(size_t)i * NZ]); }
            oacc[r] += sigmoidf_(bf2f(Z[zo + ZGL + h * 3 + 1])) * o;
            LDS_WAIT();
        }
#pragma unroll
        for (int r = 0; r < 4; ++r) {
            const int h = 4 * g + r; const float slope = exp2f(-0.5f * (float)(h + 1));
#pragma unroll
            for (int ch = 0; ch < 8; ++ch) { const int pos = t - 511 + ch * 64 + lane; float s = -INFINITY;
                if (pos >= 0) s = dot64(qs + r * 64, Z + (size_t)(b * T + pos) * NZ + ZKW + g * 64) * 0.125f - slope * (float)(t - pos);
                ps[ch * 64 + lane] = s; }
            LDS_WAIT();
            softmax_lds(ps, 512, lane);
            float o = 0.f;
            const int i0 = t >= 511 ? 0 : 511 - t;
            const bf16* vb = Z + ZVW + g * 64 + lane;
            for (int i = i0; i < 512; ++i) o += ps[i] * bf2f(vb[(size_t)(b * T + t - 511 + i) * NZ]);
            oacc[r] += sigmoidf_(bf2f(Z[zo + ZGL + h * 3 + 2])) * o;
            CAT[(size_t)m * D + h * 64 + lane] = (bf16)f2bf(oacc[r]);
            LDS_WAIT();
        }
    }
}

namespace nsa {
typedef short bf16x8 __attribute__((ext_vector_type(8)));
typedef float f32x16 __attribute__((ext_vector_type(16)));
typedef __bf16 bf2_t __attribute__((ext_vector_type(2)));
typedef float f2_t __attribute__((ext_vector_type(2)));
__device__ __forceinline__ unsigned pkbf(float a, float b) { f2_t v; v.x = a; v.y = b; return __builtin_bit_cast(unsigned, __builtin_convertvector(v, bf2_t)); }
constexpr int KP = 144, TILE_B = 64 * KP;
constexpr int IMP_LD = 65;
constexpr int L_IMP = 8 * TILE_B;
constexpr int L_INVL = L_IMP + 4 * 64 * IMP_LD * 4;
constexpr int L_SEL = L_INVL + 1024;
constexpr int L_UNI = L_SEL + 512;
constexpr int L_UNIT = L_UNI + 64;
static_assert(L_UNIT + 64 <= LDS_MISC, "attention LDS map");
constexpr float LOG2E = 1.4426950408889634f, SCL = 0.125f * LOG2E, NEGBIG = -1e30f;

struct StageRegs { u32x4 k, v; };
__device__ __forceinline__ void stage_load(StageRegs& r, const bf16* kb, const bf16* vb, size_t pitch, int tid) {
    const int key = tid >> 3, ch = tid & 7;
    r.k = *(const u32x4*)(kb + (size_t)key * pitch + ch * 8);
    r.v = *(const u32x4*)(vb + (size_t)key * pitch + ch * 8);
}
__device__ __forceinline__ void stage_store(const StageRegs& r, LAS unsigned char* lds, int slot, int tid) {
    const int key = tid >> 3, ch = tid & 7;
    *(LAS u32x4*)(lds + slot * TILE_B + key * KP + ch * 16) = r.k;
    const int kl = key & 15, vpos = (key & 48) + (kl & 3) + 4 * (kl >> 3) + 8 * ((kl >> 2) & 1);
    LAS unsigned char* vp = lds + (4 + slot) * TILE_B + (ch * 8) * KP + vpos * 2;
#pragma unroll
    for (int e = 0; e < 8; ++e) { const unsigned w = r.v[e >> 1]; *(LAS unsigned short*)(vp + e * KP) = (unsigned short)((e & 1) ? (w >> 16) : (w & 0xffffu)); }
}
template <int MODE>
__device__ __forceinline__ void tile_core(const LAS unsigned char* Kl, const LAS unsigned char* Vl, const bf16x8 (&qf)[4], const float (&bias)[16], float sl32, f32x16 (&O)[2], float& m, float& l,
                                          float off, bool need_mask, bool use_lo, int lo, int hi, bool lv, int lane, float (&p)[2][16]) {
    const int n = lane & 31, h = lane >> 5;
    f32x16 st[2];
#pragma unroll
    for (int kt = 0; kt < 2; ++kt) {
#pragma unroll
        for (int i = 0; i < 16; ++i) st[kt][i] = 0.f;
#pragma unroll
        for (int s = 0; s < 4; ++s) { const bf16x8 a = *(const LAS bf16x8*)(Kl + (32 * kt + n) * KP + (16 * s + 8 * h) * 2); st[kt] = __builtin_amdgcn_mfma_f32_32x32x16_bf16(a, qf[s], st[kt], 0, 0, 0); }
    }
#pragma unroll
    for (int kt = 0; kt < 2; ++kt)
#pragma unroll
        for (int i = 0; i < 16; ++i) p[kt][i] = fmaf(st[kt][i], SCL, bias[i]);
    if (need_mask) {
#pragma unroll
        for (int kt = 0; kt < 2; ++kt)
#pragma unroll
            for (int i = 0; i < 16; ++i) { const int c = 32 * kt + (i & 3) + 8 * (i >> 2); p[kt][i] = (c <= hi) ? p[kt][i] : -INFINITY; }
        if (use_lo) {
#pragma unroll
            for (int kt = 0; kt < 2; ++kt)
#pragma unroll
                for (int i = 0; i < 16; ++i) { const int c = 32 * kt + (i & 3) + 8 * (i >> 2); p[kt][i] = (c >= lo) ? p[kt][i] : -INFINITY; }
        }
    }
    float mrel;
    if constexpr (MODE != 1) {
        float tm0 = p[0][0], tm1 = p[1][0];
#pragma unroll
        for (int i = 1; i < 16; ++i) { tm0 = fmaxf(tm0, p[0][i]); tm1 = fmaxf(tm1, p[1][i]); }
        float tm = fmaxf(tm0, tm1 + sl32);
        tm = lv ? tm : -INFINITY;
        { const auto sw_ = __builtin_amdgcn_permlane32_swap(__float_as_uint(tm), __float_as_uint(tm), false, false); tm = fmaxf(__uint_as_float(sw_[0]), __uint_as_float(sw_[1])); }
        const float mn = fmaxf(m, tm + off);
        if constexpr (MODE == 0) { m = mn; return; }
        const float alpha = __builtin_amdgcn_exp2f(m - mn);
        m = mn; l *= alpha; O[0] = O[0] * alpha; O[1] = O[1] * alpha;
        mrel = lv ? mn - off : INFINITY;
    } else mrel = m - off;
    float ps = 0.f;
#pragma unroll
    for (int kt = 0; kt < 2; ++kt)
#pragma unroll
        for (int i = 0; i < 16; ++i) { p[kt][i] = __builtin_amdgcn_exp2f(p[kt][i] - (kt ? mrel - sl32 : mrel)); ps += p[kt][i]; }
    l += ps;
#pragma unroll
    for (int g16 = 0; g16 < 4; ++g16) {
        const int kt = g16 >> 1, s8 = (g16 & 1) * 8;
        u32x4 pw; pw.x = pkbf(p[kt][s8 + 0], p[kt][s8 + 1]); pw.y = pkbf(p[kt][s8 + 2], p[kt][s8 + 3]); pw.z = pkbf(p[kt][s8 + 4], p[kt][s8 + 5]); pw.w = pkbf(p[kt][s8 + 6], p[kt][s8 + 7]);
        const bf16x8 pb = __builtin_bit_cast(bf16x8, pw);
#pragma unroll
        for (int dt = 0; dt < 2; ++dt) { const bf16x8 a = *(const LAS bf16x8*)(Vl + (32 * dt + n) * KP + (16 * g16 + 8 * h) * 2); O[dt] = __builtin_amdgcn_mfma_f32_32x32x16_bf16(a, pb, O[dt], 0, 0, 0); }
    }
}
__device__ __forceinline__ void set_bias(float (&bias)[16], float sl, int h) {
#pragma unroll
    for (int i = 0; i < 16; ++i) bias[i] = sl * (float)((i & 3) + 8 * (i >> 2) + 4 * h);
}

__device__ __forceinline__ void attn_phase(Frame& F, int rep) {
    unsigned char* ws = F.ws;
    const bf16* Z = (const bf16*)(ws + WS_Z);
    const bf16* KC = (const bf16*)(ws + WS_KCMP); const bf16* VC = (const bf16*)(ws + WS_VCMP);
    bf16* CAT = (bf16*)(ws + WS_CAT);
    LAS unsigned char* lds = F.lds;
    LAS float* imph = (LAS float*)(lds + L_IMP); LAS float* invl = (LAS float*)(lds + L_INVL);
    LAS unsigned long long* selm = (LAS unsigned long long*)(lds + L_SEL); LAS unsigned long long* unis = (LAS unsigned long long*)(lds + L_UNI);
    unsigned* ctr = (unsigned*)(ws + WS_CTL) + CW_ATTNQ + 64 * rep;
    const int tid = F.tid, lane = F.lane, wave = F.wave, n = lane & 31, h = lane >> 5, r = wave >> 1, th = wave & 1, tq = 32 * th + n;
    for (;;) {
        __syncthreads();
        if (tid == 0) *(LAS int*)(lds + L_UNIT) = (int)atomicAdd(ctr, 1u);
        __syncthreads();
        const int u = *(LAS int*)(lds + L_UNIT);
        if (u >= NB * 4 * 64) break;
        const int qt = 63 - (u >> 4), b = (u >> 2) & 3, g = u & 3, t0 = 64 * qt, head = 4 * g + r, t = t0 + tq;
        const size_t zrow = (size_t)(b * T + t) * NZ;
        bf16x8 qf[4];
#pragma unroll
        for (int s = 0; s < 4; ++s) qf[s] = *(const bf16x8*)(Z + zrow + ZQ + head * 64 + 16 * s + 8 * h);
        const float slope2 = exp2f(-0.5f * (float)(head + 1)) * LOG2E;
        const float g0 = sigmoidf_(bf2f(Z[zrow + ZGL + head * 3 + 0])), g1 = sigmoidf_(bf2f(Z[zrow + ZGL + head * 3 + 1])), g2 = sigmoidf_(bf2f(Z[zrow + ZGL + head * 3 + 2]));
        const int ncmax = (4 * qt + 3) < NCMP ? (4 * qt + 3) : NCMP, ntc = (ncmax + 63) >> 6;
        for (int tau = 0; tau < ntc; ++tau) { StageRegs sr; const size_t ro = ((size_t)(b * 256 + 64 * tau) * 4 + g) * 64; stage_load(sr, KC + ro, VC + ro, 256, tid); stage_store(sr, lds, tau, tid); }
        __syncthreads();
        float bias[16], p[2][16];
        f32x16 O[2];
        set_bias(bias, slope2 * 16.0f, h);
        float sl32 = slope2 * 512.0f;
        const int ncv = t >= 31 ? ((t - 31) >> 4) + 1 : 0;
        float m = NEGBIG, l = 0.f;
#pragma unroll
        for (int i = 0; i < 16; ++i) { O[0][i] = 0.f; O[1][i] = 0.f; }
        for (int tau = 0; tau < ntc; ++tau)
            tile_core<0>(lds + tau * TILE_B, lds + (4 + tau) * TILE_B, qf, bias, sl32, O, m, l, slope2 * (float)(1024 * tau + 31 - t), true, false, 0, ncv - 1 - 64 * tau - 4 * h, true, lane, p);
        float carry = 0.f;
        for (int tau = 0; tau < ntc; ++tau) {
            tile_core<1>(lds + tau * TILE_B, lds + (4 + tau) * TILE_B, qf, bias, sl32, O, m, l, slope2 * (float)(1024 * tau + 31 - t), true, false, 0, ncv - 1 - 64 * tau - 4 * h, true, lane, p);
            float recv[8];
#pragma unroll
            for (int f = 0; f < 8; ++f) recv[f] = __shfl_xor(16.0f * p[f >> 2][4 * (f & 3) + 3], 32);
#pragma unroll
            for (int f = 0; f < 8; ++f) { const int kt = f >> 2, q4 = f & 3;
                const float gsum = 32.0f * (p[kt][4 * q4] + p[kt][4 * q4 + 1] + p[kt][4 * q4 + 2]) + 16.0f * p[kt][4 * q4 + 3];
                const float prev0 = (f == 0) ? carry : recv[f == 0 ? 0 : f - 1];
                const float prev = h ? recv[f] : prev0;
                imph[(r * 64 + tq) * IMP_LD + 16 * tau + 8 * kt + 2 * q4 + h] = gsum + prev; }
            carry = recv[7];
        }
        { const float lt = l + __shfl_xor(l, 32); const float inv = 1.0f / fmaxf(lt, 1e-30f); if (h == 0) invl[r * 64 + tq] = inv; O[0] = O[0] * (inv * g0); O[1] = O[1] * (inv * g0); }
        __syncthreads();
        { unsigned long long uw = 0ull; const unsigned long long vmask = qt >= 63 ? ~0ull : ((1ull << (qt + 1)) - 1ull);
          for (int qq = 0; qq < 8; ++qq) { const int q = 8 * wave + qq;
              float v = 0.f;
#pragma unroll
              for (int rr = 0; rr < 4; ++rr) v += imph[(rr * 64 + q) * IMP_LD + lane] * invl[rr * 64 + q];
              if (lane == 0 || lane == qt || lane == qt - 1) v = INFINITY; else if (lane > qt) v = -INFINITY;
              int rank = 0;
#pragma unroll
              for (int jj = 0; jj < 64; ++jj) { const float vv = __shfl(v, jj); rank += (vv > v || (vv == v && jj < lane)) ? 1 : 0; }
              const unsigned long long mk = __ballot(rank < 16) & vmask;
              if (lane == 0) selm[q] = mk;
              uw |= mk; }
          if (lane == 0) unis[wave] = uw; }
        __syncthreads();
        unsigned long long uni = 0ull;
#pragma unroll
        for (int w8 = 0; w8 < 8; ++w8) uni |= unis[w8];
        uni = __builtin_amdgcn_readfirstlane((unsigned)uni) | ((unsigned long long)__builtin_amdgcn_readfirstlane((unsigned)(uni >> 32)) << 32);
        const unsigned long long selq = selm[tq];
        LAS float* oacc = (LAS float*)(lds + L_IMP) + wave * 2048 + lane;
#pragma unroll
        for (int i = 0; i < 16; ++i) { oacc[i * 64] = O[0][i]; oacc[(16 + i) * 64] = O[1][i]; }
        set_bias(bias, slope2, h); sl32 = slope2 * 32.0f;
        m = NEGBIG; l = 0.f;
#pragma unroll
        for (int i = 0; i < 16; ++i) { O[0][i] = 0.f; O[1][i] = 0.f; }
        {
            unsigned long long mm = uni; int j = __builtin_ctzll(mm); mm &= mm - 1; int cb = 0;
            { StageRegs sr; const bf16* kb = Z + (size_t)(b * T + 64 * j) * NZ + g * 64; stage_load(sr, kb + ZKS, kb + ZVS, NZ, tid); stage_store(sr, lds, 0, tid); }
            __syncthreads();
            for (;;) {
                const bool more = mm != 0ull; int jn = 0; StageRegs sr;
                if (more) { jn = __builtin_ctzll(mm); mm &= mm - 1; const bf16* kb = Z + (size_t)(b * T + 64 * jn) * NZ + g * 64; stage_load(sr, kb + ZKS, kb + ZVS, NZ, tid); }
                const bool lv = (selq >> j) & 1ull; const bool diag = (j == qt);
                tile_core<2>(lds + cb * TILE_B, lds + (4 + cb) * TILE_B, qf, bias, sl32, O, m, l, slope2 * (float)(64 * j - t), diag, false, 0, tq - 4 * h, lv, lane, p);
                if (more) stage_store(sr, lds, cb ^ 1, tid);
                __syncthreads();
                if (!more) break;
                j = jn; cb ^= 1;
            }
        }
        { const float lt = l + __shfl_xor(l, 32); const float inv = 1.0f / fmaxf(lt, 1e-30f) * g1;
#pragma unroll
          for (int i = 0; i < 16; ++i) { oacc[i * 64] += O[0][i] * inv; oacc[(16 + i) * 64] += O[1][i] * inv; } }
        m = NEGBIG; l = 0.f;
#pragma unroll
        for (int i = 0; i < 16; ++i) { O[0][i] = 0.f; O[1][i] = 0.f; }
        {
            int j = qt >= 8 ? qt - 8 : 0; int cb = 0;
            { StageRegs sr; const bf16* kb = Z + (size_t)(b * T + 64 * j) * NZ + g * 64; stage_load(sr, kb + ZKW, kb + ZVW, NZ, tid); stage_store(sr, lds, 0, tid); }
            __syncthreads();
            for (;;) {
                const bool more = j < qt; StageRegs sr;
                if (more) { const bf16* kb = Z + (size_t)(b * T + 64 * (j + 1)) * NZ + g * 64; stage_load(sr, kb + ZKW, kb + ZVW, NZ, tid); }
                const bool left = (j == qt - 8), diag = (j == qt);
                const int lo = (left ? tq + 1 : -1000) - 4 * h, hi = (diag ? tq : 1000) - 4 * h;
                tile_core<2>(lds + cb * TILE_B, lds + (4 + cb) * TILE_B, qf, bias, sl32, O, m, l, slope2 * (float)(64 * j - t), left || diag, left, lo, hi, true, lane, p);
                if (more) stage_store(sr, lds, cb ^ 1, tid);
                __syncthreads();
                if (!more) break;
                ++j; cb ^= 1;
            }
        }
        { const float lt = l + __shfl_xor(l, 32); const float inv = 1.0f / fmaxf(lt, 1e-30f) * g2;
#pragma unroll
          for (int i = 0; i < 16; ++i) { O[0][i] = oacc[i * 64] + O[0][i] * inv; O[1][i] = oacc[(16 + i) * 64] + O[1][i] * inv; } }
        bf16* orow = CAT + (size_t)(b * T + t) * D + head * 64;
#pragma unroll
        for (int dt = 0; dt < 2; ++dt)
#pragma unroll
            for (int q4 = 0; q4 < 4; ++q4) { u32x2 w; w.x = pkbf(O[dt][4 * q4], O[dt][4 * q4 + 1]); w.y = pkbf(O[dt][4 * q4 + 2], O[dt][4 * q4 + 3]); *(u32x2*)(orow + 32 * dt + 8 * q4 + 4 * h) = w; }
    }
    __syncthreads();
}
}

__device__ __forceinline__ void p6_rwkv_out(Frame& F, const Args& a) {
    unsigned char* ws = F.ws;
    const float* Y = (const float*)(ws + WS_Y); const float* SC = (const float*)(ws + WS_SC); const float* G = (const float*)(ws + WS_G);
    const float* rk = a.in[I_RK]; const float* lng = a.in[I_LNG]; const float* lnb = a.in[I_LNB];
    bf16* CAT = (bf16*)(ws + WS_CAT);
    const int lane = F.lane, gw = F.bid * 8 + F.wave, NGW = F.G * 8;
    for (int it = gw; it < M * 2; it += NGW) {
        const int m = it >> 1, half = it & 1, t = m & (T - 1), b = m >> 12, col = (half * 64 + lane) * 8, h = col >> 6, j8 = col & 63;
        float y[8], bv[8], gg[8], lg8[8], lb8[8];
        ld8f(Y + (size_t)m * 1024 + col, y);
        unpack8(*(const u32x4*)((const bf16*)(ws + WS_ACK) + (size_t)m * 1024 + col), bv); unpack8(*(const u32x4*)((const bf16*)(ws + WS_G) + (size_t)m * 1024 + col), gg);
        ld8f(lng + col, lg8); ld8f(lnb + col, lb8);
        float s1 = 0.f;
#pragma unroll
        for (int e = 0; e < 8; ++e) s1 += y[e];
        const float mean = dpp_sum8(s1) * (1.0f / 64.0f);
        float s2 = 0.f;
#pragma unroll
        for (int e = 0; e < 8; ++e) { y[e] -= mean; s2 += y[e] * y[e]; }
        const float rstd = rsqrtf(dpp_sum8(s2) * (1.0f / 64.0f) + GN_EPS);
        float o[8];
#pragma unroll
        for (int e = 0; e < 8; ++e) o[e] = (y[e] * rstd * lg8[e] + lb8[e] + bv[e]) * gg[e];
        *(u32x4*)(CAT + (size_t)m * D + 1024 + col) = pack8(o);
    }
}

__device__ __forceinline__ void p8_ln_router(Frame& F, const Args& a) {
    typedef short bf16x8_t __attribute__((ext_vector_type(8)));
    unsigned char* ws = F.ws;
    const float* PRE = F.out; float* H1 = (float*)(ws + WS_H1); unsigned char* H1Q = (unsigned char*)(ws + WS_H1B);
    const float* g1 = a.in[I_LN1G]; const float* b1 = a.in[I_LN1B]; const float* rb = a.in[I_RB];
    const bf16* RWT = (const bf16*)(ws + WS_RWT);
    int* TOPE = (int*)(ws + WS_TOPE); float* TOPW = (float*)(ws + WS_TOPW); int* SLOT = (int*)(ws + WS_SLOT); int* HIST = (int*)(ws + WS_HIST);
    const int lane = F.lane, wave = F.wave, tid = F.tid;
    LAS float* part = (LAS float*)F.lds;
    LAS int* es = (LAS int*)(F.lds + 2 * 64 * 33 * 4);
    for (int ch = F.bid; ch < M / 64; ch += F.G) {
        for (int i = 0; i < 8; ++i) {
            const int m = ch * 64 + wave * 8 + i;
            float v[4][8]; float s1 = 0.f;
#pragma unroll
            for (int j = 0; j < 4; ++j) { ld8f(PRE + (size_t)m * D + 512 * j + 8 * lane, v[j]);
#pragma unroll
                for (int e = 0; e < 8; ++e) s1 += v[j][e]; }
            const float mean = wave_sum(s1) * (1.0f / D); float s2 = 0.f;
#pragma unroll
            for (int j = 0; j < 4; ++j)
#pragma unroll
                for (int e = 0; e < 8; ++e) { v[j][e] -= mean; s2 += v[j][e] * v[j][e]; }
            const float rstd = rsqrtf(wave_sum(s2) * (1.0f / D) + LN_EPS);
#pragma unroll
            for (int j = 0; j < 4; ++j) { const int c0 = 512 * j + 8 * lane; float g8[8], b8[8], o[8]; ld8f(g1 + c0, g8); ld8f(b1 + c0, b8);
#pragma unroll
                for (int e = 0; e < 8; ++e) o[e] = v[j][e] * rstd * g8[e] + b8[e];
                st8f(H1 + (size_t)m * D + c0, o);
                u32x2 q; q.x = pk_fp8x4(o[0] * FP8_SA1, o[1] * FP8_SA1, o[2] * FP8_SA1, o[3] * FP8_SA1); q.y = pk_fp8x4(o[4] * FP8_SA1, o[5] * FP8_SA1, o[6] * FP8_SA1, o[7] * FP8_SA1);
                *(u32x2*)(H1Q + (size_t)m * D + c0) = q; }
        }
        asm volatile("s_waitcnt vmcnt(0)" ::: "memory");
        __syncthreads();
        {
            const int tb = 16 * (wave & 3), kh = wave >> 2, row = lane & 15, g = lane >> 4;
            f32x4 acc0 = (f32x4){0.f, 0.f, 0.f, 0.f}, acc1 = acc0;
            const float* hp = H1 + (size_t)(ch * 64 + tb + row) * D + kh * 1024 + 8 * g;
            const bf16* w0 = RWT + (size_t)row * D + kh * 1024 + 8 * g;
#pragma unroll 4
            for (int ks = 0; ks < 32; ++ks) {
                float x[8]; ld8f(hp + 32 * ks, x);
                float hi[8], lo[8];
#pragma unroll
                for (int e = 0; e < 8; ++e) { hi[e] = bf2f(f2bf(x[e])); lo[e] = x[e] - hi[e]; }
                const bf16x8_t ah = __builtin_bit_cast(bf16x8_t, pack8(hi)), al = __builtin_bit_cast(bf16x8_t, pack8(lo));
                const bf16x8_t b0h = *(const bf16x8_t*)(w0 + 32 * ks), b1h = *(const bf16x8_t*)(w0 + 16 * D + 32 * ks);
                const bf16x8_t b0l = *(const bf16x8_t*)(w0 + 32 * D + 32 * ks), b1l = *(const bf16x8_t*)(w0 + 48 * D + 32 * ks);
                acc0 = __builtin_amdgcn_mfma_f32_16x16x32_bf16(ah, b0h, acc0, 0, 0, 0); acc1 = __builtin_amdgcn_mfma_f32_16x16x32_bf16(ah, b1h, acc1, 0, 0, 0);
                acc0 = __builtin_amdgcn_mfma_f32_16x16x32_bf16(ah, b0l, acc0, 0, 0, 0); acc1 = __builtin_amdgcn_mfma_f32_16x16x32_bf16(ah, b1l, acc1, 0, 0, 0);
                acc0 = __builtin_amdgcn_mfma_f32_16x16x32_bf16(al, b0h, acc0, 0, 0, 0); acc1 = __builtin_amdgcn_mfma_f32_16x16x32_bf16(al, b1h, acc1, 0, 0, 0);
            }
#pragma unroll
            for (int q = 0; q < 4; ++q) { part[(kh * 64 + tb + 4 * g + q) * 33 + row] = acc0[q]; part[(kh * 64 + tb + 4 * g + q) * 33 + 16 + row] = acc1[q]; }
        }
        __syncthreads();
        for (int i = 0; i < 8; ++i) {
            const int tl_ = wave * 8 + i, m = ch * 64 + tl_;
            float lg = -INFINITY;
            if (lane < 32) lg = part[tl_ * 33 + lane] + part[(64 + tl_) * 33 + lane] + rb[lane];
            float tl[4]; int te[4];
#pragma unroll
            for (int k = 0; k < 4; ++k) { const float mx = wave_max(lg); const unsigned long long bm = __ballot(lg == mx); const int idx = __builtin_ctzll(bm); tl[k] = mx; te[k] = idx; if (lane == idx) lg = -INFINITY; }
            const float e1 = __expf(tl[1] - tl[0]), e2 = __expf(tl[2] - tl[0]), e3 = __expf(tl[3] - tl[0]); const float inv = 1.0f / (1.0f + e1 + e2 + e3);
            if (lane == 0) { *(int4*)(TOPE + (size_t)m * 4) = make_int4(te[0], te[1], te[2], te[3]); *(f32x4*)(TOPW + (size_t)m * 4) = (f32x4){inv, e1 * inv, e2 * inv, e3 * inv};
                es[tl_ * 4 + 0] = te[0]; es[tl_ * 4 + 1] = te[1]; es[tl_ * 4 + 2] = te[2]; es[tl_ * 4 + 3] = te[3]; }
        }
        __syncthreads();
        if (tid < 256) { const int e = es[tid]; int slot = 0; for (int q = 0; q < tid; ++q) slot += (es[q] == e) ? 1 : 0; SLOT[(size_t)ch * 256 + tid] = slot; }
        if (tid >= 256 && tid < 288) { const int e = tid - 256; int cnt = 0; for (int q = 0; q < 256; ++q) cnt += (es[q] == e) ? 1 : 0; HIST[ch * 32 + e] = cnt; }
        __syncthreads();
    }
}

__device__ __forceinline__ void p9_offsets(Frame& F) {
    unsigned char* ws = F.ws;
    const int* HIST = (const int*)(ws + WS_HIST); const int* TOPE = (const int*)(ws + WS_TOPE); const int* SLOT = (const int*)(ws + WS_SLOT);
    int* TOKROW = (int*)(ws + WS_TOKROW); int* ROWTOK = (int*)(ws + WS_ROWTOK); int* BLKE = (int*)(ws + WS_BLKE);
    LAS int* part = (LAS int*)F.lds;
    LAS int* tot = part + 512;
    LAS int* pre = tot + 32;
    LAS int* startp = pre + 32;
    LAS int* dsts = startp + 64;
    const int tid = F.tid, e = tid & 31, pg = tid >> 5;
    for (int ch = F.bid; ch < M / 64; ch += F.G) {
        __syncthreads();
        { int s = 0; for (int c = pg * 16; c < pg * 16 + 16; ++c) s += HIST[c * 32 + e]; part[pg * 32 + e] = s; }
        __syncthreads();
        if (tid < 32) { int s = 0; for (int q = 0; q < 16; ++q) s += part[q * 32 + tid]; tot[tid] = s; }
        __syncthreads();
        { int s = 0; for (int c = pg * 16; c < pg * 16 + 16; ++c) if (c < ch) s += HIST[c * 32 + e]; part[pg * 32 + e] = s; }
        __syncthreads();
        if (tid < 32) { int s = 0; for (int q = 0; q < 16; ++q) s += part[q * 32 + tid]; pre[tid] = s; }
        if (tid == 32) { int s = 0; for (int q = 0; q < 32; ++q) { startp[q] = s; s += (tot[q] + 255) / 256 * 256; } startp[32] = s; }
        __syncthreads();
        if (tid < 256) { const int m = ch * 64 + (tid >> 2); const int ee = TOPE[(size_t)m * 4 + (tid & 3)]; const int dest = startp[ee] + pre[ee] + SLOT[(size_t)ch * 256 + tid];
            ROWTOK[dest] = m; TOKROW[(size_t)m * 4 + (tid & 3)] = dest; dsts[tid] = dest; }
        __syncthreads();
        { const unsigned char* H1Q = (const unsigned char*)(ws + WS_H1B); unsigned char* XG = (unsigned char*)(ws + WS_XG);
          for (int a = F.wave; a < 256; a += 8) { const int m = ch * 64 + (a >> 2); const int dest = dsts[a];
              const u32x4 v0 = *(const u32x4*)(H1Q + (size_t)m * D + F.lane * 32), v1 = *(const u32x4*)(H1Q + (size_t)m * D + F.lane * 32 + 16);
              *(u32x4*)(XG + (size_t)dest * D + F.lane * 32) = v0; *(u32x4*)(XG + (size_t)dest * D + F.lane * 32 + 16) = v1; } }
        if (ch == 0) {
            const int nblk = startp[32] >> 8;
            if (tid < MAXBLK) { int be = -1; if (tid < nblk) { for (int q = 0; q < 32; ++q) if (startp[q] <= tid * 256 && tid * 256 < startp[q + 1]) be = q; } BLKE[tid] = be < 0 ? 0 : be; }
            if (tid == 0) BLKE[MAXBLK] = nblk;
        }
    }
    __syncthreads();
}

__device__ __forceinline__ void p12_combine_ln2(Frame& F, const Args& a) {
    unsigned char* ws = F.ws;
    const float* H1 = (const float*)(ws + WS_H1); const bf16* EO = (const bf16*)(ws + WS_EO); const int* TOKROW = (const int*)(ws + WS_TOKROW); const float* TOPW = (const float*)(ws + WS_TOPW);
    float* H2 = F.out; bf16* H2B = (bf16*)(ws + WS_H2B);
    const float* g2 = a.in[I_LN2G]; const float* b2 = a.in[I_LN2B];
    const int lane = F.lane, gw = F.bid * 8 + F.wave, NGW = F.G * 8;
    for (int m = gw; m < M; m += NGW) {
        const int4 rows = *(const int4*)(TOKROW + (size_t)m * 4); const f32x4 tw = *(const f32x4*)(TOPW + (size_t)m * 4);
        const int rr[4] = {rows.x, rows.y, rows.z, rows.w};
        float v[4][8]; float s = 0.f;
#pragma unroll
        for (int j = 0; j < 4; ++j) {
            const int c0 = 512 * j + 8 * lane;
            float h8[8]; ld8f(H1 + (size_t)m * D + c0, h8);
#pragma unroll
            for (int e = 0; e < 8; ++e) v[j][e] = ALPHA * h8[e];
#pragma unroll
            for (int k = 0; k < 4; ++k) { float e8[8]; unpack8(*(const u32x4*)(EO + (size_t)rr[k] * D + c0), e8); const float wk = tw[k];
#pragma unroll
                for (int e = 0; e < 8; ++e) v[j][e] += wk * e8[e]; }
#pragma unroll
            for (int e = 0; e < 8; ++e) s += v[j][e];
        }
        const float mean = wave_sum(s) * (1.0f / D); float s2 = 0.f;
#pragma unroll
        for (int j = 0; j < 4; ++j)
#pragma unroll
            for (int e = 0; e < 8; ++e) { v[j][e] -= mean; s2 += v[j][e] * v[j][e]; }
        const float rstd = rsqrtf(wave_sum(s2) * (1.0f / D) + LN_EPS);
#pragma unroll
        for (int j = 0; j < 4; ++j) { const int c0 = 512 * j + 8 * lane; float g8[8], b8[8], o[8]; ld8f(g2 + c0, g8); ld8f(b2 + c0, b8);
#pragma unroll
            for (int e = 0; e < 8; ++e) o[e] = v[j][e] * rstd * g8[e] + b8[e];
            st8f(H2 + (size_t)m * D + c0, o); *(u32x4*)(H2B + (size_t)m * D + c0) = pack8(o); }
    }
}

__global__ void __launch_bounds__(512, 2) hymba_fwd(Args args) {
    extern __shared__ __attribute__((aligned(16))) unsigned char lds_raw[];
    Frame F;
    F.lds = (LAS unsigned char*)lds_raw; F.ws = args.ws; F.out = args.out;
    F.tid = threadIdx.x; F.lane = F.tid & 63; F.wave = __builtin_amdgcn_readfirstlane(F.tid >> 6); F.bid = blockIdx.x; F.G = gridDim.x;
    unsigned char* ws = args.ws;
    volatile LAS unsigned* MISC = (volatile LAS unsigned*)(F.lds + LDS_MISC);
    if (F.tid < 32) MISC[F.tid] = 0u;
    __syncthreads();
    XcdBarrier bar; bar.bar = (unsigned*)(ws + WS_CTL) + CW_BAR; bar.x = 0; bar.st = nullptr;
    const int lo = args.ph_lo, hi = args.ph_hi;
    const bool one_launch = (hi - lo) > 1;
    if (one_launch) bar = xcd_barrier_post((unsigned*)(ws + WS_CTL) + CW_BAR, MISC + 8);
#ifdef ONLYPH
#define IN(k) ((k) == ONLYPH && lo <= (k) && (k) < hi)
#else
#define IN(k) (lo <= (k) && (k) < hi)
#endif
#ifndef PROF_IDX
#define PROF_IDX -1
#endif
#ifndef PROF_SCALE
#define PROF_SCALE 4
#endif
    unsigned long long* prof = (unsigned long long*)(ws + WS_CTL + 512 * 1024);
#define STAMP(i) do { if (PROF_IDX >= 0 && F.bid == 0 && F.tid == 0) { __builtin_amdgcn_s_waitcnt(0); prof[(i)] = __builtin_amdgcn_s_memrealtime(); } } while (0)
#define SEAM(k) do { if (IN(k) && IN((k) + 1)) { xcd_barrier(bar); STAMP((k) + 1); } } while (0)
    STAMP(0);
#ifndef PROBE_MASK
#define PROBE_MASK 0ull
#endif
#ifndef PROBE_MODE
#define PROBE_MODE 3
#endif
#define REPS(k) for (int rp_ = 0; rp_ < ((((PROBE_MASK) >> (k)) & 1ull) ? 2 : 1); ++rp_)

    if (IN(0)) REPS(0) { p0_prologue(F, args); } SEAM(0);
    if (IN(1)) REPS(1) { GemmDesc g{(const bf16*)(ws + WS_XB), D, nullptr, (const bf16*)(ws + WS_WIN), D, M, NZ, D, nullptr, 0, nullptr, 127, 127, 0}; EpiZ E{(bf16*)(ws + WS_Z)}; gemm_run<false>(F, g, E); } SEAM(1);
    if (IN(2)) REPS(2) { p2_prep(F, args); } SEAM(2);
    if (IN(3)) {
        static_assert(WS_AL == WS_WL + (size_t)M * 256 * 2 && WS_GLS == WS_AL + (size_t)M * 256 * 2 && WS_AUP == WS_WUP + 1024 * 256 * 2 && WS_GUP == WS_AUP + 1024 * 256 * 2, "the three LoRA operand sets are stacked");
        GemmDesc gl{(const bf16*)(ws + WS_WL), 256, nullptr, (const bf16*)(ws + WS_WUP), 256, 3 * M, 1024, 256, (const int*)(ws + WS_BLKE + 4096), (size_t)1024 * 256, nullptr, 127, 127, 0};
        EpiLora El{(float*)(ws + WS_DEC), (float*)(ws + WS_ASIG), (bf16*)(ws + WS_G), args.in[I_W0], args.in[I_A0]};
        const bool split = F.G >= 128;
        if (split && F.bid < 64) {
            const int grp = F.bid >> 4, kv = grp >> 1, kh = grp & 1;
            GemmDesc gc{(const bf16*)(ws + (kv ? WS_ACV : WS_ACK)) + kh * 1024, D, nullptr, (const bf16*)(ws + (kv ? WS_CW1V : WS_CW1K)) + kh * 1024, D, 4096, 256, D, nullptr, 0, nullptr, 127, 127, 1024};
            EpiCmpPart Ec{(float*)(ws + (kv ? WS_HCMPV : WS_HCMPK)) + (size_t)kh * 4096 * 64};
            gemm_run_part(F, gc, Ec, 16, F.bid & 15);
        } else {
            const int Gp = split ? F.G - 64 : F.G, cp = split ? F.bid - 64 : F.bid;
            if (!split) { for (int q = 0; q < 4; ++q) { const int kv = q >> 1, kh = q & 1;
                GemmDesc gc{(const bf16*)(ws + (kv ? WS_ACV : WS_ACK)) + kh * 1024, D, nullptr, (const bf16*)(ws + (kv ? WS_CW1V : WS_CW1K)) + kh * 1024, D, 4096, 256, D, nullptr, 0, nullptr, 127, 127, 1024};
                EpiCmpPart Ec{(float*)(ws + (kv ? WS_HCMPV : WS_HCMPK)) + (size_t)kh * 4096 * 64}; gemm_run_part(F, gc, Ec, Gp, cp); } }
            gemm_run_part(F, gl, El, Gp, cp); }
    } SEAM(3);
    if (IN(4)) REPS(4) { p4_prep(F, args); } SEAM(4);
    #ifndef NAIVE_ATTN
#define NAIVE_ATTN 0
#endif
    if (IN(5)) { REPS(50) p5_scan_conv(F, args, rp_ == 0 ? 3 : PROBE_MODE);
#if PROF_IDX == 15
        if (one_launch) { xcd_barrier(bar); STAMP(16); if (F.bid == 0 && F.tid == 0) { __builtin_amdgcn_s_waitcnt(0); prof[15] = prof[5]; } }
#endif
#if NAIVE_ATTN
        p5_attn_naive(F);
#else
        REPS(51) nsa::attn_phase(F, rp_);
#endif
    } SEAM(5);
    if (IN(6)) REPS(6) { p6_rwkv_out(F, args); } SEAM(6);
    if (IN(7)) REPS(7) { GemmDesc g{(const bf16*)(ws + WS_CAT), D, nullptr, (const bf16*)(ws + WS_WOUT), D, M, D, D, nullptr, 0, nullptr, 127, 127, 0}; EpiPre1 E{F.out, args.in[I_X]}; gemm_run<false>(F, g, E); } SEAM(7);
    if (IN(8)) REPS(8) { p8_ln_router(F, args); } SEAM(8);
    if (IN(9)) REPS(9) { p9_offsets(F); } SEAM(9);
    if (IN(10)) REPS(10) { GemmDesc g{(const bf16*)(ws + WS_XG), D, nullptr, (const bf16*)(ws + WS_WGU), D, MAXROWS, 4096, D, (const int*)(ws + WS_BLKE), (size_t)4096 * D, (const int*)(ws + WS_BLKE) + MAXBLK, FP8_EA1, FP8_EW, 0};
        EpiSwiglu E{(unsigned char*)(ws + WS_HACT), args.in[I_EBG], args.in[I_EBU]}; gemm_run<true, EpiSwiglu, true>(F, g, E); } SEAM(10);
    if (IN(11)) REPS(11) {
        { GemmDesc g{(const bf16*)(ws + WS_HACT), D, nullptr, (const bf16*)(ws + WS_WDN), D, MAXROWS, D, D, (const int*)(ws + WS_BLKE), (size_t)D * D, (const int*)(ws + WS_BLKE) + MAXBLK, FP8_EA2, FP8_EW, 0};
          EpiDown E{(bf16*)(ws + WS_EO), args.in[I_EBD]}; gemm_run<false, EpiDown, true>(F, g, E); }
        { GemmDesc g{(const bf16*)(ws + WS_PB), 256, nullptr, (const bf16*)(ws + WS_WPL), 256, M, D, 256, nullptr, 0, nullptr, 127, 127, 0}; EpiBf16 E{(bf16*)(ws + WS_PL), D}; gemm_run<false>(F, g, E); }
    } SEAM(11);
    if (IN(12)) REPS(12) { p12_combine_ln2(F, args); } SEAM(12);
    if (IN(13)) { GemmDesc g{(const bf16*)(ws + WS_H2B), D, nullptr, (const bf16*)(ws + WS_WPG), D, M, D, D, nullptr, 0, nullptr, 127, 127, 0}; EpiFinal E{F.out, (const bf16*)(ws + WS_PL)}; gemm_run<false>(F, g, E); }
    if (PROF_IDX >= 0 && one_launch) {
        xcd_barrier(bar); STAMP(14);
        if (F.bid == 0 && F.tid == 0) { asm volatile("s_waitcnt vmcnt(0)" ::: "memory");
            const unsigned long long d = (__hip_atomic_load(prof + PROF_IDX + 1, __ATOMIC_RELAXED, __HIP_MEMORY_SCOPE_AGENT) - __hip_atomic_load(prof + PROF_IDX, __ATOMIC_RELAXED, __HIP_MEMORY_SCOPE_AGENT)) * PROF_SCALE;
            const unsigned long long t0 = __builtin_amdgcn_s_memrealtime(); while (__builtin_amdgcn_s_memrealtime() - t0 < d) __builtin_amdgcn_s_sleep(8); }
    }
#undef IN
#undef SEAM
}

extern "C" void kernel_launch(void* const* d_in, const int* in_sizes, int n_in, void* d_out, int out_size, void* d_ws, size_t ws_size, hipStream_t stream) {
    static int grid = 0;
    if (grid == 0) {
        if (n_in != 35 || out_size != M * D || ws_size < WS_END) { fprintf(stderr, "kernel_launch: unexpected problem (n_in %d, out %d, ws %zu < %zu)\n", n_in, out_size, ws_size, (size_t)WS_END); grid = -1; return; }
        int dev = 0, cus = 0, per_cu = 0;
        if (hipGetDevice(&dev) != hipSuccess || hipDeviceGetAttribute(&cus, hipDeviceAttributeMultiprocessorCount, dev) != hipSuccess) { grid = -1; return; }
        if (hipFuncSetAttribute((const void*)hymba_fwd, hipFuncAttributeMaxDynamicSharedMemorySize, LDS_BYTES) != hipSuccess) { fprintf(stderr, "kernel_launch: hipFuncSetAttribute failed\n"); grid = -1; return; }
        if (hipOccupancyMaxActiveBlocksPerMultiprocessor(&per_cu, (const void*)hymba_fwd, 512, LDS_BYTES) != hipSuccess || per_cu < 1) fprintf(stderr, "kernel_launch: occupancy query reports %d\n", per_cu);
        (void)hipGetLastError();
        grid = cus;
    }
    if (grid < 0) return;
    if (hipMemsetAsync((char*)d_ws + WS_CTL, 0, CTL_ZERO_BYTES, stream) != hipSuccess) return;
    Args a{};
    for (int i = 0; i < 35; ++i) a.in[i] = (const float*)d_in[i];
    a.out = (float*)d_out; a.ws = (unsigned char*)d_ws;
#if MK_LAUNCH_PER_PHASE
    for (int ph = 0; ph < NPHASE; ++ph) { a.ph_lo = ph; a.ph_hi = ph + 1; a.li = ph; hipLaunchKernelGGL(hymba_fwd, dim3(grid), dim3(512), LDS_BYTES, stream, a); }
#else
    a.ph_lo = 0; a.ph_hi = NPHASE; a.li = 0;
    hipLaunchKernelGGL(hymba_fwd, dim3(grid), dim3(512), LDS_BYTES, stream, a);
#endif
}
```

```cpp
#include <hip/hip_runtime.h>
#include <cstdio>
#include <cstdint>

#ifndef MK_LAUNCH_PER_PHASE
#define MK_LAUNCH_PER_PHASE 0
#endif

#define GAS __attribute__((address_space(1)))
#define LAS __attribute__((address_space(3)))
typedef unsigned short bf16;
typedef float f32x4 __attribute__((ext_vector_type(4)));
typedef unsigned u32x4 __attribute__((ext_vector_type(4)));
typedef unsigned u32x2 __attribute__((ext_vector_type(2)));
#define LDS_WAIT() asm volatile("s_waitcnt lgkmcnt(0)" ::: "memory")

constexpr int NB = 4, T = 4096, D = 2048, M = NB * T;
constexpr int NZ = 6144;
constexpr int ZQ = 0, ZKC = 1024, ZVC = 1280, ZKS = 1536, ZVS = 1792, ZKW = 2048, ZVW = 2304, ZGL = 2560, ZRW = 2608;
constexpr int ZR = 2608, ZK = 3632, ZV = 4656, ZWL = 5680, ZAL = 5776, ZGLO = 5872, INC = 6128;
constexpr int NCMP = 255, NE = 32, MAXBLK = 288, MAXROWS = MAXBLK * 256;
constexpr float LN_EPS = 1e-5f, GN_EPS = 64e-5f, ALPHA = 1.189207115002721f;
constexpr int NPHASE = 14;

constexpr size_t MiB = 1u << 20;
constexpr size_t WS_CTL = 0, CTL_ZERO_BYTES = 1 * MiB;
constexpr size_t WS_HIST = 1 * MiB;
constexpr size_t WS_BLKE = 1 * MiB + 64 * 1024;
constexpr size_t WS_TOPE = 2 * MiB;
constexpr size_t WS_TOPW = WS_TOPE + 256 * 1024;
constexpr size_t WS_SLOT = WS_TOPW + 256 * 1024;
constexpr size_t WS_TOKROW = WS_SLOT + 256 * 1024;
constexpr size_t WS_ROWTOK = 3 * MiB;
constexpr size_t WS_RWT = 3 * MiB + 512 * 1024;
constexpr size_t WS_WPL = 4 * MiB;
constexpr size_t WS_WUP = 5 * MiB;
constexpr size_t WS_AUP = WS_WUP + 512 * 1024;
constexpr size_t WS_GUP = 6 * MiB;
constexpr size_t WS_CW1K = 7 * MiB;
constexpr size_t WS_CW1V = 8 * MiB;
constexpr size_t WS_HCMPK = 1844 * MiB;
constexpr size_t WS_HCMPV = 1846 * MiB;
constexpr size_t WS_KCMP = 11 * MiB;
constexpr size_t WS_VCMP = 11 * MiB + 512 * 1024;
constexpr size_t WS_WIN = 12 * MiB;
constexpr size_t WS_WOUT = 36 * MiB;
constexpr size_t WS_WPG = 44 * MiB;
constexpr size_t WS_PB = 52 * MiB;
constexpr size_t WS_WGU = 60 * MiB;
constexpr size_t WS_WDN = 572 * MiB;
constexpr size_t WS_S = 828 * MiB;
constexpr size_t WS_XB = WS_S;
constexpr size_t WS_Z = WS_S + 64 * MiB;
constexpr size_t WS_ACK = WS_S + 256 * MiB;
constexpr size_t WS_ACV = WS_S + 272 * MiB;
constexpr size_t WS_WL = WS_S + 288 * MiB;
constexpr size_t WS_AL = WS_S + 296 * MiB;
constexpr size_t WS_GLS = WS_S + 304 * MiB;
constexpr size_t WS_DEC = WS_S + 312 * MiB;
constexpr size_t WS_ASIG = WS_S + 376 * MiB;
constexpr size_t WS_G = WS_S + 440 * MiB;
constexpr size_t WS_SC = WS_S + 504 * MiB;
constexpr size_t WS_Y = WS_S + 888 * MiB;
constexpr size_t WS_CAT = WS_S + 952 * MiB;
constexpr size_t WS_H1 = WS_S;
constexpr size_t WS_H1B = WS_S + 128 * MiB;
constexpr size_t WS_XG = WS_S + 160 * MiB;
constexpr size_t WS_HACT = WS_S + 304 * MiB;
constexpr size_t WS_EO = WS_S + 480 * MiB;
constexpr size_t WS_H2B = WS_S + 768 * MiB;
constexpr size_t WS_PL = WS_S + 832 * MiB;
constexpr size_t WS_END = 1848 * MiB;
static_assert(WS_S + 1016 * MiB <= WS_HCMPK, "d_ws map");
constexpr int CW_BAR = 4096;

constexpr int LDS_BYTES = 147456;
constexpr int LDS_MISC = 147456 - 128;
constexpr int CW_ATTNQ = 8192;

__device__ __forceinline__ unsigned f2bf(float f) { unsigned u = __float_as_uint(f); return (u + 0x7fffu + ((u >> 16) & 1u)) >> 16; }
typedef __bf16 bf2v_t __attribute__((ext_vector_type(2)));
typedef float f2v_t __attribute__((ext_vector_type(2)));
__device__ __forceinline__ unsigned pk2(float lo, float hi) { f2v_t v; v.x = lo; v.y = hi; return __builtin_bit_cast(unsigned, __builtin_convertvector(v, bf2v_t)); }
__device__ __forceinline__ float bf2f(unsigned h) { return __uint_as_float(h << 16); }
__device__ __forceinline__ float bflo(unsigned w) { return __uint_as_float(w << 16); }
__device__ __forceinline__ float bfhi(unsigned w) { return __uint_as_float(w & 0xffff0000u); }
#define DPPF(x, ctrl) __builtin_bit_cast(float, __builtin_amdgcn_update_dpp(0, __builtin_bit_cast(int, (x)), (ctrl), 0xF, 0xF, true))
__device__ __forceinline__ float wave_sum(float v) {
    v += DPPF(v, 0xB1); v += DPPF(v, 0x4E); v += DPPF(v, 0x141); v += DPPF(v, 0x140);
    { const auto q = __builtin_amdgcn_permlane16_swap(__float_as_uint(v), __float_as_uint(v), false, false); v = __uint_as_float(q[0]) + __uint_as_float(q[1]); }
    { const auto q = __builtin_amdgcn_permlane32_swap(__float_as_uint(v), __float_as_uint(v), false, false); v = __uint_as_float(q[0]) + __uint_as_float(q[1]); }
    return v;
}
__device__ __forceinline__ float wave_max(float v) {
    v = fmaxf(v, DPPF(v, 0xB1)); v = fmaxf(v, DPPF(v, 0x4E)); v = fmaxf(v, DPPF(v, 0x141)); v = fmaxf(v, DPPF(v, 0x140));
    { const auto q = __builtin_amdgcn_permlane16_swap(__float_as_uint(v), __float_as_uint(v), false, false); v = fmaxf(__uint_as_float(q[0]), __uint_as_float(q[1])); }
    { const auto q = __builtin_amdgcn_permlane32_swap(__float_as_uint(v), __float_as_uint(v), false, false); v = fmaxf(__uint_as_float(q[0]), __uint_as_float(q[1])); }
    return v;
}
__device__ __forceinline__ unsigned pk_fp8x4(float a, float b, float c, float d) {
    a = __builtin_amdgcn_fmed3f(a, -448.f, 448.f); b = __builtin_amdgcn_fmed3f(b, -448.f, 448.f); c = __builtin_amdgcn_fmed3f(c, -448.f, 448.f); d = __builtin_amdgcn_fmed3f(d, -448.f, 448.f);
    int w = 0; w = __builtin_amdgcn_cvt_pk_fp8_f32(a, b, w, false); w = __builtin_amdgcn_cvt_pk_fp8_f32(c, d, w, true); return (unsigned)w; }
constexpr float FP8_SW = 64.0f, FP8_SA1 = 16.0f, FP8_SA2 = 4.0f;
constexpr int FP8_EW = 127 - 6, FP8_EA1 = 127 - 4, FP8_EA2 = 127 - 2;
__device__ __forceinline__ float sigmoidf_(float x) { return __builtin_amdgcn_rcpf(1.0f + __builtin_amdgcn_exp2f(-1.4426950408889634f * x)); }
__device__ __forceinline__ float gelu_tanh(float x) { const float u = 0.7978845608028654f * (x + 0.044715f * x * x * x); return x * sigmoidf_(2.0f * u); }

#define XB_TMO      128
#define XB_XCNT(j)  (256  + 64 * (j))
#define XB_XSUB(j)  (1280 + 64 * (j))
#define XB_XGEN(j)  (2304 + 64 * (j))
#define XB_TOP      3328
#define XB_TOPGEN   3392
#define XCD_BAR_WORDS 3456
#define XB_SPIN_CAP (1u << 22)
__device__ __forceinline__ unsigned xb_ld(unsigned* p)              { return __hip_atomic_load(p, __ATOMIC_RELAXED, __HIP_MEMORY_SCOPE_AGENT); }
__device__ __forceinline__ unsigned xb_add(unsigned* p, unsigned v) { return __hip_atomic_fetch_add(p, v, __ATOMIC_RELAXED, __HIP_MEMORY_SCOPE_AGENT); }
__device__ __forceinline__ unsigned xb_xcc_id() { return (unsigned)__builtin_amdgcn_s_getreg((3 << 11) | 20) & 0xFu; }
#define XB_SPIN(cond, bar) do { unsigned _sp = 0; while (cond) { __builtin_amdgcn_s_sleep(1); \
    if ((++_sp & 255u) == 0u) { if (xb_ld(&(bar)[XB_TMO])) break; if (_sp > XB_SPIN_CAP) { atomicAdd(&(bar)[XB_TMO], 1u); break; } } } } while (0)
struct XcdBarrier { unsigned* bar; unsigned x; volatile LAS unsigned* st; };
__device__ __forceinline__ XcdBarrier xcd_barrier_post(unsigned* bar, volatile LAS unsigned* st) {
    XcdBarrier b; b.bar = bar; b.x = xb_xcc_id(); b.st = st;
    if (threadIdx.x == 0) (void)xb_add(&bar[XB_XCNT(b.x)], 1u);
    return b;
}
__device__ __forceinline__ void xcd_barrier_complete(unsigned* bar, unsigned x, unsigned& nloc, unsigned& nx) {
    const unsigned G = gridDim.x * gridDim.y * gridDim.z;
    unsigned sum, cnt, mine, sp = 0u;
    for (;;) {
        sum = 0u; cnt = 0u; mine = 0u;
#pragma unroll
        for (unsigned j = 0; j < 16; ++j) { const unsigned c = xb_ld(&bar[XB_XCNT(j)]); sum += c; cnt += (c > 0u) ? 1u : 0u; mine = (j == x) ? c : mine; }
        if (sum == G) break;
        __builtin_amdgcn_s_sleep(1);
        if ((++sp & 255u) == 0u) { if (xb_ld(&bar[XB_TMO])) break; if (sp > XB_SPIN_CAP) { atomicAdd(&bar[XB_TMO], 1u); break; } }
    }
    nloc = mine > 0u ? mine : 1u; nx = cnt > 0u ? cnt : 1u;
}
__device__ __forceinline__ void xcd_barrier(const XcdBarrier& b) {
    asm volatile("s_waitcnt vmcnt(0)" ::: "memory");
    __syncthreads();
    if (threadIdx.x == 0) {
        unsigned* bar = b.bar;
        __builtin_amdgcn_s_waitcnt(0);
        unsigned nloc = b.st[0], nx = b.st[1];
        if (nloc == 0u) { xcd_barrier_complete(bar, b.x, nloc, nx); b.st[0] = nloc; b.st[1] = nx; }
        const unsigned old = xb_add(&bar[XB_XSUB(b.x)], 1u);
        const unsigned gen = old / nloc;
        if (old + 1u == (gen + 1u) * nloc) {
            __builtin_amdgcn_fence(__ATOMIC_RELEASE, "agent");
            asm volatile("s_waitcnt vmcnt(0)" ::: "memory");
            const unsigned og = xb_add(&bar[XB_TOP], 1u);
            const unsigned tg = og / nx;
            if (og + 1u == (tg + 1u) * nx) xb_add(&bar[XB_TOPGEN], 1u);
            else XB_SPIN(xb_ld(&bar[XB_TOPGEN]) == tg, bar);
            __builtin_amdgcn_fence(__ATOMIC_ACQUIRE, "agent");
            xb_add(&bar[XB_XGEN(b.x)], 1u);
            asm volatile("s_waitcnt vmcnt(0)" ::: "memory");
        } else {
            XB_SPIN(xb_ld(&bar[XB_XGEN(b.x)]) == gen, bar);
            __builtin_amdgcn_fence(__ATOMIC_ACQUIRE, "agent");
            asm volatile("s_waitcnt vmcnt(0)" ::: "memory");
        }
    }
    __syncthreads();
}

struct Args { const float* in[35]; float* out; unsigned char* ws; int ph_lo, ph_hi, li, pad; };
struct Frame {
    LAS unsigned char* lds;
    unsigned char* ws; float* out;
    int tid, lane, wave, bid, G;
};
enum { I_X = 0, I_P, I_WIN, I_PEK, I_W1K, I_W2K, I_PEV, I_W1V, I_W2V, I_MU, I_W0, I_WUP, I_A0, I_AUP, I_GUP, I_KK, I_KA, I_RK, I_LNG, I_LNB, I_WOUT,
       I_LN1G, I_LN1B, I_RW, I_RB, I_EWG, I_EBG, I_EWU, I_EBU, I_EWD, I_EBD, I_LN2G, I_LN2B, I_PLEW, I_PLEG };

struct GemmDesc {
    const bf16* A; int lda; const int* rowidx;
    const bf16* Bt; int ldb;
    int Mrows, N, K;
    const int* block_e; size_t bstride; const int* nblk;
    int ea, eb;
    int kext;
};
template <bool PAIR, class Epi>
__device__ __forceinline__ void ngemm_phase(Frame& F, const GemmDesc& g, const Epi& E) {
    LAS float* As = (LAS float*)F.lds;
    LAS float* Bs = As + 32 * 132;
    LAS float* Bu = Bs + 32 * 132;
    const int tid = F.tid, ty = tid >> 5, tx = tid & 31;
    const int lrow = tid >> 2, lkc = (tid & 3) * 8;
    const int ntm = g.Mrows / 128, ntn = PAIR ? g.N / 256 : g.N / 128;
    const int mlive = g.nblk ? (*g.nblk) * 256 : g.Mrows;
    for (int tile = F.bid; tile < ntm * ntn; tile += F.G) {
        const int tm = tile / ntn, tn = tile % ntn, m0 = tm * 128;
        if (m0 >= mlive) continue;
        const int e = g.block_e ? g.block_e[m0 >> 8] : 0;
        const bf16* Bt = g.Bt + (size_t)e * g.bstride;
        const int arow = g.rowidx ? g.rowidx[m0 + lrow] : (m0 + lrow);
        const bf16* ap = g.A + (size_t)arow * g.lda + lkc;
        const bf16* bp = Bt + (size_t)((PAIR ? tn * 256 : tn * 128) + lrow) * g.ldb + lkc;
        const bf16* bup = bp + (size_t)128 * g.ldb;
        f32x4 acc[8], accu[8];
#pragma unroll
        for (int i = 0; i < 8; ++i) { acc[i] = (f32x4){0.f, 0.f, 0.f, 0.f}; accu[i] = (f32x4){0.f, 0.f, 0.f, 0.f}; }
        for (int k0 = 0; k0 < g.K; k0 += 32) {
            const u32x4 av = *(const u32x4*)(ap + k0), bv = *(const u32x4*)(bp + k0);
            u32x4 uv = (u32x4){0u, 0u, 0u, 0u}; if (PAIR) uv = *(const u32x4*)(bup + k0);
            __syncthreads();
#pragma unroll
            for (int j = 0; j < 4; ++j) {
                As[(lkc + 2 * j) * 132 + lrow] = bflo(av[j]); As[(lkc + 2 * j + 1) * 132 + lrow] = bfhi(av[j]);
                Bs[(lkc + 2 * j) * 132 + lrow] = bflo(bv[j]); Bs[(lkc + 2 * j + 1) * 132 + lrow] = bfhi(bv[j]);
                if (PAIR) { Bu[(lkc + 2 * j) * 132 + lrow] = bflo(uv[j]); Bu[(lkc + 2 * j + 1) * 132 + lrow] = bfhi(uv[j]); }
            }
            __syncthreads();
#pragma unroll 4
            for (int k = 0; k < 32; ++k) {
                const f32x4 a0 = *(const LAS f32x4*)(As + k * 132 + ty * 8), a1 = *(const LAS f32x4*)(As + k * 132 + ty * 8 + 4);
                const f32x4 b = *(const LAS f32x4*)(Bs + k * 132 + tx * 4);
                acc[0] += a0.x * b; acc[1] += a0.y * b; acc[2] += a0.z * b; acc[3] += a0.w * b;
                acc[4] += a1.x * b; acc[5] += a1.y * b; acc[6] += a1.z * b; acc[7] += a1.w * b;
                if (PAIR) { const f32x4 u = *(const LAS f32x4*)(Bu + k * 132 + tx * 4);
                    accu[0] += a0.x * u; accu[1] += a0.y * u; accu[2] += a0.z * u; accu[3] += a0.w * u;
                    accu[4] += a1.x * u; accu[5] += a1.y * u; accu[6] += a1.z * u; accu[7] += a1.w * u; }
            }
        }
        const int col = (PAIR ? tn * 128 : tn * 128) + tx * 4;
#pragma unroll
        for (int i = 0; i < 8; ++i) { const int row = m0 + ty * 8 + i;
            if constexpr (PAIR) E.stp(row, col, acc[i], accu[i], e); else E.st(row, col, acc[i], e); }
    }
    __syncthreads();
}

__device__ __forceinline__ void st_bf16x4(bf16* p, f32x4 v) { u32x2 w; w.x = pk2(v.x, v.y); w.y = pk2(v.z, v.w); *(u32x2*)p = w; }
__device__ __forceinline__ void st_bf16x8(bf16* p, f32x4 a, f32x4 b) { u32x4 w; w.x = pk2(a.x, a.y); w.y = pk2(a.z, a.w); w.z = pk2(b.x, b.y); w.w = pk2(b.z, b.w); *(u32x4*)p = w; }
struct EpiZ { static constexpr bool PERM = true; bf16* Z; __device__ __forceinline__ void st(int r, int c, f32x4 v, int) const { st_bf16x4(Z + (size_t)r * NZ + c, v); }
    __device__ __forceinline__ void st8(int r, int c, f32x4 a, f32x4 b, int) const { st_bf16x8(Z + (size_t)r * NZ + c, a, b); } };
struct EpiCmp { float* H; __device__ __forceinline__ void st(int r, int c, f32x4 v, int) const { if (c < 64) { f32x4 o; o.x = gelu_tanh(v.x); o.y = gelu_tanh(v.y); o.z = gelu_tanh(v.z); o.w = gelu_tanh(v.w); *(f32x4*)(H + (size_t)r * 64 + c) = o; } } };
struct EpiCmpPart { float* H; __device__ __forceinline__ void st(int r, int c, f32x4 v, int) const { if (c < 64) *(f32x4*)(H + (size_t)r * 64 + c) = v; } };
struct EpiDecay { float* O; const float* w0;
    __device__ __forceinline__ float f(float x) const { const float y = -x; const float sp = fmaxf(y, 0.f) + __logf(1.0f + __expf(-fabsf(y))); return __expf(-__expf(-sp - 0.5f)); }
    __device__ __forceinline__ void st(int r, int c, f32x4 v, int) const { const f32x4 b = *(const f32x4*)(w0 + c); f32x4 o; o.x = f(v.x + b.x); o.y = f(v.y + b.y); o.z = f(v.z + b.z); o.w = f(v.w + b.w); *(f32x4*)(O + (size_t)r * 1024 + c) = o; } };
struct EpiASig { float* O; const float* a0;
    __device__ __forceinline__ void st(int r, int c, f32x4 v, int) const { const f32x4 b = *(const f32x4*)(a0 + c); f32x4 o; o.x = sigmoidf_(v.x + b.x); o.y = sigmoidf_(v.y + b.y); o.z = sigmoidf_(v.z + b.z); o.w = sigmoidf_(v.w + b.w); *(f32x4*)(O + (size_t)r * 1024 + c) = o; } };
struct EpiLora { static constexpr bool PERM = true; float* DEC; float* ASIG; bf16* G; const float* w0; const float* a0;
    __device__ __forceinline__ float fd(float x) const { const float y = -x; const float sp = fmaxf(y, 0.f) + __logf(1.0f + __expf(-fabsf(y))); return __expf(-__expf(-sp - 0.5f)); }
    __device__ __forceinline__ void st8(int r, int c, f32x4 a, f32x4 b, int e) const { const int m = r - e * M;
        if (e == 0) { const f32x4 b0 = *(const f32x4*)(w0 + c), b1 = *(const f32x4*)(w0 + c + 4); f32x4 o0, o1; o0.x = fd(a.x + b0.x); o0.y = fd(a.y + b0.y); o0.z = fd(a.z + b0.z); o0.w = fd(a.w + b0.w); o1.x = fd(b.x + b1.x); o1.y = fd(b.y + b1.y); o1.z = fd(b.z + b1.z); o1.w = fd(b.w + b1.w);
            *(f32x4*)(DEC + (size_t)m * 1024 + c) = o0; *(f32x4*)(DEC + (size_t)m * 1024 + c + 4) = o1; }
        else if (e == 1) { const f32x4 b0 = *(const f32x4*)(a0 + c), b1 = *(const f32x4*)(a0 + c + 4); f32x4 o0, o1; o0.x = sigmoidf_(a.x + b0.x); o0.y = sigmoidf_(a.y + b0.y); o0.z = sigmoidf_(a.z + b0.z); o0.w = sigmoidf_(a.w + b0.w); o1.x = sigmoidf_(b.x + b1.x); o1.y = sigmoidf_(b.y + b1.y); o1.z = sigmoidf_(b.z + b1.z); o1.w = sigmoidf_(b.w + b1.w);
            st_bf16x8((bf16*)ASIG + (size_t)m * 1024 + c, o0, o1); }
        else st_bf16x8(G + (size_t)m * 1024 + c, a, b); }
    __device__ __forceinline__ void st(int, int, f32x4, int) const {} };
struct EpiF32 { float* O; int ld; __device__ __forceinline__ void st(int r, int c, f32x4 v, int) const { *(f32x4*)(O + (size_t)r * ld + c) = v; } };
struct EpiPre1 { float* O; const float* x; __device__ __forceinline__ void st(int r, int c, f32x4 v, int) const { const f32x4 xv = *(const f32x4*)(x + (size_t)r * D + c); *(f32x4*)(O + (size_t)r * D + c) = ALPHA * xv + v; } };
struct EpiSwiglu { static constexpr bool PERM = true; unsigned char* H; const float* bg; const float* bu;
    __device__ __forceinline__ float f(float g, float u) const { g = fminf(g, 7.0f); u = fminf(fmaxf(u, -7.0f), 7.0f); return g * sigmoidf_(1.702f * g) * (u + 1.0f); }
    __device__ __forceinline__ void stp(int r, int c, f32x4 g, f32x4 u, int e) const { const f32x4 b0 = *(const f32x4*)(bg + (size_t)e * D + c), b1 = *(const f32x4*)(bu + (size_t)e * D + c);
        f32x4 o; o.x = f(g.x + b0.x, u.x + b1.x); o.y = f(g.y + b0.y, u.y + b1.y); o.z = f(g.z + b0.z, u.z + b1.z); o.w = f(g.w + b0.w, u.w + b1.w); *(unsigned*)(H + (size_t)r * D + c) = pk_fp8x4(o.x * FP8_SA2, o.y * FP8_SA2, o.z * FP8_SA2, o.w * FP8_SA2); }
    __device__ __forceinline__ unsigned q4(int c, f32x4 g, f32x4 u, int e) const { const f32x4 b0 = *(const f32x4*)(bg + (size_t)e * D + c), b1 = *(const f32x4*)(bu + (size_t)e * D + c);
        return pk_fp8x4(f(g.x + b0.x, u.x + b1.x) * FP8_SA2, f(g.y + b0.y, u.y + b1.y) * FP8_SA2, f(g.z + b0.z, u.z + b1.z) * FP8_SA2, f(g.w + b0.w, u.w + b1.w) * FP8_SA2); }
    __device__ __forceinline__ void stp8(int r, int c, f32x4 g0, f32x4 g1, f32x4 u0, f32x4 u1, int e) const { u32x2 w; w.x = q4(c, g0, u0, e); w.y = q4(c + 4, g1, u1, e); *(u32x2*)(H + (size_t)r * D + c) = w; } };
struct EpiDown { static constexpr bool PERM = true; bf16* O; const float* bd; __device__ __forceinline__ void st(int r, int c, f32x4 v, int e) const { const f32x4 b = *(const f32x4*)(bd + (size_t)e * D + c); st_bf16x4(O + (size_t)r * D + c, v + b); }
    __device__ __forceinline__ void st8(int r, int c, f32x4 a, f32x4 b, int e) const { const f32x4 b0 = *(const f32x4*)(bd + (size_t)e * D + c), b1 = *(const f32x4*)(bd + (size_t)e * D + c + 4); st_bf16x8(O + (size_t)r * D + c, a + b0, b + b1); } };
struct EpiBf16 { static constexpr bool PERM = true; bf16* O; int ld; __device__ __forceinline__ void st(int r, int c, f32x4 v, int) const { st_bf16x4(O + (size_t)r * ld + c, v); }
    __device__ __forceinline__ void st8(int r, int c, f32x4 a, f32x4 b, int) const { st_bf16x8(O + (size_t)r * ld + c, a, b); } };
struct EpiFinal { float* out; const bf16* PL; const bf16* H2;
    __device__ __forceinline__ void st(int r, int c, f32x4 v, int) const { const size_t o = (size_t)r * D + c; const u32x2 hw = *(const u32x2*)(H2 + o); const u32x2 pw = *(const u32x2*)(PL + o);
        f32x4 q; q.x = bflo(hw.x) + sigmoidf_(v.x) * bflo(pw.x); q.y = bfhi(hw.x) + sigmoidf_(v.y) * bfhi(pw.x); q.z = bflo(hw.y) + sigmoidf_(v.z) * bflo(pw.y); q.w = bfhi(hw.y) + sigmoidf_(v.w) * bfhi(pw.y); *(f32x4*)(out + o) = q; } };


namespace pg8 {
typedef short bf16x8 __attribute__((ext_vector_type(8)));
constexpr int BM = 256, BK = 64, HALF = 128, HTB = HALF * BK * 2, STAGE_BYTES = 8 * HTB, NXCD = 8, WGM = 8;
__device__ __forceinline__ int lds_byte(int r, int c) { const int st = (r >> 4) * 2 + (c >> 5), rr = r & 15, cc = c & 31, ob = rr * 64 + cc * 2; return st * 1024 + (ob ^ (((ob >> 9) & 1) << 5)); }
__device__ __forceinline__ void stage_rc(int b, int& R, int& C) { const int st = b / 1024, sb = b % 1024, swz = sb ^ (((sb >> 9) & 1) << 5); R = (st >> 1) * 16 + swz / 64; C = (st & 1) * 32 + (swz % 64) / 2; }
struct Unit { int pm, pn; };
struct StaticOrder {
    int nM, nN, nwg, G, c;
    __device__ void init(int nM_, int nN_, int G_, int c_) { nM = nM_; nN = nN_; nwg = nM * nN; G = G_; c = c_; }
    __device__ bool next(int i, Unit& u) const {
        const long L = (long)i * G + c; if (L >= nwg) return false;
        int wgid = (int)L; { const int q = nwg / NXCD, r = nwg % NXCD, xcd = wgid % NXCD, off = wgid / NXCD; wgid = (xcd < r ? xcd * (q + 1) : r * (q + 1) + (xcd - r) * q) + off; }
        const int nig = WGM * nN, gid = wgid / nig, fm = gid * WGM, gsz = (nM - fm) < WGM ? (nM - fm) : WGM;
        u.pm = fm + ((wgid % nig) % gsz); u.pn = (wgid % nig) / gsz; return true;
    }
};
template <class E, class = void> struct epi_perm { static constexpr bool value = false; };
template <class E> struct epi_perm<E, decltype((void)E::PERM)> { static constexpr bool value = E::PERM; };
__device__ __forceinline__ int perm32(int rho) { const int n = rho >> 4, i = rho & 15; return 8 * (i >> 2) + 4 * n + (i & 3); }
template <bool PAIR, class Epi>
__device__ __forceinline__ void epilogue(const f32x4 (&acc)[2][2][4][2], const Unit& u, int e, const Epi& E, int wr, int wc, int fr, int fq) {
    const int row0 = u.pm * BM + wr * 64 + fr;
#pragma unroll
    for (int ai = 0; ai < 2; ++ai)
#pragma unroll
        for (int m = 0; m < 4; ++m) { const int row = row0 + ai * HALF + m * 16;
            if constexpr (PAIR) {
                if constexpr (epi_perm<Epi>::value) E.stp8(row, u.pn * HALF + wc * 32 + 8 * fq, acc[ai][0][m][0], acc[ai][0][m][1], acc[ai][1][m][0], acc[ai][1][m][1], e);
                else {
#pragma unroll
                    for (int n = 0; n < 2; ++n) E.stp(row, u.pn * HALF + wc * 32 + n * 16 + 4 * fq, acc[ai][0][m][n], acc[ai][1][m][n], e); }
            } else if constexpr (epi_perm<Epi>::value) {
#pragma unroll
                for (int bj = 0; bj < 2; ++bj) E.st8(row, u.pn * BM + bj * HALF + wc * 32 + 8 * fq, acc[ai][bj][m][0], acc[ai][bj][m][1], e);
            } else {
#pragma unroll
                for (int bj = 0; bj < 2; ++bj)
#pragma unroll
                    for (int n = 0; n < 2; ++n) E.st(row, u.pn * BM + bj * HALF + wc * 32 + n * 16 + 4 * fq, acc[ai][bj][m][n], e);
            } }
}
typedef int i32x8 __attribute__((ext_vector_type(8)));
__device__ __forceinline__ i32x8 cat8(const bf16x8& lo, const bf16x8& hi) { const u32x4 a = __builtin_bit_cast(u32x4, lo), b = __builtin_bit_cast(u32x4, hi); i32x8 r; r[0] = (int)a.x; r[1] = (int)a.y; r[2] = (int)a.z; r[3] = (int)a.w; r[4] = (int)b.x; r[5] = (int)b.y; r[6] = (int)b.z; r[7] = (int)b.w; return r; }
template <bool PAIR, bool FP8, class Epi>
__device__ __forceinline__ void gemm_phase(LAS unsigned char* lds, const GemmDesc& g, const Epi& E, int G, int cid) {
    const int tid = threadIdx.x, wid = __builtin_amdgcn_readfirstlane(tid >> 6), lane = tid & 63, wr = wid >> 2, wc = wid & 3, fr = lane & 15, fq = lane >> 4;
    const unsigned pitchB = FP8 ? (unsigned)g.K : (unsigned)g.K * 2u;
    const int nt = g.kext ? (int)((FP8 ? (unsigned)g.kext : (unsigned)g.kext * 2u) / 128u) : (int)(pitchB / 128u);
    const int sc_a = g.ea, sc_b = g.eb;
    StaticOrder S; S.init(g.nblk ? *g.nblk : g.Mrows / BM, g.N / BM, G, cid);
    unsigned voffA[2], voffB[2];
#pragma unroll
    for (int i = 0; i < 2; ++i) { int R, C; stage_rc(tid * 16 + i * 8192, R, C); const int Rb = epi_perm<Epi>::value ? ((R & ~31) + perm32(R & 31)) : R;
        voffA[i] = (unsigned)R * pitchB + (unsigned)C * 2u; voffB[i] = (unsigned)Rb * pitchB + (unsigned)C * 2u; }
    const size_t kstep = (size_t)(BK * 2);
    const size_t hstep = (size_t)HALF * pitchB;
    const size_t tstep = 2 * hstep;
    const unsigned ldsw = (unsigned)wid * 1024u;
    const int aoff = lds_byte(wr * 64 + fr, fq * 8), boff = lds_byte(wc * 32 + fr, fq * 8);
    const char* gA = (const char*)g.A;
#define PG8_SA(b, h) (((b) * 2 + (h)) * HTB)
#define PG8_SB(b, h) ((4 + (b) * 2 + (h)) * HTB)
#define PG8_STAGE(bufoff, gbase, voff) do { _Pragma("unroll") for (int _i = 0; _i < 2; ++_i) \
        __builtin_amdgcn_global_load_lds((const unsigned*)((const char*)(gbase) + (voff)[_i]), (LAS unsigned*)(lds + (bufoff) + ldsw + _i * 8192), 16, 0, 0); } while (0)
#define PG8_LD8(dst, off) do { const u32x4 lo_ = *(const LAS u32x4*)(lds + (off)), hi_ = *(const LAS u32x4*)(lds + (off) + 1024); \
        dst[0] = (int)lo_.x; dst[1] = (int)lo_.y; dst[2] = (int)lo_.z; dst[3] = (int)lo_.w; dst[4] = (int)hi_.x; dst[5] = (int)hi_.y; dst[6] = (int)hi_.z; dst[7] = (int)hi_.w; } while (0)
#define PG8_LDA(dst, b, h) do { _Pragma("unroll") for (int m = 0; m < 4; ++m) { if constexpr (FP8) PG8_LD8(dst##8[m], PG8_SA(b, h) + aoff + m * 2048); else { _Pragma("unroll") for (int k = 0; k < 2; ++k) dst[m][k] = *(const LAS bf16x8*)(lds + PG8_SA(b, h) + aoff + m * 2048 + k * 1024); } } } while (0)
#define PG8_LDB(dst, b, h) do { _Pragma("unroll") for (int n = 0; n < 2; ++n) { if constexpr (FP8) PG8_LD8(dst##8[n], PG8_SB(b, h) + boff + n * 2048); else { _Pragma("unroll") for (int k = 0; k < 2; ++k) dst[n][k] = *(const LAS bf16x8*)(lds + PG8_SB(b, h) + boff + n * 2048 + k * 1024); } } } while (0)
#define PG8_MMA(ai, bj, At, Bt) do { __builtin_amdgcn_s_setprio(1); _Pragma("unroll") for (int m = 0; m < 4; ++m) _Pragma("unroll") for (int n = 0; n < 2; ++n) { \
        if constexpr (FP8) asm volatile("v_mfma_scale_f32_16x16x128_f8f6f4 %0, %1, %2, %0, %3, %4 op_sel_hi:[0,0,0]" : "+v"(acc[ai][bj][m][n]) : "v"(Bt##8[n]), "v"(At##8[m]), "v"(sc_b), "v"(sc_a));   \
        else { _Pragma("unroll") for (int k = 0; k < 2; ++k) acc[ai][bj][m][n] = __builtin_amdgcn_mfma_f32_16x16x32_bf16(Bt[n][k], At[m][k], acc[ai][bj][m][n], 0, 0, 0); } } __builtin_amdgcn_s_setprio(0); } while (0)
#define PG8_WAIT_V(n) asm volatile("s_waitcnt vmcnt(" #n ")" ::: "memory")
#define PG8_WAIT_L(n) asm volatile("s_waitcnt lgkmcnt(" #n ")" ::: "memory")
#define PG8_BAR __builtin_amdgcn_s_barrier()
#define PG8_SCHED __builtin_amdgcn_sched_barrier(0)
    Unit cur, nxt; int ui = 0;
    if (!S.next(0, cur)) return;
    f32x4 acc[2][2][4][2];
#pragma unroll
    for (int a = 0; a < 2; ++a)
#pragma unroll
        for (int b = 0; b < 2; ++b)
#pragma unroll
            for (int m = 0; m < 4; ++m)
#pragma unroll
                for (int n = 0; n < 2; ++n) acc[a][b][m][n] = (f32x4){0.f, 0.f, 0.f, 0.f};
    bf16x8 At[4][2], B0[2][2], B1[2][2];
    i32x8 At8[4], B08[2], B18[2];
    int ecur = g.block_e ? g.block_e[cur.pm] : 0;
    const char* cA = gA + (size_t)cur.pm * tstep;
    const char* cB = (const char*)g.Bt + (size_t)ecur * g.bstride * (FP8 ? 1 : 2) + (size_t)cur.pn * tstep;
    PG8_STAGE(PG8_SB(0, 0), cB, voffB); PG8_STAGE(PG8_SB(0, 1), cB + hstep, voffB); PG8_STAGE(PG8_SA(0, 0), cA, voffA); PG8_STAGE(PG8_SA(0, 1), cA + hstep, voffA);
    if (wr == 1) PG8_BAR;
    PG8_WAIT_V(2); PG8_BAR;
    PG8_STAGE(PG8_SB(1, 0), cB + kstep, voffB); PG8_STAGE(PG8_SA(1, 0), cA + kstep, voffA); PG8_STAGE(PG8_SB(1, 1), cB + hstep + kstep, voffB);
    PG8_WAIT_V(6); PG8_BAR;
    for (;;) {
        const bool has_next = S.next(ui + 1, nxt);
        int enxt = ecur; const char* nB = cB; const char* nA = cA;
        if (has_next) { enxt = g.block_e ? g.block_e[nxt.pm] : 0; nA = gA + (size_t)nxt.pm * tstep; nB = (const char*)g.Bt + (size_t)enxt * g.bstride * (FP8 ? 1 : 2) + (size_t)nxt.pn * tstep; }
        for (int t = 0; t < nt; t += 2) {
            const bool last = (t == nt - 2);
            const char* a1 = cA + (size_t)(t + 1) * kstep;
            const char* a2 = last ? nA : cA + (size_t)(t + 2) * kstep; const char* b2 = last ? nB : cB + (size_t)(t + 2) * kstep;
            const char* a3 = a2 + kstep; const char* b3 = b2 + kstep;
            PG8_LDB(B0, 0, 0); PG8_LDB(B1, 0, 1); PG8_SCHED; PG8_LDA(At, 0, 0); PG8_STAGE(PG8_SA(1, 1), a1 + hstep, voffA);
            PG8_WAIT_V(8); PG8_WAIT_L(0); PG8_BAR; PG8_MMA(0, 0, At, B0); PG8_MMA(0, 1, At, B1); PG8_BAR; PG8_SCHED;
            PG8_LDA(At, 0, 1); PG8_STAGE(PG8_SB(0, 0), b2, voffB); PG8_STAGE(PG8_SB(0, 1), b2 + hstep, voffB); PG8_STAGE(PG8_SA(0, 0), a2, voffA);
            PG8_WAIT_V(8); PG8_WAIT_L(0); PG8_BAR; PG8_MMA(1, 0, At, B0); PG8_MMA(1, 1, At, B1); PG8_BAR; PG8_SCHED;
            PG8_LDB(B0, 1, 0); PG8_LDB(B1, 1, 1); PG8_SCHED; PG8_LDA(At, 1, 0); PG8_STAGE(PG8_SA(0, 1), a2 + hstep, voffA);
            PG8_WAIT_V(8); PG8_WAIT_L(0); PG8_BAR; PG8_MMA(0, 0, At, B0); PG8_MMA(0, 1, At, B1); PG8_BAR; PG8_SCHED;
            PG8_LDA(At, 1, 1); PG8_STAGE(PG8_SB(1, 0), b3, voffB); PG8_STAGE(PG8_SB(1, 1), b3 + hstep, voffB); PG8_STAGE(PG8_SA(1, 0), a3, voffA);
            PG8_WAIT_V(8); PG8_WAIT_L(0); PG8_BAR; PG8_MMA(1, 0, At, B0); PG8_MMA(1, 1, At, B1); PG8_BAR; PG8_SCHED;
        }
        if constexpr (FP8) asm volatile("s_nop 15\n\ts_nop 15" ::: "memory");
        if (wr == 0) PG8_BAR;
        epilogue<PAIR, Epi>(acc, cur, ecur, E, wr, wc, fr, fq);
        if (!has_next) break;
#pragma unroll
        for (int a = 0; a < 2; ++a)
#pragma unroll
            for (int b = 0; b < 2; ++b)
#pragma unroll
                for (int m = 0; m < 4; ++m)
#pragma unroll
                    for (int n = 0; n < 2; ++n) acc[a][b][m][n] = (f32x4){0.f, 0.f, 0.f, 0.f};
        cur = nxt; cA = nA; cB = nB; ecur = enxt; ++ui;
        if (wr == 1) PG8_BAR;
    }
    PG8_WAIT_V(0);
    PG8_BAR;
#undef PG8_SA
#undef PG8_SB
#undef PG8_STAGE
#undef PG8_LDA
#undef PG8_LD8
#undef PG8_LDB
#undef PG8_MMA
#undef PG8_WAIT_V
#undef PG8_WAIT_L
#undef PG8_BAR
#undef PG8_SCHED
}
}

#ifndef NAIVE_GEMM
#define NAIVE_GEMM 0
#endif
template <class Epi> __device__ __forceinline__ void gemm_run_part(Frame& F, const GemmDesc& g, const Epi& E, int G, int cid) {
    pg8::gemm_phase<false, false, Epi>(F.lds, g, E, G, cid);
    __syncthreads();
}
template <bool PAIR, class Epi, bool FP8 = false> __device__ __forceinline__ void gemm_run(Frame& F, const GemmDesc& g, const Epi& E) {
#if NAIVE_GEMM
    static_assert(!FP8, "the naive GEMM has no fp8 path");
    ngemm_phase<PAIR, Epi>(F, g, E);
#else
    pg8::gemm_phase<PAIR, FP8, Epi>(F.lds, g, E, F.G, F.bid);
    __syncthreads();
#endif
}

__device__ __forceinline__ void transpose_item(const float* W, int K, int N, bf16* WT, int Kp, size_t row0, int k0, int n0, LAS float* scr, int lane) {
    const int n = n0 + (lane & 31);
#pragma unroll 8
    for (int i = 0; i < 32; ++i) { const int kk = 2 * i + (lane >> 5), k = k0 + kk; scr[kk * 33 + (lane & 31)] = (k < K && n < N) ? W[(size_t)k * N + n] : 0.f; }
    LDS_WAIT(); asm volatile("" ::: "memory");
    const int c = lane & 7;
#pragma unroll
    for (int j = 0; j < 4; ++j) { const int nn = (lane >> 3) + 8 * j; const LAS float* s = scr + (8 * c) * 33 + nn;
        u32x4 o; o.x = pk2(s[0 * 33], s[1 * 33]); o.y = pk2(s[2 * 33], s[3 * 33]); o.z = pk2(s[4 * 33], s[5 * 33]); o.w = pk2(s[6 * 33], s[7 * 33]);
        *(u32x4*)(WT + (row0 + nn) * Kp + k0 + 8 * c) = o; }
    LDS_WAIT(); asm volatile("" ::: "memory");
}
__device__ __forceinline__ void tb_load(const float* W, int N, int k0, int n0, f32x4 (&v)[16], int lane) {
    const int kr = lane >> 4, n4 = n0 + (lane & 15) * 4; const bool ok = n4 < N;
#pragma unroll
    for (int i = 0; i < 16; ++i) v[i] = ok ? __builtin_nontemporal_load((const f32x4*)(W + (size_t)(k0 + 4 * i + kr) * N + n4)) : (f32x4){0.f, 0.f, 0.f, 0.f};
}
__device__ __forceinline__ void tb_store(bf16* WT, int Kp, int k0, int n0, const f32x4 (&v)[16], int lane) {
    const int R = lane >> 4, c16 = lane & 15;
    unsigned od[32];
#pragma unroll
    for (int i = 0; i < 16; ++i) {
        unsigned x0 = __float_as_uint(v[i].x), x1 = __float_as_uint(v[i].y), x2 = __float_as_uint(v[i].z), x3 = __float_as_uint(v[i].w);
        { const auto q = __builtin_amdgcn_permlane16_swap(x0, x1, false, false); x0 = q[0]; x1 = q[1]; }
        { const auto q = __builtin_amdgcn_permlane16_swap(x2, x3, false, false); x2 = q[0]; x3 = q[1]; }
        { const auto q = __builtin_amdgcn_permlane32_swap(x0, x2, false, false); x0 = q[0]; x2 = q[1]; }
        { const auto q = __builtin_amdgcn_permlane32_swap(x1, x3, false, false); x1 = q[0]; x3 = q[1]; }
        od[2 * i] = pk2(__uint_as_float(x0), __uint_as_float(x1)); od[2 * i + 1] = pk2(__uint_as_float(x2), __uint_as_float(x3));
    }
    bf16* dp = WT + (size_t)(n0 + 4 * c16 + R) * Kp + k0;
#pragma unroll
    for (int j = 0; j < 8; ++j) *(u32x4*)(dp + 8 * j) = (u32x4){od[4 * j], od[4 * j + 1], od[4 * j + 2], od[4 * j + 3]};
}
__device__ __forceinline__ void p0_prologue(Frame& F, const Args& a) {
    LAS float* scr = (LAS float*)(F.lds + F.wave * 16384);
    unsigned char* ws = F.ws;
    const int gw = F.bid * 8 + F.wave, NGW = F.G * 8;
    {
        constexpr int NB0 = 96 * 32, NB1 = 32 * 32, NBIG = NB0 + 2 * NB1;
        f32x4 va[16];
        for (int it = gw; it < NBIG; it += NGW) {
            const float* W; bf16* WT; int N, r = it;
            if (r < NB0) { W = a.in[I_WIN]; WT = (bf16*)(ws + WS_WIN); N = INC; }
            else if (r < NB0 + NB1) { r -= NB0; W = a.in[I_WOUT]; WT = (bf16*)(ws + WS_WOUT); N = D; }
            else { r -= NB0 + NB1; W = a.in[I_PLEG]; WT = (bf16*)(ws + WS_WPG); N = D; }
            const int kb = r & 31, nb = r >> 5;
            tb_load(W, N, 64 * kb, 64 * nb, va, F.lane); tb_store(WT, D, 64 * kb, 64 * nb, va, F.lane);
        }
    }
    constexpr int I3 = 4 * 64, I4 = 4 * 32, I5 = 4 * 32, I6 = 4 * 32, I7 = 32 * 8, I8 = 32 * 8;
    constexpr int NITEMS = I3 + I4 + I5 + I6 + I7 + I8;
    for (int it = gw; it < NITEMS; it += NGW) {
        int r = it;
#define TR_SIMPLE(cnt, W, K, N, WT, Kp, nblk) if (r < (cnt)) { const int kb = r / (nblk), nb = r % (nblk); transpose_item((W), (K), (N), (bf16*)(WT), (Kp), (size_t)(32 * nb), 64 * kb, 32 * nb, scr, F.lane); continue; } r -= (cnt);
        TR_SIMPLE(I3, a.in[I_PLEW], 256, 2048, ws + WS_WPL, 256, 64)
        TR_SIMPLE(I4, a.in[I_WUP], 96, 1024, ws + WS_WUP, 256, 32)
        TR_SIMPLE(I5, a.in[I_AUP], 96, 1024, ws + WS_AUP, 256, 32)
        TR_SIMPLE(I6, a.in[I_GUP], 256, 1024, ws + WS_GUP, 256, 32)
        TR_SIMPLE(I7, a.in[I_W1K], 2048, 64, ws + WS_CW1K, 2048, 8)
        TR_SIMPLE(I8, a.in[I_W1V], 2048, 64, ws + WS_CW1V, 2048, 8)
#undef TR_SIMPLE
        (void)r;
    }
    const size_t gt = (size_t)F.bid * 512 + F.tid, NT = (size_t)F.G * 512;
    { const float* x = a.in[I_X]; bf16* xb = (bf16*)(ws + WS_XB);
      constexpr size_t NV = (size_t)M * D / 8;
      for (size_t i = gt; i < NV; i += 4 * NT) {
          f32x4 v0[4], v1[4];
#pragma unroll
          for (int q = 0; q < 4; ++q) { const size_t j = i + q * NT; if (j < NV) { v0[q] = __builtin_nontemporal_load((const f32x4*)(x + j * 8)); v1[q] = __builtin_nontemporal_load((const f32x4*)(x + j * 8 + 4)); } }
#pragma unroll
          for (int q = 0; q < 4; ++q) { const size_t j = i + q * NT; if (j < NV) { u32x4 o; o.x = pk2(v0[q].x, v0[q].y); o.y = pk2(v0[q].z, v0[q].w); o.z = pk2(v1[q].x, v1[q].y); o.w = pk2(v1[q].z, v1[q].w); *(u32x4*)(xb + j * 8) = o; } } } }
    { const float* p = a.in[I_P]; bf16* pb = (bf16*)(ws + WS_PB);
      for (size_t i = gt; i < (size_t)M * 256 / 8; i += NT) { const f32x4 v0 = *(const f32x4*)(p + i * 8), v1 = *(const f32x4*)(p + i * 8 + 4);
          u32x4 o; o.x = pk2(v0.x, v0.y); o.y = pk2(v0.z, v0.w); o.z = pk2(v1.x, v1.y); o.w = pk2(v1.z, v1.w); *(u32x4*)(pb + i * 8) = o; } }
    { int* rt = (int*)(ws + WS_ROWTOK); for (size_t i = gt; i < (size_t)MAXROWS; i += NT) rt[i] = 0; }
    if (gt < 192) ((int*)(ws + WS_BLKE + 4096))[gt] = (int)(gt >> 6);
    { const float* rw = a.in[I_RW]; bf16* rwt = (bf16*)(ws + WS_RWT);
      for (size_t i = gt; i < (size_t)32 * D; i += NT) { const int e = (int)(i >> 11), k = (int)(i & 2047); const float w = rw[(size_t)k * 32 + e]; const unsigned hi = f2bf(w); rwt[i] = (bf16)hi; rwt[(size_t)32 * D + i] = (bf16)f2bf(w - bf2f(hi)); } }
}

__device__ __forceinline__ void unpack8(const u32x4 w, float (&f)[8]) { f[0] = bflo(w.x); f[1] = bfhi(w.x); f[2] = bflo(w.y); f[3] = bfhi(w.y); f[4] = bflo(w.z); f[5] = bfhi(w.z); f[6] = bflo(w.w); f[7] = bfhi(w.w); }
__device__ __forceinline__ u32x4 pack8(const float (&f)[8]) { u32x4 o; o.x = pk2(f[0], f[1]); o.y = pk2(f[2], f[3]); o.z = pk2(f[4], f[5]); o.w = pk2(f[6], f[7]); return o; }
__device__ __forceinline__ void ld8f(const float* p, float (&f)[8]) { const f32x4 a = *(const f32x4*)p, b = *(const f32x4*)(p + 4); f[0] = a.x; f[1] = a.y; f[2] = a.z; f[3] = a.w; f[4] = b.x; f[5] = b.y; f[6] = b.z; f[7] = b.w; }
__device__ __forceinline__ void st8f(float* p, const float (&f)[8]) { *(f32x4*)p = (f32x4){f[0], f[1], f[2], f[3]}; *(f32x4*)(p + 4) = (f32x4){f[4], f[5], f[6], f[7]}; }
__device__ __forceinline__ float dpp_sum8(float x) {
    x += __builtin_bit_cast(float, __builtin_amdgcn_update_dpp(0, __builtin_bit_cast(int, x), 0xB1, 0xF, 0xF, true));
    x += __builtin_bit_cast(float, __builtin_amdgcn_update_dpp(0, __builtin_bit_cast(int, x), 0x4E, 0xF, 0xF, true));
    x += __builtin_bit_cast(float, __builtin_amdgcn_update_dpp(0, __builtin_bit_cast(int, x), 0x141, 0xF, 0xF, true));
    return x;
}
__device__ __forceinline__ void shift8(const bf16* Z, size_t zo, int c, bool has_prev, const float* mu, float (&o)[8]) {
    float zc[8], zp[8], m8[8];
    unpack8(*(const u32x4*)(Z + zo + c), zc);
    if (has_prev) unpack8(*(const u32x4*)(Z + zo - NZ + c), zp); else {
#pragma unroll
        for (int i = 0; i < 8; ++i) zp[i] = 0.f; }
    ld8f(mu + (c - ZRW), m8);
#pragma unroll
    for (int i = 0; i < 8; ++i) o[i] = zc[i] + (zp[i] - zc[i]) * m8[i];
}

__device__ __forceinline__ void p2_prep(Frame& F, const Args& a) {
    unsigned char* ws = F.ws;
    const bf16* Z = (const bf16*)(ws + WS_Z);
    const int gw = F.bid * 8 + F.wave, NGW = F.G * 8, lane = F.lane;
    for (int it = gw; it < 2 * 4096; it += NGW) {
        const int kv = it >> 12, row = it & 4095, g = row & 3, c = (row >> 2) & 255, b = row >> 10;
        bf16* dst = (bf16*)(ws + (kv ? WS_ACV : WS_ACK)) + (size_t)row * 2048;
        const float* pe = a.in[kv ? I_PEV : I_PEK];
        const int col0 = (kv ? ZVC : ZKC) + g * 64;
#pragma unroll
        for (int q = 0; q < 4; ++q) {
            const int idx = q * 64 + lane, i = idx >> 3, d8 = (idx & 7) * 8;
            u32x4 o = (u32x4){0u, 0u, 0u, 0u};
            if (c < NCMP) { float z8[8], p8[8]; unpack8(*(const u32x4*)(Z + (size_t)(b * T + 16 * c + i) * NZ + col0 + d8), z8); ld8f(pe + i * 64 + d8, p8);
#pragma unroll
                for (int e = 0; e < 8; ++e) z8[e] += p8[e];
                o = pack8(z8); }
            *(u32x4*)(dst + i * 64 + d8) = o;
        }
    }
    const float* mu = a.in[I_MU];
    bf16* WL = (bf16*)(ws + WS_WL); bf16* AL = (bf16*)(ws + WS_AL); bf16* GLS = (bf16*)(ws + WS_GLS);
    for (int m = gw; m < M; m += NGW) {
        const int t = m & (T - 1);
        float zs[8];
#pragma unroll
        for (int e = 0; e < 8; ++e) zs[e] = 0.f;
        if (lane < 56) shift8(Z, (size_t)m * NZ, ZWL + lane * 8, t != 0, mu, zs);
        if (lane < 32) { float o[8];
#pragma unroll
            for (int e = 0; e < 8; ++e) o[e] = lane < 12 ? tanhf(zs[e]) : 0.f;
            *(u32x4*)(WL + (size_t)m * 256 + lane * 8) = pack8(o); }
        if (lane >= 12 && lane < 44) { float o[8];
#pragma unroll
            for (int e = 0; e < 8; ++e) o[e] = lane < 24 ? zs[e] : 0.f;
            *(u32x4*)(AL + (size_t)m * 256 + (lane - 12) * 8) = pack8(o); }
        if (lane >= 24 && lane < 56) { float o[8];
#pragma unroll
            for (int e = 0; e < 8; ++e) o[e] = sigmoidf_(zs[e]);
            *(u32x4*)(GLS + (size_t)m * 256 + (lane - 24) * 8) = pack8(o); }
    }
}

__device__ __forceinline__ void p4_prep(Frame& F, const Args& a) {
    unsigned char* ws = F.ws;
    const int gw = F.bid * 8 + F.wave, NGW = F.G * 8, lane = F.lane;
    for (int it = gw; it < 2 * 4096; it += NGW) {
        const int kv = it >> 12, row = it & 4095;
        const float* H = (const float*)(ws + (kv ? WS_HCMPV : WS_HCMPK)) + (size_t)row * 64;
        const float* w2 = a.in[kv ? I_W2V : I_W2K];
        const float hv = gelu_tanh(H[lane] + H[(size_t)4096 * 64 + lane]); float o = 0.f;
#pragma unroll 8
        for (int j = 0; j < 64; ++j) o += __shfl(hv, j) * w2[j * 64 + lane];
        ((bf16*)(ws + (kv ? WS_VCMP : WS_KCMP)))[(size_t)row * 64 + lane] = (bf16)f2bf(o);
    }
    const bf16* Z = (const bf16*)(ws + WS_Z);
    const float* mu = a.in[I_MU]; const float* DEC = (const float*)(ws + WS_DEC); const float* ASIG = (const float*)(ws + WS_ASIG);
    const float* kk_w = a.in[I_KK]; const float* ka_w = a.in[I_KA];
    float* SC = (float*)(ws + WS_SC);
    for (int it = gw; it < M * 2; it += NGW) {
        const int m = it >> 1, half = it & 1, t = m & (T - 1), b = m >> 12, col = (half * 64 + lane) * 8, h = col >> 6, j8 = col & 63;
        const size_t zo = (size_t)m * NZ;
        float r[8], k[8], v[8], av[8], w[8], kkw[8], kaw[8];
        shift8(Z, zo, ZR + col, t != 0, mu, r); shift8(Z, zo, ZK + col, t != 0, mu, k); shift8(Z, zo, ZV + col, t != 0, mu, v);
        unpack8(*(const u32x4*)((const bf16*)ASIG + (size_t)m * 1024 + col), av); ld8f(DEC + (size_t)m * 1024 + col, w); ld8f(kk_w + col, kkw); ld8f(ka_w + col, kaw);
        float kk[8], ss = 0.f;
#pragma unroll
        for (int e = 0; e < 8; ++e) { kk[e] = k[e] * kkw[e]; ss += kk[e] * kk[e]; }
        const float inv = 1.0f / fmaxf(sqrtf(dpp_sum8(ss)), 1e-12f);
        float k2[8], na[8], bb[8];
#pragma unroll
        for (int e = 0; e < 8; ++e) { kk[e] *= inv; k2[e] = k[e] * (1.0f + (av[e] - 1.0f) * kaw[e]); na[e] = -kk[e]; bb[e] = kk[e] * av[e]; }
        { const size_t ti = (size_t)(b * 16 + h) * T + t; st8f(SC + ti * 64 + j8, w);
          bf16* sb16 = (bf16*)(ws + WS_SC + (size_t)64 * MiB) + ti * 320 + j8;
          *(u32x4*)(sb16) = pack8(r); *(u32x4*)(sb16 + 64) = pack8(k2); *(u32x4*)(sb16 + 128) = pack8(v); *(u32x4*)(sb16 + 192) = pack8(na); *(u32x4*)(sb16 + 256) = pack8(bb); }
        { float rk8[8], sb = 0.f; ld8f(a.in[I_RK] + col, rk8);
#pragma unroll
          for (int e = 0; e < 8; ++e) sb += r[e] * k2[e] * rk8[e];
          const float bonus = dpp_sum8(sb); float bv[8];
#pragma unroll
          for (int e = 0; e < 8; ++e) bv[e] = bonus * v[e];
          *(u32x4*)((bf16*)(ws + WS_ACK) + (size_t)m * 1024 + col) = pack8(bv); }
    }
}

__device__ __forceinline__ float dpp_sum16(float x) {
    x += __builtin_bit_cast(float, __builtin_amdgcn_update_dpp(0, __builtin_bit_cast(int, x), 0xB1, 0xF, 0xF, true));
    x += __builtin_bit_cast(float, __builtin_amdgcn_update_dpp(0, __builtin_bit_cast(int, x), 0x4E, 0xF, 0xF, true));
    x += __builtin_bit_cast(float, __builtin_amdgcn_update_dpp(0, __builtin_bit_cast(int, x), 0x141, 0xF, 0xF, true));
    x += __builtin_bit_cast(float, __builtin_amdgcn_update_dpp(0, __builtin_bit_cast(int, x), 0x140, 0xF, 0xF, true));
    return x;
}
struct CvItem { const float* src; unsigned char* dst; };
__device__ __forceinline__ CvItem cv_decode(const Args& a, unsigned char* ws, int it) {
    const int e = it / 3072, rr = it % 3072, which = rr >> 10, ri = rr & 1023, kb = ri & 31, nb = ri >> 5, n0 = 64 * nb, k0 = 64 * kb;
    CvItem c;
    const float* W = a.in[which == 0 ? I_EWG : (which == 1 ? I_EWU : I_EWD)] + (size_t)e * D * D;
    c.src = W + (size_t)k0 * D + n0;
    const size_t row0 = which == 2 ? (size_t)e * 2048 + n0 : (size_t)e * 4096 + (n0 >> 7) * 256 + (which == 1 ? 128 : 0) + (n0 & 127);
    c.dst = (unsigned char*)(ws + (which == 2 ? WS_WDN : WS_WGU)) + row0 * D + k0;
    return c;
}
__device__ __forceinline__ void cv_load(const CvItem& c, f32x4 (&v)[16], int lane) {
    const int kr = lane >> 4, n4 = (lane & 15) * 4;
#pragma unroll
    for (int i = 0; i < 16; ++i) v[i] = __builtin_nontemporal_load((const f32x4*)(c.src + (size_t)(4 * i + kr) * D + n4));
}
__device__ __forceinline__ void cv_store(const CvItem& cc, const f32x4 (&v)[16], int lane) {
    const int R = lane >> 4, c16 = lane & 15;
    unsigned od[16];
#pragma unroll
    for (int i = 0; i < 16; ++i) {
        unsigned x0 = __float_as_uint(v[i].x), x1 = __float_as_uint(v[i].y), x2 = __float_as_uint(v[i].z), x3 = __float_as_uint(v[i].w);
        { const auto q = __builtin_amdgcn_permlane16_swap(x0, x1, false, false); x0 = q[0]; x1 = q[1]; }
        { const auto q = __builtin_amdgcn_permlane16_swap(x2, x3, false, false); x2 = q[0]; x3 = q[1]; }
        { const auto q = __builtin_amdgcn_permlane32_swap(x0, x2, false, false); x0 = q[0]; x2 = q[1]; }
        { const auto q = __builtin_amdgcn_permlane32_swap(x1, x3, false, false); x1 = q[0]; x3 = q[1]; }
        od[i] = pk_fp8x4(__uint_as_float(x0) * FP8_SW, __uint_as_float(x1) * FP8_SW, __uint_as_float(x2) * FP8_SW, __uint_as_float(x3) * FP8_SW);
    }
    unsigned char* dp = cc.dst + (size_t)(4 * c16 + R) * D;
#pragma unroll
    for (int j = 0; j < 4; ++j) *(u32x4*)(dp + 16 * j) = (u32x4){od[4 * j], od[4 * j + 1], od[4 * j + 2], od[4 * j + 3]};
}
__device__ __forceinline__ void p5_scan_conv(Frame& F, const Args& a, int mode) {
#ifndef SCAN_TC
#define SCAN_TC 32
#endif
    constexpr int TC = SCAN_TC, CHF = TC * 384, NLD = CHF / 1024;
    LAS float* buf = (LAS float*)F.lds;
    LAS unsigned* cnt = (LAS unsigned*)(F.lds + 2 * CHF * 4);
    const int tid = F.tid, lane = F.lane, wave = F.wave;
    if (tid == 0) *cnt = 0u;
    __syncthreads();
    if (wave < 4) { if (mode & 1) {
        const float* SC = (const float*)(F.ws + WS_SC);
        float* Y = (float*)(F.ws + WS_Y);
        const int kq = lane & 15, rl = lane >> 4;
        unsigned target = 0u;
        __builtin_amdgcn_s_setprio(3);
#define BAR4() do { LDS_WAIT(); asm volatile("" ::: "memory"); target += 4u; if (lane == 0) __hip_atomic_fetch_add(cnt, 1u, __ATOMIC_RELAXED, __HIP_MEMORY_SCOPE_WORKGROUP); \
        while (__hip_atomic_load(cnt, __ATOMIC_RELAXED, __HIP_MEMORY_SCOPE_WORKGROUP) < target) __builtin_amdgcn_s_sleep(1); asm volatile("" ::: "memory"); } while (0)
        for (int task = F.bid; task < 256; task += F.G) {
            const int bh = task >> 2, quarter = task & 3, b = bh >> 4, h = bh & 15;
            const int row = (quarter * 4 + wave) * 4 + rl;
            static_assert(TC == 32, "the compact staging below is written for 32-step chunks");
            const float* srcw = SC + (size_t)bh * T * 64;
            const bf16* srcb = (const bf16*)(F.ws + WS_SC + (size_t)64 * MiB) + (size_t)bh * T * 320;
            int wofs[2], bofs[5];
#pragma unroll
            for (int i = 0; i < 2; ++i) { const int p = tid + 256 * i; wofs[i] = (p >> 4) * 384 + 64 + (p & 15) * 4; }
#pragma unroll
            for (int i = 0; i < 5; ++i) { const int p = tid + 256 * i, tt = p / 40, q = p - tt * 40, comp = q >> 3; bofs[i] = tt * 384 + (comp == 0 ? 0 : 64 + 64 * comp) + (q & 7) * 8; }
#define SCAN_STAGE_LOAD(cc) do { _Pragma("unroll") for (int i = 0; i < 2; ++i) nw[i] = *(const f32x4*)(srcw + (size_t)(cc) * TC * 64 + (size_t)(tid + 256 * i) * 4); \
                _Pragma("unroll") for (int i = 0; i < 5; ++i) nb[i] = *(const u32x4*)(srcb + (size_t)(cc) * TC * 320 + (size_t)(tid + 256 * i) * 8); } while (0)
#define SCAN_STAGE_STORE(bufp) do { _Pragma("unroll") for (int i = 0; i < 2; ++i) *(LAS f32x4*)((bufp) + wofs[i]) = nw[i]; \
                _Pragma("unroll") for (int i = 0; i < 5; ++i) { *(LAS f32x4*)((bufp) + bofs[i]) = (f32x4){bflo(nb[i].x), bfhi(nb[i].x), bflo(nb[i].y), bfhi(nb[i].y)}; \
                    *(LAS f32x4*)((bufp) + bofs[i] + 4) = (f32x4){bflo(nb[i].z), bfhi(nb[i].z), bflo(nb[i].w), bfhi(nb[i].w)}; } } while (0)
            f32x4 nw[2]; u32x4 nb[5];
            BAR4();
            SCAN_STAGE_LOAD(0); SCAN_STAGE_STORE(buf);
            BAR4();
            f32x4 S = (f32x4){0.f, 0.f, 0.f, 0.f};
            for (int c = 0; c < T / TC; ++c) {
                const bool more = (c + 1 < T / TC);
                if (more) SCAN_STAGE_LOAD(c + 1);
                const LAS float* cb = buf + (c & 1) * CHF;
                f32x4 r4[2], w4[2], k4[2], a4[2], b4[2]; float vv[2];
                r4[0] = *(const LAS f32x4*)(cb + kq * 4); w4[0] = *(const LAS f32x4*)(cb + 64 + kq * 4); k4[0] = *(const LAS f32x4*)(cb + 128 + kq * 4);
                a4[0] = *(const LAS f32x4*)(cb + 256 + kq * 4); b4[0] = *(const LAS f32x4*)(cb + 320 + kq * 4); vv[0] = cb[192 + row];
                float ykeep[TC / 16], yprev = 0.f;
#pragma unroll
                for (int q = 0; q < TC / 16; ++q) ykeep[q] = 0.f;
#pragma unroll
                for (int tt = 0; tt < TC; ++tt) {
                    const int cu = tt & 1, nx1 = cu ^ 1;
                    if (tt + 1 < TC) { const LAS float* sp = cb + (tt + 1) * 384;
                        r4[nx1] = *(const LAS f32x4*)(sp + kq * 4); w4[nx1] = *(const LAS f32x4*)(sp + 64 + kq * 4); k4[nx1] = *(const LAS f32x4*)(sp + 128 + kq * 4);
                        a4[nx1] = *(const LAS f32x4*)(sp + 256 + kq * 4); b4[nx1] = *(const LAS f32x4*)(sp + 320 + kq * 4); vv[nx1] = sp[192 + row]; }
                    __builtin_amdgcn_sched_barrier(0);
                    float sa = (S.x * a4[cu].x + S.y * a4[cu].y) + (S.z * a4[cu].z + S.w * a4[cu].w);
                    sa = dpp_sum16(sa);
                    if (tt > 0) { const float yr = dpp_sum16(yprev); ykeep[(tt - 1) >> 4] = (kq == ((tt - 1) & 15)) ? yr : ykeep[(tt - 1) >> 4]; }
                    S = S * w4[cu] + sa * b4[cu] + vv[cu] * k4[cu];
                    yprev = (S.x * r4[cu].x + S.y * r4[cu].y) + (S.z * r4[cu].z + S.w * r4[cu].w);
                    __builtin_amdgcn_sched_barrier(0);
                }
                { const float yr = dpp_sum16(yprev); ykeep[(TC - 1) >> 4] = (kq == ((TC - 1) & 15)) ? yr : ykeep[(TC - 1) >> 4]; }
#pragma unroll
                for (int q = 0; q < TC / 16; ++q) Y[((size_t)(b * T) + c * TC + 16 * q + kq) * 1024 + h * 64 + row] = ykeep[q];
                if (more) SCAN_STAGE_STORE(buf + ((c + 1) & 1) * CHF);
                BAR4();
            }
        }
#undef BAR4
#undef SCAN_STAGE_LOAD
#undef SCAN_STAGE_STORE
        __builtin_amdgcn_s_setprio(0);
    } } else if (mode & 2) {
        unsigned char* ws = F.ws;
        const int gw = F.bid * 4 + (wave - 4), NGW = F.G * 4;
        constexpr int NIT = NE * 3 * 1024;
        f32x4 va[16], vb[16];
        int it = gw;
        CvItem ca = cv_decode(a, ws, it < NIT ? it : 0), cb = ca;
        if (it < NIT) cv_load(ca, va, lane);
        for (; it < NIT; it += 2 * NGW) {
            const int it1 = it + NGW, it2 = it + 2 * NGW;
            if (it1 < NIT) { cb = cv_decode(a, ws, it1); cv_load(cb, vb, lane); }
            cv_store(ca, va, lane);
            if (it1 < NIT) {
                if (it2 < NIT) { ca = cv_decode(a, ws, it2); cv_load(ca, va, lane); }
                cv_store(cb, vb, lane);
            }
        }
    }
    __syncthreads();
}

__device__ __forceinline__ void softmax_lds(LAS float* ps, int nk, int lane) {
    float mx = -INFINITY;
    for (int i = lane; i < nk; i += 64) mx = fmaxf(mx, ps[i]);
    mx = wave_max(mx);
    if (mx == -INFINITY) { for (int i = lane; i < nk; i += 64) ps[i] = 0.f; LDS_WAIT(); return; }
    float sum = 0.f;
    for (int i = lane; i < nk; i += 64) { const float e = __expf(ps[i] - mx); ps[i] = e; sum += e; }
    sum = wave_sum(sum);
    const float inv = 1.0f / fmaxf(sum, 1e-30f);
    for (int i = lane; i < nk; i += 64) ps[i] *= inv;
    LDS_WAIT();
}
__device__ __forceinline__ float dot64(const LAS float* q, const bf16* krow) {
    float s = 0.f;
#pragma unroll
    for (int j = 0; j < 8; ++j) { const u32x4 kv = *(const u32x4*)(krow + 8 * j); const f32x4 q0 = *(const LAS f32x4*)(q + 8 * j), q1 = *(const LAS f32x4*)(q + 8 * j + 4);
        s += q0.x * bflo(kv.x) + q0.y * bfhi(kv.x) + q0.z * bflo(kv.y) + q0.w * bfhi(kv.y) + q1.x * bflo(kv.z) + q1.y * bfhi(kv.z) + q1.z * bflo(kv.w) + q1.w * bfhi(kv.w); }
    return s;
}
__device__ __forceinline__ void p5_attn_naive(Frame& F) {
    unsigned char* ws = F.ws;
    const bf16* Z = (const bf16*)(ws + WS_Z);
    const bf16* KC = (const bf16*)(ws + WS_KCMP); const bf16* VC = (const bf16*)(ws + WS_VCMP);
    bf16* CAT = (bf16*)(ws + WS_CAT);
    const int lane = F.lane, gw = F.bid * 8 + F.wave, NGW = F.G * 8;
    LAS float* qs = (LAS float*)(F.lds + F.wave * 5120);
    LAS float* ps = qs + 256;
    for (int it = gw; it < NB * 4 * T; it += NGW) {
        const int t = it & (T - 1), g = (it >> 12) & 3, b = it >> 14, m = b * T + t, cur = t >> 6;
        const size_t zo = (size_t)m * NZ;
#pragma unroll
        for (int r = 0; r < 4; ++r) qs[r * 64 + lane] = bf2f(Z[zo + ZQ + (4 * g + r) * 64 + lane]);
        LDS_WAIT();
        float imp = 0.f, oacc[4];
        const int ncv = t >= 31 ? ((t - 31) >> 4) + 1 : 0;
#pragma unroll
        for (int r = 0; r < 4; ++r) {
            const int h = 4 * g + r; const float slope = exp2f(-0.5f * (float)(h + 1));
#pragma unroll
            for (int ch = 0; ch < 4; ++ch) { const int c = ch * 64 + lane; float s = -INFINITY;
                if (c < ncv) s = dot64(qs + r * 64, KC + ((size_t)(b * 256 + c) * 4 + g) * 64) * 0.125f - slope * (float)(t - (16 * c + 31));
                ps[c] = s; }
            LDS_WAIT();
            softmax_lds(ps, 256, lane);
            float o = 0.f;
            for (int c = 0; c < ncv; ++c) o += ps[c] * bf2f(VC[((size_t)(b * 256 + c) * 4 + g) * 64 + lane]);
            { const int j = lane; float v = 32.0f * (ps[4 * j] + ps[4 * j + 1] + ps[4 * j + 2]);
              if (j > 0) v += 16.0f * ps[4 * j - 1];
              v += 16.0f * ps[4 * j + 3];
              imp += v; }
            oacc[r] = sigmoidf_(bf2f(Z[zo + ZGL + h * 3 + 0])) * o;
            LDS_WAIT();
        }
        float v = imp;
        if (lane == 0 || lane == cur || lane == cur - 1) v = INFINITY; else if (lane > cur) v = -INFINITY;
        int rank = 0;
        for (int jj = 0; jj < 64; ++jj) { const float vv = __shfl(v, jj); rank += (vv > v || (vv == v && jj < lane)) ? 1 : 0; }
        const unsigned long long selmask = __ballot(rank < 16) & (cur >= 63 ? ~0ull : ((1ull << (cur + 1)) - 1ull));
#pragma unroll
        for (int r = 0; r < 4; ++r) {
            const int h = 4 * g + r; const float slope = exp2f(-0.5f * (float)(h + 1));
            int n = 0;
            for (unsigned long long mm = selmask; mm; mm &= mm - 1, ++n) { const int j = __builtin_ctzll(mm); const int pos = 64 * j + lane; float s = -INFINITY;
                if (pos <= t) s = dot64(qs + r * 64, Z + (size_t)(b * T + pos) * NZ + ZKS + g * 64) * 0.125f - slope * (float)(t - pos);
                ps[n * 64 + lane] = s; }
            LDS_WAIT();
            softmax_lds(ps, n * 64, lane);
            float o = 0.f; n = 0;
            for (unsigned long long mm = selmask; mm; mm &= mm - 1, ++n) { const int j = __builtin_ctzll(mm);
                const int lim = (64 * j + 63 <= t) ? 64 : (t - 64 * j + 1);
                const bf16* vb = Z + (size_t)(b * T + 64 * j) * NZ + ZVS + g * 64 + lane;
                for (int i = 0; i < lim; ++i) o += ps[n * 64 + i] * bf2f(vb[(size_t)i * NZ]); }
            oacc[r] += sigmoidf_(bf2f(Z[zo + ZGL + h * 3 + 1])) * o;
            LDS_WAIT();
        }
#pragma unroll
        for (int r = 0; r < 4; ++r) {
            const int h = 4 * g + r; const float slope = exp2f(-0.5f * (float)(h + 1));
#pragma unroll
            for (int ch = 0; ch < 8; ++ch) { const int pos = t - 511 + ch * 64 + lane; float s = -INFINITY;
                if (pos >= 0) s = dot64(qs + r * 64, Z + (size_t)(b * T + pos) * NZ + ZKW + g * 64) * 0.125f - slope * (float)(t - pos);
                ps[ch * 64 + lane] = s; }
            LDS_WAIT();
            softmax_lds(ps, 512, lane);
            float o = 0.f;
            const int i0 = t >= 511 ? 0 : 511 - t;
            const bf16* vb = Z + ZVW + g * 64 + lane;
            for (int i = i0; i < 512; ++i) o += ps[i] * bf2f(vb[(size_t)(b * T + t - 511 + i) * NZ]);
            oacc[r] += sigmoidf_(bf2f(Z[zo + ZGL + h * 3 + 2])) * o;
            CAT[(size_t)m * D + h * 64 + lane] = (bf16)f2bf(oacc[r]);
            LDS_WAIT();
        }
    }
}

namespace nsa {
typedef short bf16x8 __attribute__((ext_vector_type(8)));
typedef float f32x16 __attribute__((ext_vector_type(16)));
typedef __bf16 bf2_t __attribute__((ext_vector_type(2)));
typedef float f2_t __attribute__((ext_vector_type(2)));
__device__ __forceinline__ unsigned pkbf(float a, float b) { f2_t v; v.x = a; v.y = b; return __builtin_bit_cast(unsigned, __builtin_convertvector(v, bf2_t)); }
constexpr int KP = 144, TILE_B = 64 * KP;
constexpr int IMP_LD = 65;
constexpr int L_IMP = 8 * TILE_B;
constexpr int L_INVL = L_IMP + 4 * 64 * IMP_LD * 4;
constexpr int L_SEL = L_INVL + 1024;
constexpr int L_UNI = L_SEL + 512;
constexpr int L_UNIT = L_UNI + 64;
static_assert(L_UNIT + 64 <= LDS_MISC, "attention LDS map");
constexpr float LOG2E = 1.4426950408889634f, SCL = 0.125f * LOG2E, NEGBIG = -1e30f;

struct StageRegs { u32x4 k, v; };
__device__ __forceinline__ void stage_load(StageRegs& r, const bf16* kb, const bf16* vb, size_t pitch, int tid) {
    const int key = tid >> 3, ch = tid & 7;
    r.k = *(const u32x4*)(kb + (size_t)key * pitch + ch * 8);
    r.v = *(const u32x4*)(vb + (size_t)key * pitch + ch * 8);
}
__device__ __forceinline__ void stage_store(const StageRegs& r, LAS unsigned char* lds, int slot, int tid) {
    const int key = tid >> 3, ch = tid & 7;
    *(LAS u32x4*)(lds + slot * TILE_B + key * KP + ch * 16) = r.k;
    const int kl = key & 15, vpos = (key & 48) + (kl & 3) + 4 * (kl >> 3) + 8 * ((kl >> 2) & 1);
    LAS unsigned char* vp = lds + (4 + slot) * TILE_B + (ch * 8) * KP + vpos * 2;
#pragma unroll
    for (int e = 0; e < 8; ++e) { const unsigned w = r.v[e >> 1]; *(LAS unsigned short*)(vp + e * KP) = (unsigned short)((e & 1) ? (w >> 16) : (w & 0xffffu)); }
}
template <int MODE>
__device__ __forceinline__ void tile_core(const LAS unsigned char* Kl, const LAS unsigned char* Vl, const bf16x8 (&qf)[4], const float (&bias)[16], float sl32, f32x16 (&O)[2], float& m, float& l,
                                          float off, bool need_mask, bool use_lo, int lo, int hi, bool lv, int lane, float (&p)[2][16]) {
    const int n = lane & 31, h = lane >> 5;
    f32x16 st[2];
#pragma unroll
    for (int kt = 0; kt < 2; ++kt) {
#pragma unroll
        for (int i = 0; i < 16; ++i) st[kt][i] = 0.f;
#pragma unroll
        for (int s = 0; s < 4; ++s) { const bf16x8 a = *(const LAS bf16x8*)(Kl + (32 * kt + n) * KP + (16 * s + 8 * h) * 2); st[kt] = __builtin_amdgcn_mfma_f32_32x32x16_bf16(a, qf[s], st[kt], 0, 0, 0); }
    }
#pragma unroll
    for (int kt = 0; kt < 2; ++kt)
#pragma unroll
        for (int i = 0; i < 16; ++i) p[kt][i] = fmaf(st[kt][i], SCL, bias[i]);
    if (need_mask) {
#pragma unroll
        for (int kt = 0; kt < 2; ++kt)
#pragma unroll
            for (int i = 0; i < 16; ++i) { const int c = 32 * kt + (i & 3) + 8 * (i >> 2); p[kt][i] = (c <= hi) ? p[kt][i] : -INFINITY; }
        if (use_lo) {
#pragma unroll
            for (int kt = 0; kt < 2; ++kt)
#pragma unroll
                for (int i = 0; i < 16; ++i) { const int c = 32 * kt + (i & 3) + 8 * (i >> 2); p[kt][i] = (c >= lo) ? p[kt][i] : -INFINITY; }
        }
    }
    float mrel;
    if constexpr (MODE != 1) {
        float tm0 = p[0][0], tm1 = p[1][0];
#pragma unroll
        for (int i = 1; i < 16; ++i) { tm0 = fmaxf(tm0, p[0][i]); tm1 = fmaxf(tm1, p[1][i]); }
        float tm = fmaxf(tm0, tm1 + sl32);
        tm = lv ? tm : -INFINITY;
        { const auto sw_ = __builtin_amdgcn_permlane32_swap(__float_as_uint(tm), __float_as_uint(tm), false, false); tm = fmaxf(__uint_as_float(sw_[0]), __uint_as_float(sw_[1])); }
        const float mn = fmaxf(m, tm + off);
        if constexpr (MODE == 0) { m = mn; return; }
        const float alpha = __builtin_amdgcn_exp2f(m - mn);
        m = mn; l *= alpha; O[0] = O[0] * alpha; O[1] = O[1] * alpha;
        mrel = lv ? mn - off : INFINITY;
    } else mrel = m - off;
    float ps = 0.f;
#pragma unroll
    for (int kt = 0; kt < 2; ++kt)
#pragma unroll
        for (int i = 0; i < 16; ++i) { p[kt][i] = __builtin_amdgcn_exp2f(p[kt][i] - (kt ? mrel - sl32 : mrel)); ps += p[kt][i]; }
    l += ps;
#pragma unroll
    for (int g16 = 0; g16 < 4; ++g16) {
        const int kt = g16 >> 1, s8 = (g16 & 1) * 8;
        u32x4 pw; pw.x = pkbf(p[kt][s8 + 0], p[kt][s8 + 1]); pw.y = pkbf(p[kt][s8 + 2], p[kt][s8 + 3]); pw.z = pkbf(p[kt][s8 + 4], p[kt][s8 + 5]); pw.w = pkbf(p[kt][s8 + 6], p[kt][s8 + 7]);
        const bf16x8 pb = __builtin_bit_cast(bf16x8, pw);
#pragma unroll
        for (int dt = 0; dt < 2; ++dt) { const bf16x8 a = *(const LAS bf16x8*)(Vl + (32 * dt + n) * KP + (16 * g16 + 8 * h) * 2); O[dt] = __builtin_amdgcn_mfma_f32_32x32x16_bf16(a, pb, O[dt], 0, 0, 0); }
    }
}
__device__ __forceinline__ void set_bias(float (&bias)[16], float sl, int h) {
#pragma unroll
    for (int i = 0; i < 16; ++i) bias[i] = sl * (float)((i & 3) + 8 * (i >> 2) + 4 * h);
}

__device__ __forceinline__ void attn_phase(Frame& F, int rep) {
    unsigned char* ws = F.ws;
    const bf16* Z = (const bf16*)(ws + WS_Z);
    const bf16* KC = (const bf16*)(ws + WS_KCMP); const bf16* VC = (const bf16*)(ws + WS_VCMP);
    bf16* CAT = (bf16*)(ws + WS_CAT);
    LAS unsigned char* lds = F.lds;
    LAS float* imph = (LAS float*)(lds + L_IMP); LAS float* invl = (LAS float*)(lds + L_INVL);
    LAS unsigned long long* selm = (LAS unsigned long long*)(lds + L_SEL); LAS unsigned long long* unis = (LAS unsigned long long*)(lds + L_UNI);
    unsigned* ctr = (unsigned*)(ws + WS_CTL) + CW_ATTNQ + 64 * rep;
    const int tid = F.tid, lane = F.lane, wave = F.wave, n = lane & 31, h = lane >> 5, r = wave >> 1, th = wave & 1, tq = 32 * th + n;
    for (;;) {
        __syncthreads();
        if (tid == 0) *(LAS int*)(lds + L_UNIT) = (int)atomicAdd(ctr, 1u);
        __syncthreads();
        const int u = *(LAS int*)(lds + L_UNIT);
        if (u >= NB * 4 * 64) break;
        const int qt = 63 - (u >> 4), b = (u >> 2) & 3, g = u & 3, t0 = 64 * qt, head = 4 * g + r, t = t0 + tq;
        const size_t zrow = (size_t)(b * T + t) * NZ;
        bf16x8 qf[4];
#pragma unroll
        for (int s = 0; s < 4; ++s) qf[s] = *(const bf16x8*)(Z + zrow + ZQ + head * 64 + 16 * s + 8 * h);
        const float slope2 = exp2f(-0.5f * (float)(head + 1)) * LOG2E;
        const float g0 = sigmoidf_(bf2f(Z[zrow + ZGL + head * 3 + 0])), g1 = sigmoidf_(bf2f(Z[zrow + ZGL + head * 3 + 1])), g2 = sigmoidf_(bf2f(Z[zrow + ZGL + head * 3 + 2]));
        const int ncmax = (4 * qt + 3) < NCMP ? (4 * qt + 3) : NCMP, ntc = (ncmax + 63) >> 6;
        for (int tau = 0; tau < ntc; ++tau) { StageRegs sr; const size_t ro = ((size_t)(b * 256 + 64 * tau) * 4 + g) * 64; stage_load(sr, KC + ro, VC + ro, 256, tid); stage_store(sr, lds, tau, tid); }
        __syncthreads();
        float bias[16], p[2][16];
        f32x16 O[2];
        set_bias(bias, slope2 * 16.0f, h);
        float sl32 = slope2 * 512.0f;
        const int ncv = t >= 31 ? ((t - 31) >> 4) + 1 : 0;
        float m = NEGBIG, l = 0.f;
#pragma unroll
        for (int i = 0; i < 16; ++i) { O[0][i] = 0.f; O[1][i] = 0.f; }
        for (int tau = 0; tau < ntc; ++tau)
            tile_core<0>(lds + tau * TILE_B, lds + (4 + tau) * TILE_B, qf, bias, sl32, O, m, l, slope2 * (float)(1024 * tau + 31 - t), true, false, 0, ncv - 1 - 64 * tau - 4 * h, true, lane, p);
        float carry = 0.f;
        for (int tau = 0; tau < ntc; ++tau) {
            tile_core<1>(lds + tau * TILE_B, lds + (4 + tau) * TILE_B, qf, bias, sl32, O, m, l, slope2 * (float)(1024 * tau + 31 - t), true, false, 0, ncv - 1 - 64 * tau - 4 * h, true, lane, p);
            float recv[8];
#pragma unroll
            for (int f = 0; f < 8; ++f) recv[f] = __shfl_xor(16.0f * p[f >> 2][4 * (f & 3) + 3], 32);
#pragma unroll
            for (int f = 0; f < 8; ++f) { const int kt = f >> 2, q4 = f & 3;
                const float gsum = 32.0f * (p[kt][4 * q4] + p[kt][4 * q4 + 1] + p[kt][4 * q4 + 2]) + 16.0f * p[kt][4 * q4 + 3];
                const float prev0 = (f == 0) ? carry : recv[f == 0 ? 0 : f - 1];
                const float prev = h ? recv[f] : prev0;
                imph[(r * 64 + tq) * IMP_LD + 16 * tau + 8 * kt + 2 * q4 + h] = gsum + prev; }
            carry = recv[7];
        }
        { const float lt = l + __shfl_xor(l, 32); const float inv = 1.0f / fmaxf(lt, 1e-30f); if (h == 0) invl[r * 64 + tq] = inv; O[0] = O[0] * (inv * g0); O[1] = O[1] * (inv * g0); }
        __syncthreads();
        { unsigned long long uw = 0ull; const unsigned long long vmask = qt >= 63 ? ~0ull : ((1ull << (qt + 1)) - 1ull);
          for (int qq = 0; qq < 8; ++qq) { const int q = 8 * wave + qq;
              float v = 0.f;
#pragma unroll
              for (int rr = 0; rr < 4; ++rr) v += imph[(rr * 64 + q) * IMP_LD + lane] * invl[rr * 64 + q];
              if (lane == 0 || lane == qt || lane == qt - 1) v = INFINITY; else if (lane > qt) v = -INFINITY;
              int rank = 0;
#pragma unroll
              for (int jj = 0; jj < 64; ++jj) { const float vv = __shfl(v, jj); rank += (vv > v || (vv == v && jj < lane)) ? 1 : 0; }
              const unsigned long long mk = __ballot(rank < 16) & vmask;
              if (lane == 0) selm[q] = mk;
              uw |= mk; }
          if (lane == 0) unis[wave] = uw; }
        __syncthreads();
        unsigned long long uni = 0ull;
#pragma unroll
        for (int w8 = 0; w8 < 8; ++w8) uni |= unis[w8];
        uni = __builtin_amdgcn_readfirstlane((unsigned)uni) | ((unsigned long long)__builtin_amdgcn_readfirstlane((unsigned)(uni >> 32)) << 32);
        const unsigned long long selq = selm[tq];
        LAS float* oacc = (LAS float*)(lds + L_IMP) + wave * 2048 + lane;
#pragma unroll
        for (int i = 0; i < 16; ++i) { oacc[i * 64] = O[0][i]; oacc[(16 + i) * 64] = O[1][i]; }
        set_bias(bias, slope2, h); sl32 = slope2 * 32.0f;
        m = NEGBIG; l = 0.f;
#pragma unroll
        for (int i = 0; i < 16; ++i) { O[0][i] = 0.f; O[1][i] = 0.f; }
        {
            unsigned long long mm = uni; int j = __builtin_ctzll(mm); mm &= mm - 1; int cb = 0;
            { StageRegs sr; const bf16* kb = Z + (size_t)(b * T + 64 * j) * NZ + g * 64; stage_load(sr, kb + ZKS, kb + ZVS, NZ, tid); stage_store(sr, lds, 0, tid); }
            __syncthreads();
            for (;;) {
                const bool more = mm != 0ull; int jn = 0; StageRegs sr;
                if (more) { jn = __builtin_ctzll(mm); mm &= mm - 1; const bf16* kb = Z + (size_t)(b * T + 64 * jn) * NZ + g * 64; stage_load(sr, kb + ZKS, kb + ZVS, NZ, tid); }
                const bool lv = (selq >> j) & 1ull; const bool diag = (j == qt);
                tile_core<2>(lds + cb * TILE_B, lds + (4 + cb) * TILE_B, qf, bias, sl32, O, m, l, slope2 * (float)(64 * j - t), diag, false, 0, tq - 4 * h, lv, lane, p);
                if (more) stage_store(sr, lds, cb ^ 1, tid);
                __syncthreads();
                if (!more) break;
                j = jn; cb ^= 1;
            }
        }
        { const float lt = l + __shfl_xor(l, 32); const float inv = 1.0f / fmaxf(lt, 1e-30f) * g1;
#pragma unroll
          for (int i = 0; i < 16; ++i) { oacc[i * 64] += O[0][i] * inv; oacc[(16 + i) * 64] += O[1][i] * inv; } }
        m = NEGBIG; l = 0.f;
#pragma unroll
        for (int i = 0; i < 16; ++i) { O[0][i] = 0.f; O[1][i] = 0.f; }
        {
            int j = qt >= 8 ? qt - 8 : 0; int cb = 0;
            { StageRegs sr; const bf16* kb = Z + (size_t)(b * T + 64 * j) * NZ + g * 64; stage_load(sr, kb + ZKW, kb + ZVW, NZ, tid); stage_store(sr, lds, 0, tid); }
            __syncthreads();
            for (;;) {
                const bool more = j < qt; StageRegs sr;
                if (more) { const bf16* kb = Z + (size_t)(b * T + 64 * (j + 1)) * NZ + g * 64; stage_load(sr, kb + ZKW, kb + ZVW, NZ, tid); }
                const bool left = (j == qt - 8), diag = (j == qt);
                const int lo = (left ? tq + 1 : -1000) - 4 * h, hi = (diag ? tq : 1000) - 4 * h;
                tile_core<2>(lds + cb * TILE_B, lds + (4 + cb) * TILE_B, qf, bias, sl32, O, m, l, slope2 * (float)(64 * j - t), left || diag, left, lo, hi, true, lane, p);
                if (more) stage_store(sr, lds, cb ^ 1, tid);
                __syncthreads();
                if (!more) break;
                ++j; cb ^= 1;
            }
        }
        { const float lt = l + __shfl_xor(l, 32); const float inv = 1.0f / fmaxf(lt, 1e-30f) * g2;
#pragma unroll
          for (int i = 0; i < 16; ++i) { O[0][i] = oacc[i * 64] + O[0][i] * inv; O[1][i] = oacc[(16 + i) * 64] + O[1][i] * inv; } }
        bf16* orow = CAT + (size_t)(b * T + t) * D + head * 64;
#pragma unroll
        for (int dt = 0; dt < 2; ++dt)
#pragma unroll
            for (int q4 = 0; q4 < 4; ++q4) { u32x2 w; w.x = pkbf(O[dt][4 * q4], O[dt][4 * q4 + 1]); w.y = pkbf(O[dt][4 * q4 + 2], O[dt][4 * q4 + 3]); *(u32x2*)(orow + 32 * dt + 8 * q4 + 4 * h) = w; }
    }
    __syncthreads();
}
}

__device__ __forceinline__ void p6_rwkv_out(Frame& F, const Args& a) {
    unsigned char* ws = F.ws;
    const float* Y = (const float*)(ws + WS_Y); const float* SC = (const float*)(ws + WS_SC); const float* G = (const float*)(ws + WS_G);
    const float* rk = a.in[I_RK]; const float* lng = a.in[I_LNG]; const float* lnb = a.in[I_LNB];
    bf16* CAT = (bf16*)(ws + WS_CAT);
    const int lane = F.lane, gw = F.bid * 8 + F.wave, NGW = F.G * 8;
    for (int it = gw; it < M * 2; it += NGW) {
        const int m = it >> 1, half = it & 1, t = m & (T - 1), b = m >> 12, col = (half * 64 + lane) * 8, h = col >> 6, j8 = col & 63;
        float y[8], bv[8], gg[8], lg8[8], lb8[8];
        ld8f(Y + (size_t)m * 1024 + col, y);
        unpack8(*(const u32x4*)((const bf16*)(ws + WS_ACK) + (size_t)m * 1024 + col), bv); unpack8(*(const u32x4*)((const bf16*)(ws + WS_G) + (size_t)m * 1024 + col), gg);
        ld8f(lng + col, lg8); ld8f(lnb + col, lb8);
        float s1 = 0.f;
#pragma unroll
        for (int e = 0; e < 8; ++e) s1 += y[e];
        const float mean = dpp_sum8(s1) * (1.0f / 64.0f);
        float s2 = 0.f;
#pragma unroll
        for (int e = 0; e < 8; ++e) { y[e] -= mean; s2 += y[e] * y[e]; }
        const float rstd = rsqrtf(dpp_sum8(s2) * (1.0f / 64.0f) + GN_EPS);
        float o[8];
#pragma unroll
        for (int e = 0; e < 8; ++e) o[e] = (y[e] * rstd * lg8[e] + lb8[e] + bv[e]) * gg[e];
        *(u32x4*)(CAT + (size_t)m * D + 1024 + col) = pack8(o);
    }
}

__device__ __forceinline__ void p8_ln_router(Frame& F, const Args& a) {
    typedef short bf16x8_t __attribute__((ext_vector_type(8)));
    unsigned char* ws = F.ws;
    const float* PRE = F.out; float* H1 = (float*)(ws + WS_H1); unsigned char* H1Q = (unsigned char*)(ws + WS_H1B);
    const float* g1 = a.in[I_LN1G]; const float* b1 = a.in[I_LN1B]; const float* rb = a.in[I_RB];
    const bf16* RWT = (const bf16*)(ws + WS_RWT);
    int* TOPE = (int*)(ws + WS_TOPE); float* TOPW = (float*)(ws + WS_TOPW); int* SLOT = (int*)(ws + WS_SLOT); int* HIST = (int*)(ws + WS_HIST);
    const int lane = F.lane, wave = F.wave, tid = F.tid;
    LAS float* part = (LAS float*)F.lds;
    LAS int* es = (LAS int*)(F.lds + 2 * 64 * 33 * 4);
    for (int ch = F.bid; ch < M / 64; ch += F.G) {
        {
            const int tb = 16 * (wave & 3), kh = wave >> 2, row = lane & 15, g = lane >> 4;
            const int m = ch * 64 + tb + row;
            const float* xp = PRE + (size_t)m * D + kh * 1024 + 8 * g;
            float s1 = 0.f, s2 = 0.f;
#pragma unroll 8
            for (int ks = 0; ks < 32; ++ks) { float x[8]; ld8f(xp + 32 * ks, x);
#pragma unroll
                for (int e = 0; e < 8; ++e) { s1 += x[e]; s2 += x[e] * x[e]; } }
            { auto q = __builtin_amdgcn_permlane16_swap(__float_as_uint(s1), __float_as_uint(s1), false, false); s1 = __uint_as_float(q[0]) + __uint_as_float(q[1]);
              q = __builtin_amdgcn_permlane32_swap(__float_as_uint(s1), __float_as_uint(s1), false, false); s1 = __uint_as_float(q[0]) + __uint_as_float(q[1]);
              q = __builtin_amdgcn_permlane16_swap(__float_as_uint(s2), __float_as_uint(s2), false, false); s2 = __uint_as_float(q[0]) + __uint_as_float(q[1]);
              q = __builtin_amdgcn_permlane32_swap(__float_as_uint(s2), __float_as_uint(s2), false, false); s2 = __uint_as_float(q[0]) + __uint_as_float(q[1]); }
            LAS float* st = (LAS float*)(F.lds + 2 * 64 * 33 * 4 + 1024);
            if (g == 0) { st[(kh * 64 + tb + row) * 2] = s1; st[(kh * 64 + tb + row) * 2 + 1] = s2; }
            __syncthreads();
            const float t1 = st[(tb + row) * 2] + st[(64 + tb + row) * 2], t2 = st[(tb + row) * 2 + 1] + st[(64 + tb + row) * 2 + 1];
            const float mean = t1 * (1.0f / D), rstd = rsqrtf(fmaxf(t2 * (1.0f / D) - mean * mean, 0.f) + LN_EPS);
            f32x4 acc0 = (f32x4){0.f, 0.f, 0.f, 0.f}, acc1 = acc0;
            const bf16* w0 = RWT + (size_t)row * D + kh * 1024 + 8 * g;
            bf16* hp = (bf16*)H1 + (size_t)m * D + kh * 1024 + 8 * g; unsigned char* qp = H1Q + (size_t)m * D + kh * 1024 + 8 * g;
            const float* gp = g1 + kh * 1024 + 8 * g; const float* bp = b1 + kh * 1024 + 8 * g;
#pragma unroll 4
            for (int ks = 0; ks < 32; ++ks) {
                float x[8], g8[8], b8[8]; ld8f(xp + 32 * ks, x); ld8f(gp + 32 * ks, g8); ld8f(bp + 32 * ks, b8);
#pragma unroll
                for (int e = 0; e < 8; ++e) x[e] = (x[e] - mean) * rstd * g8[e] + b8[e];
                *(u32x4*)(hp + 32 * ks) = pack8(x);
                { u32x2 q; q.x = pk_fp8x4(x[0] * FP8_SA1, x[1] * FP8_SA1, x[2] * FP8_SA1, x[3] * FP8_SA1); q.y = pk_fp8x4(x[4] * FP8_SA1, x[5] * FP8_SA1, x[6] * FP8_SA1, x[7] * FP8_SA1); *(u32x2*)(qp + 32 * ks) = q; }
                float hi[8], lo[8];
#pragma unroll
                for (int e = 0; e < 8; ++e) { hi[e] = bf2f(f2bf(x[e])); lo[e] = x[e] - hi[e]; }
                const bf16x8_t ah = __builtin_bit_cast(bf16x8_t, pack8(hi)), al = __builtin_bit_cast(bf16x8_t, pack8(lo));
                const bf16x8_t b0h = *(const bf16x8_t*)(w0 + 32 * ks), b1h = *(const bf16x8_t*)(w0 + 16 * D + 32 * ks);
                const bf16x8_t b0l = *(const bf16x8_t*)(w0 + 32 * D + 32 * ks), b1l = *(const bf16x8_t*)(w0 + 48 * D + 32 * ks);
                acc0 = __builtin_amdgcn_mfma_f32_16x16x32_bf16(ah, b0h, acc0, 0, 0, 0); acc1 = __builtin_amdgcn_mfma_f32_16x16x32_bf16(ah, b1h, acc1, 0, 0, 0);
                acc0 = __builtin_amdgcn_mfma_f32_16x16x32_bf16(ah, b0l, acc0, 0, 0, 0); acc1 = __builtin_amdgcn_mfma_f32_16x16x32_bf16(ah, b1l, acc1, 0, 0, 0);
                acc0 = __builtin_amdgcn_mfma_f32_16x16x32_bf16(al, b0h, acc0, 0, 0, 0); acc1 = __builtin_amdgcn_mfma_f32_16x16x32_bf16(al, b1h, acc1, 0, 0, 0);
            }
#pragma unroll
            for (int q = 0; q < 4; ++q) { part[(kh * 64 + tb + 4 * g + q) * 33 + row] = acc0[q]; part[(kh * 64 + tb + 4 * g + q) * 33 + 16 + row] = acc1[q]; }
        }
        __syncthreads();
        for (int i = 0; i < 8; ++i) {
            const int tl_ = wave * 8 + i, m = ch * 64 + tl_;
            float lg = -INFINITY;
            if (lane < 32) lg = part[tl_ * 33 + lane] + part[(64 + tl_) * 33 + lane] + rb[lane];
            float tl[4]; int te[4];
#pragma unroll
            for (int k = 0; k < 4; ++k) { const float mx = wave_max(lg); const unsigned long long bm = __ballot(lg == mx); const int idx = __builtin_ctzll(bm); tl[k] = mx; te[k] = idx; if (lane == idx) lg = -INFINITY; }
            const float e1 = __expf(tl[1] - tl[0]), e2 = __expf(tl[2] - tl[0]), e3 = __expf(tl[3] - tl[0]); const float inv = 1.0f / (1.0f + e1 + e2 + e3);
            if (lane == 0) { *(int4*)(TOPE + (size_t)m * 4) = make_int4(te[0], te[1], te[2], te[3]); *(f32x4*)(TOPW + (size_t)m * 4) = (f32x4){inv, e1 * inv, e2 * inv, e3 * inv};
                es[tl_ * 4 + 0] = te[0]; es[tl_ * 4 + 1] = te[1]; es[tl_ * 4 + 2] = te[2]; es[tl_ * 4 + 3] = te[3]; }
        }
        __syncthreads();
        if (tid < 256) { const int e = es[tid]; int slot = 0; for (int q = 0; q < tid; ++q) slot += (es[q] == e) ? 1 : 0; SLOT[(size_t)ch * 256 + tid] = slot; }
        if (tid >= 256 && tid < 288) { const int e = tid - 256; int cnt = 0; for (int q = 0; q < 256; ++q) cnt += (es[q] == e) ? 1 : 0; HIST[ch * 32 + e] = cnt; }
        __syncthreads();
    }
}

__device__ __forceinline__ void p9_offsets(Frame& F) {
    unsigned char* ws = F.ws;
    const int* HIST = (const int*)(ws + WS_HIST); const int* TOPE = (const int*)(ws + WS_TOPE); const int* SLOT = (const int*)(ws + WS_SLOT);
    int* TOKROW = (int*)(ws + WS_TOKROW); int* ROWTOK = (int*)(ws + WS_ROWTOK); int* BLKE = (int*)(ws + WS_BLKE);
    LAS int* part = (LAS int*)F.lds;
    LAS int* tot = part + 512;
    LAS int* pre = tot + 32;
    LAS int* startp = pre + 32;
    LAS int* dsts = startp + 64;
    const int tid = F.tid, e = tid & 31, pg = tid >> 5;
    for (int ch = F.bid; ch < M / 64; ch += F.G) {
        __syncthreads();
        { int s = 0; for (int c = pg * 16; c < pg * 16 + 16; ++c) s += HIST[c * 32 + e]; part[pg * 32 + e] = s; }
        __syncthreads();
        if (tid < 32) { int s = 0; for (int q = 0; q < 16; ++q) s += part[q * 32 + tid]; tot[tid] = s; }
        __syncthreads();
        { int s = 0; for (int c = pg * 16; c < pg * 16 + 16; ++c) if (c < ch) s += HIST[c * 32 + e]; part[pg * 32 + e] = s; }
        __syncthreads();
        if (tid < 32) { int s = 0; for (int q = 0; q < 16; ++q) s += part[q * 32 + tid]; pre[tid] = s; }
        if (tid == 32) { int s = 0; for (int q = 0; q < 32; ++q) { startp[q] = s; s += (tot[q] + 255) / 256 * 256; } startp[32] = s; }
        __syncthreads();
        if (tid < 256) { const int m = ch * 64 + (tid >> 2); const int ee = TOPE[(size_t)m * 4 + (tid & 3)]; const int dest = startp[ee] + pre[ee] + SLOT[(size_t)ch * 256 + tid];
            ROWTOK[dest] = m; TOKROW[(size_t)m * 4 + (tid & 3)] = dest; dsts[tid] = dest; }
        __syncthreads();
        { const unsigned char* H1Q = (const unsigned char*)(ws + WS_H1B); unsigned char* XG = (unsigned char*)(ws + WS_XG);
          for (int a = F.wave; a < 256; a += 8) { const int m = ch * 64 + (a >> 2); const int dest = dsts[a];
              const u32x4 v0 = *(const u32x4*)(H1Q + (size_t)m * D + F.lane * 32), v1 = *(const u32x4*)(H1Q + (size_t)m * D + F.lane * 32 + 16);
              *(u32x4*)(XG + (size_t)dest * D + F.lane * 32) = v0; *(u32x4*)(XG + (size_t)dest * D + F.lane * 32 + 16) = v1; } }
        if (ch == 0) {
            const int nblk = startp[32] >> 8;
            if (tid < MAXBLK) { int be = -1; if (tid < nblk) { for (int q = 0; q < 32; ++q) if (startp[q] <= tid * 256 && tid * 256 < startp[q + 1]) be = q; } BLKE[tid] = be < 0 ? 0 : be; }
            if (tid == 0) BLKE[MAXBLK] = nblk;
        }
    }
    __syncthreads();
}

__device__ __forceinline__ void p12_combine_ln2(Frame& F, const Args& a) {
    unsigned char* ws = F.ws;
    const float* H1 = (const float*)(ws + WS_H1); const bf16* EO = (const bf16*)(ws + WS_EO); const int* TOKROW = (const int*)(ws + WS_TOKROW); const float* TOPW = (const float*)(ws + WS_TOPW);
    float* H2 = F.out; bf16* H2B = (bf16*)(ws + WS_H2B);
    const float* g2 = a.in[I_LN2G]; const float* b2 = a.in[I_LN2B];
    const int lane = F.lane, gw = F.bid * 8 + F.wave, NGW = F.G * 8;
    for (int m = gw; m < M; m += NGW) {
        const int4 rows = *(const int4*)(TOKROW + (size_t)m * 4); const f32x4 tw = *(const f32x4*)(TOPW + (size_t)m * 4);
        const int rr[4] = {rows.x, rows.y, rows.z, rows.w};
        float v[4][8]; float s = 0.f;
#pragma unroll
        for (int j = 0; j < 4; ++j) {
            const int c0 = 512 * j + 8 * lane;
            float h8[8]; unpack8(*(const u32x4*)((const bf16*)H1 + (size_t)m * D + c0), h8);
#pragma unroll
            for (int e = 0; e < 8; ++e) v[j][e] = ALPHA * h8[e];
#pragma unroll
            for (int k = 0; k < 4; ++k) { float e8[8]; unpack8(*(const u32x4*)(EO + (size_t)rr[k] * D + c0), e8); const float wk = tw[k];
#pragma unroll
                for (int e = 0; e < 8; ++e) v[j][e] += wk * e8[e]; }
#pragma unroll
            for (int e = 0; e < 8; ++e) s += v[j][e];
        }
        const float mean = wave_sum(s) * (1.0f / D); float s2 = 0.f;
#pragma unroll
        for (int j = 0; j < 4; ++j)
#pragma unroll
            for (int e = 0; e < 8; ++e) { v[j][e] -= mean; s2 += v[j][e] * v[j][e]; }
        const float rstd = rsqrtf(wave_sum(s2) * (1.0f / D) + LN_EPS);
#pragma unroll
        for (int j = 0; j < 4; ++j) { const int c0 = 512 * j + 8 * lane; float g8[8], b8[8], o[8]; ld8f(g2 + c0, g8); ld8f(b2 + c0, b8);
#pragma unroll
            for (int e = 0; e < 8; ++e) o[e] = v[j][e] * rstd * g8[e] + b8[e];
            *(u32x4*)(H2B + (size_t)m * D + c0) = pack8(o); }
    }
}

__global__ void __launch_bounds__(512, 2) hymba_fwd(Args args) {
    extern __shared__ __attribute__((aligned(16))) unsigned char lds_raw[];
    Frame F;
    F.lds = (LAS unsigned char*)lds_raw; F.ws = args.ws; F.out = args.out;
    F.tid = threadIdx.x; F.lane = F.tid & 63; F.wave = __builtin_amdgcn_readfirstlane(F.tid >> 6); F.bid = blockIdx.x; F.G = gridDim.x;
    unsigned char* ws = args.ws;
    volatile LAS unsigned* MISC = (volatile LAS unsigned*)(F.lds + LDS_MISC);
    if (F.tid < 32) MISC[F.tid] = 0u;
    __syncthreads();
    XcdBarrier bar; bar.bar = (unsigned*)(ws + WS_CTL) + CW_BAR; bar.x = 0; bar.st = nullptr;
    const int lo = args.ph_lo, hi = args.ph_hi;
    const bool one_launch = (hi - lo) > 1;
    if (one_launch) bar = xcd_barrier_post((unsigned*)(ws + WS_CTL) + CW_BAR, MISC + 8);
#ifdef ONLYPH
#define IN(k) ((k) == ONLYPH && lo <= (k) && (k) < hi)
#else
#define IN(k) (lo <= (k) && (k) < hi)
#endif
#ifndef PROF_IDX
#define PROF_IDX -1
#endif
#ifndef PROF_SCALE
#define PROF_SCALE 4
#endif
    unsigned long long* prof = (unsigned long long*)(ws + WS_CTL + 512 * 1024);
#define STAMP(i) do { if (PROF_IDX >= 0 && F.bid == 0 && F.tid == 0) { __builtin_amdgcn_s_waitcnt(0); prof[(i)] = __builtin_amdgcn_s_memrealtime(); } } while (0)
#define SEAM(k) do { if (IN(k) && IN((k) + 1)) { xcd_barrier(bar); STAMP((k) + 1); } } while (0)
    STAMP(0);
#ifndef PROBE_MASK
#define PROBE_MASK 0ull
#endif
#ifndef PROBE_MODE
#define PROBE_MODE 3
#endif
#define REPS(k) for (int rp_ = 0; rp_ < ((((PROBE_MASK) >> (k)) & 1ull) ? 2 : 1); ++rp_)

    if (IN(0)) REPS(0) { p0_prologue(F, args); } SEAM(0);
    if (IN(1)) REPS(1) { GemmDesc g{(const bf16*)(ws + WS_XB), D, nullptr, (const bf16*)(ws + WS_WIN), D, M, NZ, D, nullptr, 0, nullptr, 127, 127, 0}; EpiZ E{(bf16*)(ws + WS_Z)}; gemm_run<false>(F, g, E); } SEAM(1);
    if (IN(2)) REPS(2) { p2_prep(F, args); } SEAM(2);
    if (IN(3)) {
        static_assert(WS_AL == WS_WL + (size_t)M * 256 * 2 && WS_GLS == WS_AL + (size_t)M * 256 * 2 && WS_AUP == WS_WUP + 1024 * 256 * 2 && WS_GUP == WS_AUP + 1024 * 256 * 2, "the three LoRA operand sets are stacked");
        GemmDesc gl{(const bf16*)(ws + WS_WL), 256, nullptr, (const bf16*)(ws + WS_WUP), 256, 3 * M, 1024, 256, (const int*)(ws + WS_BLKE + 4096), (size_t)1024 * 256, nullptr, 127, 127, 0};
        EpiLora El{(float*)(ws + WS_DEC), (float*)(ws + WS_ASIG), (bf16*)(ws + WS_G), args.in[I_W0], args.in[I_A0]};
        const bool split = F.G >= 128;
        if (split && F.bid < 64) {
            const int grp = F.bid >> 4, kv = grp >> 1, kh = grp & 1;
            GemmDesc gc{(const bf16*)(ws + (kv ? WS_ACV : WS_ACK)) + kh * 1024, D, nullptr, (const bf16*)(ws + (kv ? WS_CW1V : WS_CW1K)) + kh * 1024, D, 4096, 256, D, nullptr, 0, nullptr, 127, 127, 1024};
            EpiCmpPart Ec{(float*)(ws + (kv ? WS_HCMPV : WS_HCMPK)) + (size_t)kh * 4096 * 64};
            gemm_run_part(F, gc, Ec, 16, F.bid & 15);
        } else {
            const int Gp = split ? F.G - 64 : F.G, cp = split ? F.bid - 64 : F.bid;
            if (!split) { for (int q = 0; q < 4; ++q) { const int kv = q >> 1, kh = q & 1;
                GemmDesc gc{(const bf16*)(ws + (kv ? WS_ACV : WS_ACK)) + kh * 1024, D, nullptr, (const bf16*)(ws + (kv ? WS_CW1V : WS_CW1K)) + kh * 1024, D, 4096, 256, D, nullptr, 0, nullptr, 127, 127, 1024};
                EpiCmpPart Ec{(float*)(ws + (kv ? WS_HCMPV : WS_HCMPK)) + (size_t)kh * 4096 * 64}; gemm_run_part(F, gc, Ec, Gp, cp); } }
            gemm_run_part(F, gl, El, Gp, cp); }
    } SEAM(3);
    if (IN(4)) REPS(4) { p4_prep(F, args); } SEAM(4);
    #ifndef NAIVE_ATTN
#define NAIVE_ATTN 0
#endif
    if (IN(5)) { REPS(50) p5_scan_conv(F, args, rp_ == 0 ? 3 : PROBE_MODE);
#if PROF_IDX == 15
        if (one_launch) { xcd_barrier(bar); STAMP(16); if (F.bid == 0 && F.tid == 0) { __builtin_amdgcn_s_waitcnt(0); prof[15] = prof[5]; } }
#endif
#if NAIVE_ATTN
        p5_attn_naive(F);
#else
        REPS(51) nsa::attn_phase(F, rp_);
#endif
    } SEAM(5);
    if (IN(6)) REPS(6) { p6_rwkv_out(F, args); } SEAM(6);
    if (IN(7)) REPS(7) { GemmDesc g{(const bf16*)(ws + WS_CAT), D, nullptr, (const bf16*)(ws + WS_WOUT), D, M, D, D, nullptr, 0, nullptr, 127, 127, 0}; EpiPre1 E{F.out, args.in[I_X]}; gemm_run<false>(F, g, E); } SEAM(7);
    if (IN(8)) REPS(8) { p8_ln_router(F, args); } SEAM(8);
    if (IN(9)) REPS(9) { p9_offsets(F); } SEAM(9);
    if (IN(10)) REPS(10) { GemmDesc g{(const bf16*)(ws + WS_XG), D, nullptr, (const bf16*)(ws + WS_WGU), D, MAXROWS, 4096, D, (const int*)(ws + WS_BLKE), (size_t)4096 * D, (const int*)(ws + WS_BLKE) + MAXBLK, FP8_EA1, FP8_EW, 0};
        EpiSwiglu E{(unsigned char*)(ws + WS_HACT), args.in[I_EBG], args.in[I_EBU]}; gemm_run<true, EpiSwiglu, true>(F, g, E); } SEAM(10);
    if (IN(11)) REPS(11) {
        { GemmDesc g{(const bf16*)(ws + WS_HACT), D, nullptr, (const bf16*)(ws + WS_WDN), D, MAXROWS, D, D, (const int*)(ws + WS_BLKE), (size_t)D * D, (const int*)(ws + WS_BLKE) + MAXBLK, FP8_EA2, FP8_EW, 0};
          EpiDown E{(bf16*)(ws + WS_EO), args.in[I_EBD]}; gemm_run<false, EpiDown, true>(F, g, E); }
        { GemmDesc g{(const bf16*)(ws + WS_PB), 256, nullptr, (const bf16*)(ws + WS_WPL), 256, M, D, 256, nullptr, 0, nullptr, 127, 127, 0}; EpiBf16 E{(bf16*)(ws + WS_PL), D}; gemm_run<false>(F, g, E); }
    } SEAM(11);
    if (IN(12)) REPS(12) { p12_combine_ln2(F, args); } SEAM(12);
    if (IN(13)) { GemmDesc g{(const bf16*)(ws + WS_H2B), D, nullptr, (const bf16*)(ws + WS_WPG), D, M, D, D, nullptr, 0, nullptr, 127, 127, 0}; EpiFinal E{F.out, (const bf16*)(ws + WS_PL), (const bf16*)(ws + WS_H2B)}; gemm_run<false>(F, g, E); }
    if (PROF_IDX >= 0 && one_launch) {
        xcd_barrier(bar); STAMP(14);
        if (F.bid == 0 && F.tid == 0) { asm volatile("s_waitcnt vmcnt(0)" ::: "memory");
            const unsigned long long d = (__hip_atomic_load(prof + PROF_IDX + 1, __ATOMIC_RELAXED, __HIP_MEMORY_SCOPE_AGENT) - __hip_atomic_load(prof + PROF_IDX, __ATOMIC_RELAXED, __HIP_MEMORY_SCOPE_AGENT)) * PROF_SCALE;
            const unsigned long long t0 = __builtin_amdgcn_s_memrealtime(); while (__builtin_amdgcn_s_memrealtime() - t0 < d) __builtin_amdgcn_s_sleep(8); }
    }
#undef IN
#undef SEAM
}

extern "C" void kernel_launch(void* const* d_in, const int* in_sizes, int n_in, void* d_out, int out_size, void* d_ws, size_t ws_size, hipStream_t stream) {
    static int grid = 0;
    if (grid == 0) {
        if (n_in != 35 || out_size != M * D || ws_size < WS_END) { fprintf(stderr, "kernel_launch: unexpected problem (n_in %d, out %d, ws %zu < %zu)\n", n_in, out_size, ws_size, (size_t)WS_END); grid = -1; return; }
        int dev = 0, cus = 0, per_cu = 0;
        if (hipGetDevice(&dev) != hipSuccess || hipDeviceGetAttribute(&cus, hipDeviceAttributeMultiprocessorCount, dev) != hipSuccess) { grid = -1; return; }
        if (hipFuncSetAttribute((const void*)hymba_fwd, hipFuncAttributeMaxDynamicSharedMemorySize, LDS_BYTES) != hipSuccess) { fprintf(stderr, "kernel_launch: hipFuncSetAttribute failed\n"); grid = -1; return; }
        if (hipOccupancyMaxActiveBlocksPerMultiprocessor(&per_cu, (const void*)hymba_fwd, 512, LDS_BYTES) != hipSuccess || per_cu < 1) fprintf(stderr, "kernel_launch: occupancy query reports %d\n", per_cu);
        (void)hipGetLastError();
        grid = cus;
    }
    if (grid < 0) return;
    if (hipMemsetAsync((char*)d_ws + WS_CTL, 0, CTL_ZERO_BYTES, stream) != hipSuccess) return;
    Args a{};
    for (int i = 0; i < 35; ++i) a.in[i] = (const float*)d_in[i];
    a.out = (float*)d_out; a.ws = (unsigned char*)d_ws;
#if MK_LAUNCH_PER_PHASE
    for (int ph = 0; ph < NPHASE; ++ph) { a.ph_lo = ph; a.ph_hi = ph + 1; a.li = ph; hipLaunchKernelGGL(hymba_fwd, dim3(grid), dim3(512), LDS_BYTES, stream, a); }
#else
    a.ph_lo = 0; a.ph_hi = NPHASE; a.li = 0;
    hipLaunchKernelGGL(hymba_fwd, dim3(grid), dim3(512), LDS_BYTES, stream, a);
#endif
}
```

```cpp
#include <hip/hip_runtime.h>
#include <cstdio>
#include <cstdint>

#ifndef MK_LAUNCH_PER_PHASE
#define MK_LAUNCH_PER_PHASE 0
#endif

#define GAS __attribute__((address_space(1)))
#define LAS __attribute__((address_space(3)))
typedef unsigned short bf16;
typedef float f32x4 __attribute__((ext_vector_type(4)));
typedef unsigned u32x4 __attribute__((ext_vector_type(4)));
typedef unsigned u32x2 __attribute__((ext_vector_type(2)));
#define LDS_WAIT() asm volatile("s_waitcnt lgkmcnt(0)" ::: "memory")

constexpr int NB = 4, T = 4096, D = 2048, M = NB * T;
constexpr int NZ = 6144;
constexpr int ZQ = 0, ZKC = 1024, ZVC = 1280, ZKS = 1536, ZVS = 1792, ZKW = 2048, ZVW = 2304, ZGL = 2560, ZRW = 2608;
constexpr int ZR = 2608, ZK = 3632, ZV = 4656, ZWL = 5680, ZAL = 5776, ZGLO = 5872, INC = 6128;
constexpr int NCMP = 255, NE = 32, MAXBLK = 288, MAXROWS = MAXBLK * 256;
constexpr float LN_EPS = 1e-5f, GN_EPS = 64e-5f, ALPHA = 1.189207115002721f;
constexpr int NPHASE = 14;

constexpr size_t MiB = 1u << 20;
constexpr size_t WS_CTL = 0, CTL_ZERO_BYTES = 1 * MiB;
constexpr size_t WS_HIST = 1 * MiB;
constexpr size_t WS_BLKE = 1 * MiB + 64 * 1024;
constexpr size_t WS_TOPE = 2 * MiB;
constexpr size_t WS_TOPW = WS_TOPE + 256 * 1024;
constexpr size_t WS_SLOT = WS_TOPW + 256 * 1024;
constexpr size_t WS_TOKROW = WS_SLOT + 256 * 1024;
constexpr size_t WS_ROWTOK = 3 * MiB;
constexpr size_t WS_RWT = 3 * MiB + 512 * 1024;
constexpr size_t WS_WPL = 4 * MiB;
constexpr size_t WS_WUP = 5 * MiB;
constexpr size_t WS_AUP = WS_WUP + 512 * 1024;
constexpr size_t WS_GUP = 6 * MiB;
constexpr size_t WS_CW1K = 7 * MiB;
constexpr size_t WS_CW1V = 8 * MiB;
constexpr size_t WS_HCMPK = 1844 * MiB;
constexpr size_t WS_HCMPV = 1846 * MiB;
constexpr size_t WS_KCMP = 11 * MiB;
constexpr size_t WS_VCMP = 11 * MiB + 512 * 1024;
constexpr size_t WS_WIN = 12 * MiB;
constexpr size_t WS_WOUT = 36 * MiB;
constexpr size_t WS_WPG = 44 * MiB;
constexpr size_t WS_PB = 52 * MiB;
constexpr size_t WS_WGU = 60 * MiB;
constexpr size_t WS_WDN = 572 * MiB;
constexpr size_t WS_S = 828 * MiB;
constexpr size_t WS_XB = WS_S;
constexpr size_t WS_Z = WS_S + 64 * MiB;
constexpr size_t WS_ACK = WS_S + 256 * MiB;
constexpr size_t WS_ACV = WS_S + 272 * MiB;
constexpr size_t WS_WL = WS_S + 288 * MiB;
constexpr size_t WS_AL = WS_S + 296 * MiB;
constexpr size_t WS_GLS = WS_S + 304 * MiB;
constexpr size_t WS_DEC = WS_S + 312 * MiB;
constexpr size_t WS_ASIG = WS_S + 376 * MiB;
constexpr size_t WS_G = WS_S + 440 * MiB;
constexpr size_t WS_SC = WS_S + 504 * MiB;
constexpr size_t WS_Y = WS_S + 888 * MiB;
constexpr size_t WS_CAT = WS_S + 952 * MiB;
constexpr size_t WS_H1 = WS_S;
constexpr size_t WS_H1B = WS_S + 128 * MiB;
constexpr size_t WS_XG = WS_S + 160 * MiB;
constexpr size_t WS_HACT = WS_S + 304 * MiB;
constexpr size_t WS_EO = WS_S + 480 * MiB;
constexpr size_t WS_H2B = WS_S + 768 * MiB;
constexpr size_t WS_PL = WS_S + 832 * MiB;
constexpr size_t WS_H2Q = WS_S + 896 * MiB;
constexpr size_t WS_END = 1848 * MiB;
static_assert(WS_S + 1016 * MiB <= WS_HCMPK, "d_ws map");
constexpr int CW_BAR = 4096;

constexpr int LDS_BYTES = 147456;
constexpr int LDS_MISC = 147456 - 128;
constexpr int CW_ATTNQ = 8192;

__device__ __forceinline__ unsigned f2bf(float f) { unsigned u = __float_as_uint(f); return (u + 0x7fffu + ((u >> 16) & 1u)) >> 16; }
typedef __bf16 bf2v_t __attribute__((ext_vector_type(2)));
typedef float f2v_t __attribute__((ext_vector_type(2)));
__device__ __forceinline__ unsigned pk2(float lo, float hi) { f2v_t v; v.x = lo; v.y = hi; return __builtin_bit_cast(unsigned, __builtin_convertvector(v, bf2v_t)); }
__device__ __forceinline__ float bf2f(unsigned h) { return __uint_as_float(h << 16); }
__device__ __forceinline__ float bflo(unsigned w) { return __uint_as_float(w << 16); }
__device__ __forceinline__ float bfhi(unsigned w) { return __uint_as_float(w & 0xffff0000u); }
#define DPPF(x, ctrl) __builtin_bit_cast(float, __builtin_amdgcn_update_dpp(0, __builtin_bit_cast(int, (x)), (ctrl), 0xF, 0xF, true))
__device__ __forceinline__ float wave_sum(float v) {
    v += DPPF(v, 0xB1); v += DPPF(v, 0x4E); v += DPPF(v, 0x141); v += DPPF(v, 0x140);
    { const auto q = __builtin_amdgcn_permlane16_swap(__float_as_uint(v), __float_as_uint(v), false, false); v = __uint_as_float(q[0]) + __uint_as_float(q[1]); }
    { const auto q = __builtin_amdgcn_permlane32_swap(__float_as_uint(v), __float_as_uint(v), false, false); v = __uint_as_float(q[0]) + __uint_as_float(q[1]); }
    return v;
}
__device__ __forceinline__ float wave_max(float v) {
    v = fmaxf(v, DPPF(v, 0xB1)); v = fmaxf(v, DPPF(v, 0x4E)); v = fmaxf(v, DPPF(v, 0x141)); v = fmaxf(v, DPPF(v, 0x140));
    { const auto q = __builtin_amdgcn_permlane16_swap(__float_as_uint(v), __float_as_uint(v), false, false); v = fmaxf(__uint_as_float(q[0]), __uint_as_float(q[1])); }
    { const auto q = __builtin_amdgcn_permlane32_swap(__float_as_uint(v), __float_as_uint(v), false, false); v = fmaxf(__uint_as_float(q[0]), __uint_as_float(q[1])); }
    return v;
}
__device__ __forceinline__ unsigned pk_fp8x4(float a, float b, float c, float d) {
    a = __builtin_amdgcn_fmed3f(a, -448.f, 448.f); b = __builtin_amdgcn_fmed3f(b, -448.f, 448.f); c = __builtin_amdgcn_fmed3f(c, -448.f, 448.f); d = __builtin_amdgcn_fmed3f(d, -448.f, 448.f);
    int w = 0; w = __builtin_amdgcn_cvt_pk_fp8_f32(a, b, w, false); w = __builtin_amdgcn_cvt_pk_fp8_f32(c, d, w, true); return (unsigned)w; }
constexpr float FP8_SW = 64.0f, FP8_SA1 = 16.0f, FP8_SA2 = 4.0f;
constexpr int FP8_EW = 127 - 6, FP8_EA1 = 127 - 4, FP8_EA2 = 127 - 2;
__device__ __forceinline__ float sigmoidf_(float x) { return __builtin_amdgcn_rcpf(1.0f + __builtin_amdgcn_exp2f(-1.4426950408889634f * x)); }
__device__ __forceinline__ float gelu_tanh(float x) { const float u = 0.7978845608028654f * (x + 0.044715f * x * x * x); return x * sigmoidf_(2.0f * u); }

#define XB_TMO      128
#define XB_XCNT(j)  (256  + 64 * (j))
#define XB_XSUB(j)  (1280 + 64 * (j))
#define XB_XGEN(j)  (2304 + 64 * (j))
#define XB_TOP      3328
#define XB_TOPGEN   3392
#define XCD_BAR_WORDS 3456
#define XB_SPIN_CAP (1u << 22)
__device__ __forceinline__ unsigned xb_ld(unsigned* p)              { return __hip_atomic_load(p, __ATOMIC_RELAXED, __HIP_MEMORY_SCOPE_AGENT); }
__device__ __forceinline__ unsigned xb_add(unsigned* p, unsigned v) { return __hip_atomic_fetch_add(p, v, __ATOMIC_RELAXED, __HIP_MEMORY_SCOPE_AGENT); }
__device__ __forceinline__ unsigned xb_xcc_id() { return (unsigned)__builtin_amdgcn_s_getreg((3 << 11) | 20) & 0xFu; }
#define XB_SPIN(cond, bar) do { unsigned _sp = 0; while (cond) { __builtin_amdgcn_s_sleep(1); \
    if ((++_sp & 255u) == 0u) { if (xb_ld(&(bar)[XB_TMO])) break; if (_sp > XB_SPIN_CAP) { atomicAdd(&(bar)[XB_TMO], 1u); break; } } } } while (0)
struct XcdBarrier { unsigned* bar; unsigned x; volatile LAS unsigned* st; };
__device__ __forceinline__ XcdBarrier xcd_barrier_post(unsigned* bar, volatile LAS unsigned* st) {
    XcdBarrier b; b.bar = bar; b.x = xb_xcc_id(); b.st = st;
    if (threadIdx.x == 0) (void)xb_add(&bar[XB_XCNT(b.x)], 1u);
    return b;
}
__device__ __forceinline__ void xcd_barrier_complete(unsigned* bar, unsigned x, unsigned& nloc, unsigned& nx) {
    const unsigned G = gridDim.x * gridDim.y * gridDim.z;
    unsigned sum, cnt, mine, sp = 0u;
    for (;;) {
        sum = 0u; cnt = 0u; mine = 0u;
#pragma unroll
        for (unsigned j = 0; j < 16; ++j) { const unsigned c = xb_ld(&bar[XB_XCNT(j)]); sum += c; cnt += (c > 0u) ? 1u : 0u; mine = (j == x) ? c : mine; }
        if (sum == G) break;
        __builtin_amdgcn_s_sleep(1);
        if ((++sp & 255u) == 0u) { if (xb_ld(&bar[XB_TMO])) break; if (sp > XB_SPIN_CAP) { atomicAdd(&bar[XB_TMO], 1u); break; } }
    }
    nloc = mine > 0u ? mine : 1u; nx = cnt > 0u ? cnt : 1u;
}
__device__ __forceinline__ void xcd_barrier(const XcdBarrier& b) {
    asm volatile("s_waitcnt vmcnt(0)" ::: "memory");
    __syncthreads();
    if (threadIdx.x == 0) {
        unsigned* bar = b.bar;
        __builtin_amdgcn_s_waitcnt(0);
        unsigned nloc = b.st[0], nx = b.st[1];
        if (nloc == 0u) { xcd_barrier_complete(bar, b.x, nloc, nx); b.st[0] = nloc; b.st[1] = nx; }
        const unsigned old = xb_add(&bar[XB_XSUB(b.x)], 1u);
        const unsigned gen = old / nloc;
        if (old + 1u == (gen + 1u) * nloc) {
            __builtin_amdgcn_fence(__ATOMIC_RELEASE, "agent");
            asm volatile("s_waitcnt vmcnt(0)" ::: "memory");
            const unsigned og = xb_add(&bar[XB_TOP], 1u);
            const unsigned tg = og / nx;
            if (og + 1u == (tg + 1u) * nx) xb_add(&bar[XB_TOPGEN], 1u);
            else XB_SPIN(xb_ld(&bar[XB_TOPGEN]) == tg, bar);
            __builtin_amdgcn_fence(__ATOMIC_ACQUIRE, "agent");
            xb_add(&bar[XB_XGEN(b.x)], 1u);
            asm volatile("s_waitcnt vmcnt(0)" ::: "memory");
        } else {
            XB_SPIN(xb_ld(&bar[XB_XGEN(b.x)]) == gen, bar);
            __builtin_amdgcn_fence(__ATOMIC_ACQUIRE, "agent");
            asm volatile("s_waitcnt vmcnt(0)" ::: "memory");
        }
    }
    __syncthreads();
}

struct Args { const float* in[35]; float* out; unsigned char* ws; int ph_lo, ph_hi, li, pad; };
struct Frame {
    LAS unsigned char* lds;
    unsigned char* ws; float* out;
    int tid, lane, wave, bid, G;
};
enum { I_X = 0, I_P, I_WIN, I_PEK, I_W1K, I_W2K, I_PEV, I_W1V, I_W2V, I_MU, I_W0, I_WUP, I_A0, I_AUP, I_GUP, I_KK, I_KA, I_RK, I_LNG, I_LNB, I_WOUT,
       I_LN1G, I_LN1B, I_RW, I_RB, I_EWG, I_EBG, I_EWU, I_EBU, I_EWD, I_EBD, I_LN2G, I_LN2B, I_PLEW, I_PLEG };

struct GemmDesc {
    const bf16* A; int lda; const int* rowidx;
    const bf16* Bt; int ldb;
    int Mrows, N, K;
    const int* block_e; size_t bstride; const int* nblk;
    int ea, eb;
    int kext;
};
template <bool PAIR, class Epi>
__device__ __forceinline__ void ngemm_phase(Frame& F, const GemmDesc& g, const Epi& E) {
    LAS float* As = (LAS float*)F.lds;
    LAS float* Bs = As + 32 * 132;
    LAS float* Bu = Bs + 32 * 132;
    const int tid = F.tid, ty = tid >> 5, tx = tid & 31;
    const int lrow = tid >> 2, lkc = (tid & 3) * 8;
    const int ntm = g.Mrows / 128, ntn = PAIR ? g.N / 256 : g.N / 128;
    const int mlive = g.nblk ? (*g.nblk) * 256 : g.Mrows;
    for (int tile = F.bid; tile < ntm * ntn; tile += F.G) {
        const int tm = tile / ntn, tn = tile % ntn, m0 = tm * 128;
        if (m0 >= mlive) continue;
        const int e = g.block_e ? g.block_e[m0 >> 8] : 0;
        const bf16* Bt = g.Bt + (size_t)e * g.bstride;
        const int arow = g.rowidx ? g.rowidx[m0 + lrow] : (m0 + lrow);
        const bf16* ap = g.A + (size_t)arow * g.lda + lkc;
        const bf16* bp = Bt + (size_t)((PAIR ? tn * 256 : tn * 128) + lrow) * g.ldb + lkc;
        const bf16* bup = bp + (size_t)128 * g.ldb;
        f32x4 acc[8], accu[8];
#pragma unroll
        for (int i = 0; i < 8; ++i) { acc[i] = (f32x4){0.f, 0.f, 0.f, 0.f}; accu[i] = (f32x4){0.f, 0.f, 0.f, 0.f}; }
        for (int k0 = 0; k0 < g.K; k0 += 32) {
            const u32x4 av = *(const u32x4*)(ap + k0), bv = *(const u32x4*)(bp + k0);
            u32x4 uv = (u32x4){0u, 0u, 0u, 0u}; if (PAIR) uv = *(const u32x4*)(bup + k0);
            __syncthreads();
#pragma unroll
            for (int j = 0; j < 4; ++j) {
                As[(lkc + 2 * j) * 132 + lrow] = bflo(av[j]); As[(lkc + 2 * j + 1) * 132 + lrow] = bfhi(av[j]);
                Bs[(lkc + 2 * j) * 132 + lrow] = bflo(bv[j]); Bs[(lkc + 2 * j + 1) * 132 + lrow] = bfhi(bv[j]);
                if (PAIR) { Bu[(lkc + 2 * j) * 132 + lrow] = bflo(uv[j]); Bu[(lkc + 2 * j + 1) * 132 + lrow] = bfhi(uv[j]); }
            }
            __syncthreads();
#pragma unroll 4
            for (int k = 0; k < 32; ++k) {
                const f32x4 a0 = *(const LAS f32x4*)(As + k * 132 + ty * 8), a1 = *(const LAS f32x4*)(As + k * 132 + ty * 8 + 4);
                const f32x4 b = *(const LAS f32x4*)(Bs + k * 132 + tx * 4);
                acc[0] += a0.x * b; acc[1] += a0.y * b; acc[2] += a0.z * b; acc[3] += a0.w * b;
                acc[4] += a1.x * b; acc[5] += a1.y * b; acc[6] += a1.z * b; acc[7] += a1.w * b;
                if (PAIR) { const f32x4 u = *(const LAS f32x4*)(Bu + k * 132 + tx * 4);
                    accu[0] += a0.x * u; accu[1] += a0.y * u; accu[2] += a0.z * u; accu[3] += a0.w * u;
                    accu[4] += a1.x * u; accu[5] += a1.y * u; accu[6] += a1.z * u; accu[7] += a1.w * u; }
            }
        }
        const int col = (PAIR ? tn * 128 : tn * 128) + tx * 4;
#pragma unroll
        for (int i = 0; i < 8; ++i) { const int row = m0 + ty * 8 + i;
            if constexpr (PAIR) E.stp(row, col, acc[i], accu[i], e); else E.st(row, col, acc[i], e); }
    }
    __syncthreads();
}

__device__ __forceinline__ void st_bf16x4(bf16* p, f32x4 v) { u32x2 w; w.x = pk2(v.x, v.y); w.y = pk2(v.z, v.w); *(u32x2*)p = w; }
__device__ __forceinline__ void st_bf16x8(bf16* p, f32x4 a, f32x4 b) { u32x4 w; w.x = pk2(a.x, a.y); w.y = pk2(a.z, a.w); w.z = pk2(b.x, b.y); w.w = pk2(b.z, b.w); *(u32x4*)p = w; }
struct EpiZ { static constexpr bool PERM = true; bf16* Z; __device__ __forceinline__ void st(int r, int c, f32x4 v, int) const { st_bf16x4(Z + (size_t)r * NZ + c, v); }
    __device__ __forceinline__ void st8(int r, int c, f32x4 a, f32x4 b, int) const { st_bf16x8(Z + (size_t)r * NZ + c, a, b); } };
struct EpiCmp { float* H; __device__ __forceinline__ void st(int r, int c, f32x4 v, int) const { if (c < 64) { f32x4 o; o.x = gelu_tanh(v.x); o.y = gelu_tanh(v.y); o.z = gelu_tanh(v.z); o.w = gelu_tanh(v.w); *(f32x4*)(H + (size_t)r * 64 + c) = o; } } };
struct EpiCmpPart { float* H; __device__ __forceinline__ void st(int r, int c, f32x4 v, int) const { if (c < 64) *(f32x4*)(H + (size_t)r * 64 + c) = v; } };
struct EpiDecay { float* O; const float* w0;
    __device__ __forceinline__ float f(float x) const { const float y = -x; const float sp = fmaxf(y, 0.f) + __logf(1.0f + __expf(-fabsf(y))); return __expf(-__expf(-sp - 0.5f)); }
    __device__ __forceinline__ void st(int r, int c, f32x4 v, int) const { const f32x4 b = *(const f32x4*)(w0 + c); f32x4 o; o.x = f(v.x + b.x); o.y = f(v.y + b.y); o.z = f(v.z + b.z); o.w = f(v.w + b.w); *(f32x4*)(O + (size_t)r * 1024 + c) = o; } };
struct EpiASig { float* O; const float* a0;
    __device__ __forceinline__ void st(int r, int c, f32x4 v, int) const { const f32x4 b = *(const f32x4*)(a0 + c); f32x4 o; o.x = sigmoidf_(v.x + b.x); o.y = sigmoidf_(v.y + b.y); o.z = sigmoidf_(v.z + b.z); o.w = sigmoidf_(v.w + b.w); *(f32x4*)(O + (size_t)r * 1024 + c) = o; } };
struct EpiLora { static constexpr bool PERM = true; float* DEC; float* ASIG; bf16* G; const float* w0; const float* a0;
    __device__ __forceinline__ float fd(float x) const { const float y = -x; const float sp = fmaxf(y, 0.f) + __logf(1.0f + __expf(-fabsf(y))); return __expf(-__expf(-sp - 0.5f)); }
    __device__ __forceinline__ void st8(int r, int c, f32x4 a, f32x4 b, int e) const { const int m = r - e * M;
        if (e == 0) { const f32x4 b0 = *(const f32x4*)(w0 + c), b1 = *(const f32x4*)(w0 + c + 4); f32x4 o0, o1; o0.x = fd(a.x + b0.x); o0.y = fd(a.y + b0.y); o0.z = fd(a.z + b0.z); o0.w = fd(a.w + b0.w); o1.x = fd(b.x + b1.x); o1.y = fd(b.y + b1.y); o1.z = fd(b.z + b1.z); o1.w = fd(b.w + b1.w);
            *(f32x4*)(DEC + (size_t)m * 1024 + c) = o0; *(f32x4*)(DEC + (size_t)m * 1024 + c + 4) = o1; }
        else if (e == 1) { const f32x4 b0 = *(const f32x4*)(a0 + c), b1 = *(const f32x4*)(a0 + c + 4); f32x4 o0, o1; o0.x = sigmoidf_(a.x + b0.x); o0.y = sigmoidf_(a.y + b0.y); o0.z = sigmoidf_(a.z + b0.z); o0.w = sigmoidf_(a.w + b0.w); o1.x = sigmoidf_(b.x + b1.x); o1.y = sigmoidf_(b.y + b1.y); o1.z = sigmoidf_(b.z + b1.z); o1.w = sigmoidf_(b.w + b1.w);
            st_bf16x8((bf16*)ASIG + (size_t)m * 1024 + c, o0, o1); }
        else st_bf16x8(G + (size_t)m * 1024 + c, a, b); }
    __device__ __forceinline__ void st(int, int, f32x4, int) const {} };
struct EpiF32 { float* O; int ld; __device__ __forceinline__ void st(int r, int c, f32x4 v, int) const { *(f32x4*)(O + (size_t)r * ld + c) = v; } };
struct EpiPre1 { float* O; const float* x; __device__ __forceinline__ void st(int r, int c, f32x4 v, int) const { const f32x4 xv = *(const f32x4*)(x + (size_t)r * D + c); *(f32x4*)(O + (size_t)r * D + c) = ALPHA * xv + v; } };
struct EpiSwiglu { static constexpr bool PERM = true; unsigned char* H; const float* bg; const float* bu;
    __device__ __forceinline__ float f(float g, float u) const { g = fminf(g, 7.0f); u = fminf(fmaxf(u, -7.0f), 7.0f); return g * sigmoidf_(1.702f * g) * (u + 1.0f); }
    __device__ __forceinline__ void stp(int r, int c, f32x4 g, f32x4 u, int e) const { const f32x4 b0 = *(const f32x4*)(bg + (size_t)e * D + c), b1 = *(const f32x4*)(bu + (size_t)e * D + c);
        f32x4 o; o.x = f(g.x + b0.x, u.x + b1.x); o.y = f(g.y + b0.y, u.y + b1.y); o.z = f(g.z + b0.z, u.z + b1.z); o.w = f(g.w + b0.w, u.w + b1.w); *(unsigned*)(H + (size_t)r * D + c) = pk_fp8x4(o.x * FP8_SA2, o.y * FP8_SA2, o.z * FP8_SA2, o.w * FP8_SA2); }
    __device__ __forceinline__ unsigned q4(int c, f32x4 g, f32x4 u, int e) const { const f32x4 b0 = *(const f32x4*)(bg + (size_t)e * D + c), b1 = *(const f32x4*)(bu + (size_t)e * D + c);
        return pk_fp8x4(f(g.x + b0.x, u.x + b1.x) * FP8_SA2, f(g.y + b0.y, u.y + b1.y) * FP8_SA2, f(g.z + b0.z, u.z + b1.z) * FP8_SA2, f(g.w + b0.w, u.w + b1.w) * FP8_SA2); }
    __device__ __forceinline__ void stp8(int r, int c, f32x4 g0, f32x4 g1, f32x4 u0, f32x4 u1, int e) const { u32x2 w; w.x = q4(c, g0, u0, e); w.y = q4(c + 4, g1, u1, e); *(u32x2*)(H + (size_t)r * D + c) = w; } };
struct EpiDown { static constexpr bool PERM = true; bf16* O; const float* bd; __device__ __forceinline__ void st(int r, int c, f32x4 v, int e) const { const f32x4 b = *(const f32x4*)(bd + (size_t)e * D + c); st_bf16x4(O + (size_t)r * D + c, v + b); }
    __device__ __forceinline__ void st8(int r, int c, f32x4 a, f32x4 b, int e) const { const f32x4 b0 = *(const f32x4*)(bd + (size_t)e * D + c), b1 = *(const f32x4*)(bd + (size_t)e * D + c + 4); st_bf16x8(O + (size_t)r * D + c, a + b0, b + b1); } };
struct EpiBf16 { static constexpr bool PERM = true; bf16* O; int ld; __device__ __forceinline__ void st(int r, int c, f32x4 v, int) const { st_bf16x4(O + (size_t)r * ld + c, v); }
    __device__ __forceinline__ void st8(int r, int c, f32x4 a, f32x4 b, int) const { st_bf16x8(O + (size_t)r * ld + c, a, b); } };
struct EpiFinal { float* out; const bf16* PL; const bf16* H2;
    __device__ __forceinline__ void st(int r, int c, f32x4 v, int) const { const size_t o = (size_t)r * D + c; const u32x2 hw = *(const u32x2*)(H2 + o); const u32x2 pw = *(const u32x2*)(PL + o);
        f32x4 q; q.x = bflo(hw.x) + sigmoidf_(v.x) * bflo(pw.x); q.y = bfhi(hw.x) + sigmoidf_(v.y) * bfhi(pw.x); q.z = bflo(hw.y) + sigmoidf_(v.z) * bflo(pw.y); q.w = bfhi(hw.y) + sigmoidf_(v.w) * bfhi(pw.y); *(f32x4*)(out + o) = q; } };


namespace pg8 {
typedef short bf16x8 __attribute__((ext_vector_type(8)));
constexpr int BM = 256, BK = 64, HALF = 128, HTB = HALF * BK * 2, STAGE_BYTES = 8 * HTB, NXCD = 8, WGM = 8;
__device__ __forceinline__ int lds_byte(int r, int c) { const int st = (r >> 4) * 2 + (c >> 5), rr = r & 15, cc = c & 31, ob = rr * 64 + cc * 2; return st * 1024 + (ob ^ (((ob >> 9) & 1) << 5)); }
__device__ __forceinline__ void stage_rc(int b, int& R, int& C) { const int st = b / 1024, sb = b % 1024, swz = sb ^ (((sb >> 9) & 1) << 5); R = (st >> 1) * 16 + swz / 64; C = (st & 1) * 32 + (swz % 64) / 2; }
struct Unit { int pm, pn; };
struct StaticOrder {
    int nM, nN, nwg, G, c;
    __device__ void init(int nM_, int nN_, int G_, int c_) { nM = nM_; nN = nN_; nwg = nM * nN; G = G_; c = c_; }
    __device__ bool next(int i, Unit& u) const {
        const long L = (long)i * G + c; if (L >= nwg) return false;
        int wgid = (int)L; { const int q = nwg / NXCD, r = nwg % NXCD, xcd = wgid % NXCD, off = wgid / NXCD; wgid = (xcd < r ? xcd * (q + 1) : r * (q + 1) + (xcd - r) * q) + off; }
        const int nig = WGM * nN, gid = wgid / nig, fm = gid * WGM, gsz = (nM - fm) < WGM ? (nM - fm) : WGM;
        u.pm = fm + ((wgid % nig) % gsz); u.pn = (wgid % nig) / gsz; return true;
    }
};
template <class E, class = void> struct epi_perm { static constexpr bool value = false; };
template <class E> struct epi_perm<E, decltype((void)E::PERM)> { static constexpr bool value = E::PERM; };
__device__ __forceinline__ int perm32(int rho) { const int n = rho >> 4, i = rho & 15; return 8 * (i >> 2) + 4 * n + (i & 3); }
template <bool PAIR, class Epi>
__device__ __forceinline__ void epilogue(const f32x4 (&acc)[2][2][4][2], const Unit& u, int e, const Epi& E, int wr, int wc, int fr, int fq) {
    const int row0 = u.pm * BM + wr * 64 + fr;
#pragma unroll
    for (int ai = 0; ai < 2; ++ai)
#pragma unroll
        for (int m = 0; m < 4; ++m) { const int row = row0 + ai * HALF + m * 16;
            if constexpr (PAIR) {
                if constexpr (epi_perm<Epi>::value) E.stp8(row, u.pn * HALF + wc * 32 + 8 * fq, acc[ai][0][m][0], acc[ai][0][m][1], acc[ai][1][m][0], acc[ai][1][m][1], e);
                else {
#pragma unroll
                    for (int n = 0; n < 2; ++n) E.stp(row, u.pn * HALF + wc * 32 + n * 16 + 4 * fq, acc[ai][0][m][n], acc[ai][1][m][n], e); }
            } else if constexpr (epi_perm<Epi>::value) {
#pragma unroll
                for (int bj = 0; bj < 2; ++bj) E.st8(row, u.pn * BM + bj * HALF + wc * 32 + 8 * fq, acc[ai][bj][m][0], acc[ai][bj][m][1], e);
            } else {
#pragma unroll
                for (int bj = 0; bj < 2; ++bj)
#pragma unroll
                    for (int n = 0; n < 2; ++n) E.st(row, u.pn * BM + bj * HALF + wc * 32 + n * 16 + 4 * fq, acc[ai][bj][m][n], e);
            } }
}
typedef int i32x8 __attribute__((ext_vector_type(8)));
__device__ __forceinline__ i32x8 cat8(const bf16x8& lo, const bf16x8& hi) { const u32x4 a = __builtin_bit_cast(u32x4, lo), b = __builtin_bit_cast(u32x4, hi); i32x8 r; r[0] = (int)a.x; r[1] = (int)a.y; r[2] = (int)a.z; r[3] = (int)a.w; r[4] = (int)b.x; r[5] = (int)b.y; r[6] = (int)b.z; r[7] = (int)b.w; return r; }
template <bool PAIR, bool FP8, class Epi>
__device__ __forceinline__ void gemm_phase(LAS unsigned char* lds, const GemmDesc& g, const Epi& E, int G, int cid) {
    const int tid = threadIdx.x, wid = __builtin_amdgcn_readfirstlane(tid >> 6), lane = tid & 63, wr = wid >> 2, wc = wid & 3, fr = lane & 15, fq = lane >> 4;
    const unsigned pitchB = FP8 ? (unsigned)g.K : (unsigned)g.K * 2u;
    const int nt = g.kext ? (int)((FP8 ? (unsigned)g.kext : (unsigned)g.kext * 2u) / 128u) : (int)(pitchB / 128u);
    const int sc_a = g.ea, sc_b = g.eb;
    StaticOrder S; S.init(g.nblk ? *g.nblk : g.Mrows / BM, g.N / BM, G, cid);
    unsigned voffA[2], voffB[2];
#pragma unroll
    for (int i = 0; i < 2; ++i) { int R, C; stage_rc(tid * 16 + i * 8192, R, C); const int Rb = epi_perm<Epi>::value ? ((R & ~31) + perm32(R & 31)) : R;
        voffA[i] = (unsigned)R * pitchB + (unsigned)C * 2u; voffB[i] = (unsigned)Rb * pitchB + (unsigned)C * 2u; }
    const size_t kstep = (size_t)(BK * 2);
    const size_t hstep = (size_t)HALF * pitchB;
    const size_t tstep = 2 * hstep;
    const unsigned ldsw = (unsigned)wid * 1024u;
    const int aoff = lds_byte(wr * 64 + fr, fq * 8), boff = lds_byte(wc * 32 + fr, fq * 8);
    const char* gA = (const char*)g.A;
#define PG8_SA(b, h) (((b) * 2 + (h)) * HTB)
#define PG8_SB(b, h) ((4 + (b) * 2 + (h)) * HTB)
#define PG8_STAGE(bufoff, gbase, voff) do { _Pragma("unroll") for (int _i = 0; _i < 2; ++_i) \
        __builtin_amdgcn_global_load_lds((const unsigned*)((const char*)(gbase) + (voff)[_i]), (LAS unsigned*)(lds + (bufoff) + ldsw + _i * 8192), 16, 0, 0); } while (0)
#define PG8_LD8(dst, off) do { const u32x4 lo_ = *(const LAS u32x4*)(lds + (off)), hi_ = *(const LAS u32x4*)(lds + (off) + 1024); \
        dst[0] = (int)lo_.x; dst[1] = (int)lo_.y; dst[2] = (int)lo_.z; dst[3] = (int)lo_.w; dst[4] = (int)hi_.x; dst[5] = (int)hi_.y; dst[6] = (int)hi_.z; dst[7] = (int)hi_.w; } while (0)
#define PG8_LDA(dst, b, h) do { _Pragma("unroll") for (int m = 0; m < 4; ++m) { if constexpr (FP8) PG8_LD8(dst##8[m], PG8_SA(b, h) + aoff + m * 2048); else { _Pragma("unroll") for (int k = 0; k < 2; ++k) dst[m][k] = *(const LAS bf16x8*)(lds + PG8_SA(b, h) + aoff + m * 2048 + k * 1024); } } } while (0)
#define PG8_LDB(dst, b, h) do { _Pragma("unroll") for (int n = 0; n < 2; ++n) { if constexpr (FP8) PG8_LD8(dst##8[n], PG8_SB(b, h) + boff + n * 2048); else { _Pragma("unroll") for (int k = 0; k < 2; ++k) dst[n][k] = *(const LAS bf16x8*)(lds + PG8_SB(b, h) + boff + n * 2048 + k * 1024); } } } while (0)
#define PG8_MMA(ai, bj, At, Bt) do { __builtin_amdgcn_s_setprio(1); _Pragma("unroll") for (int m = 0; m < 4; ++m) _Pragma("unroll") for (int n = 0; n < 2; ++n) { \
        if constexpr (FP8) asm volatile("v_mfma_scale_f32_16x16x128_f8f6f4 %0, %1, %2, %0, %3, %4 op_sel_hi:[0,0,0]" : "+v"(acc[ai][bj][m][n]) : "v"(Bt##8[n]), "v"(At##8[m]), "v"(sc_b), "v"(sc_a));   \
        else { _Pragma("unroll") for (int k = 0; k < 2; ++k) acc[ai][bj][m][n] = __builtin_amdgcn_mfma_f32_16x16x32_bf16(Bt[n][k], At[m][k], acc[ai][bj][m][n], 0, 0, 0); } } __builtin_amdgcn_s_setprio(0); } while (0)
#define PG8_WAIT_V(n) asm volatile("s_waitcnt vmcnt(" #n ")" ::: "memory")
#define PG8_WAIT_L(n) asm volatile("s_waitcnt lgkmcnt(" #n ")" ::: "memory")
#define PG8_BAR __builtin_amdgcn_s_barrier()
#define PG8_SCHED __builtin_amdgcn_sched_barrier(0)
    Unit cur, nxt; int ui = 0;
    if (!S.next(0, cur)) return;
    f32x4 acc[2][2][4][2];
#pragma unroll
    for (int a = 0; a < 2; ++a)
#pragma unroll
        for (int b = 0; b < 2; ++b)
#pragma unroll
            for (int m = 0; m < 4; ++m)
#pragma unroll
                for (int n = 0; n < 2; ++n) acc[a][b][m][n] = (f32x4){0.f, 0.f, 0.f, 0.f};
    bf16x8 At[4][2], B0[2][2], B1[2][2];
    i32x8 At8[4], B08[2], B18[2];
    int ecur = g.block_e ? g.block_e[cur.pm] : 0;
    const char* cA = gA + (size_t)cur.pm * tstep;
    const char* cB = (const char*)g.Bt + (size_t)ecur * g.bstride * (FP8 ? 1 : 2) + (size_t)cur.pn * tstep;
    PG8_STAGE(PG8_SB(0, 0), cB, voffB); PG8_STAGE(PG8_SB(0, 1), cB + hstep, voffB); PG8_STAGE(PG8_SA(0, 0), cA, voffA); PG8_STAGE(PG8_SA(0, 1), cA + hstep, voffA);
    if (wr == 1) PG8_BAR;
    PG8_WAIT_V(2); PG8_BAR;
    PG8_STAGE(PG8_SB(1, 0), cB + kstep, voffB); PG8_STAGE(PG8_SA(1, 0), cA + kstep, voffA); PG8_STAGE(PG8_SB(1, 1), cB + hstep + kstep, voffB);
    PG8_WAIT_V(6); PG8_BAR;
    for (;;) {
        const bool has_next = S.next(ui + 1, nxt);
        int enxt = ecur; const char* nB = cB; const char* nA = cA;
        if (has_next) { enxt = g.block_e ? g.block_e[nxt.pm] : 0; nA = gA + (size_t)nxt.pm * tstep; nB = (const char*)g.Bt + (size_t)enxt * g.bstride * (FP8 ? 1 : 2) + (size_t)nxt.pn * tstep; }
        for (int t = 0; t < nt; t += 2) {
            const bool last = (t == nt - 2);
            const char* a1 = cA + (size_t)(t + 1) * kstep;
            const char* a2 = last ? nA : cA + (size_t)(t + 2) * kstep; const char* b2 = last ? nB : cB + (size_t)(t + 2) * kstep;
            const char* a3 = a2 + kstep; const char* b3 = b2 + kstep;
            PG8_LDB(B0, 0, 0); PG8_LDB(B1, 0, 1); PG8_SCHED; PG8_LDA(At, 0, 0); PG8_STAGE(PG8_SA(1, 1), a1 + hstep, voffA);
            PG8_WAIT_V(8); PG8_WAIT_L(0); PG8_BAR; PG8_MMA(0, 0, At, B0); PG8_MMA(0, 1, At, B1); PG8_BAR; PG8_SCHED;
            PG8_LDA(At, 0, 1); PG8_STAGE(PG8_SB(0, 0), b2, voffB); PG8_STAGE(PG8_SB(0, 1), b2 + hstep, voffB); PG8_STAGE(PG8_SA(0, 0), a2, voffA);
            PG8_WAIT_V(8); PG8_WAIT_L(0); PG8_BAR; PG8_MMA(1, 0, At, B0); PG8_MMA(1, 1, At, B1); PG8_BAR; PG8_SCHED;
            PG8_LDB(B0, 1, 0); PG8_LDB(B1, 1, 1); PG8_SCHED; PG8_LDA(At, 1, 0); PG8_STAGE(PG8_SA(0, 1), a2 + hstep, voffA);
            PG8_WAIT_V(8); PG8_WAIT_L(0); PG8_BAR; PG8_MMA(0, 0, At, B0); PG8_MMA(0, 1, At, B1); PG8_BAR; PG8_SCHED;
            PG8_LDA(At, 1, 1); PG8_STAGE(PG8_SB(1, 0), b3, voffB); PG8_STAGE(PG8_SB(1, 1), b3 + hstep, voffB); PG8_STAGE(PG8_SA(1, 0), a3, voffA);
            PG8_WAIT_V(8); PG8_WAIT_L(0); PG8_BAR; PG8_MMA(1, 0, At, B0); PG8_MMA(1, 1, At, B1); PG8_BAR; PG8_SCHED;
        }
        if constexpr (FP8) asm volatile("s_nop 15\n\ts_nop 15" ::: "memory");
        if (wr == 0) PG8_BAR;
        epilogue<PAIR, Epi>(acc, cur, ecur, E, wr, wc, fr, fq);
        if (!has_next) break;
#pragma unroll
        for (int a = 0; a < 2; ++a)
#pragma unroll
            for (int b = 0; b < 2; ++b)
#pragma unroll
                for (int m = 0; m < 4; ++m)
#pragma unroll
                    for (int n = 0; n < 2; ++n) acc[a][b][m][n] = (f32x4){0.f, 0.f, 0.f, 0.f};
        cur = nxt; cA = nA; cB = nB; ecur = enxt; ++ui;
        if (wr == 1) PG8_BAR;
    }
    PG8_WAIT_V(0);
    PG8_BAR;
#undef PG8_SA
#undef PG8_SB
#undef PG8_STAGE
#undef PG8_LDA
#undef PG8_LD8
#undef PG8_LDB
#undef PG8_MMA
#undef PG8_WAIT_V
#undef PG8_WAIT_L
#undef PG8_BAR
#undef PG8_SCHED
}
}

#ifndef NAIVE_GEMM
#define NAIVE_GEMM 0
#endif
template <class Epi> __device__ __forceinline__ void gemm_run_part(Frame& F, const GemmDesc& g, const Epi& E, int G, int cid) {
    pg8::gemm_phase<false, false, Epi>(F.lds, g, E, G, cid);
    __syncthreads();
}
template <bool PAIR, class Epi, bool FP8 = false> __device__ __forceinline__ void gemm_run(Frame& F, const GemmDesc& g, const Epi& E) {
#if NAIVE_GEMM
    static_assert(!FP8, "the naive GEMM has no fp8 path");
    ngemm_phase<PAIR, Epi>(F, g, E);
#else
    pg8::gemm_phase<PAIR, FP8, Epi>(F.lds, g, E, F.G, F.bid);
    __syncthreads();
#endif
}

__device__ __forceinline__ void transpose_item(const float* W, int K, int N, bf16* WT, int Kp, size_t row0, int k0, int n0, LAS float* scr, int lane) {
    const int n = n0 + (lane & 31);
#pragma unroll 8
    for (int i = 0; i < 32; ++i) { const int kk = 2 * i + (lane >> 5), k = k0 + kk; scr[kk * 33 + (lane & 31)] = (k < K && n < N) ? W[(size_t)k * N + n] : 0.f; }
    LDS_WAIT(); asm volatile("" ::: "memory");
    const int c = lane & 7;
#pragma unroll
    for (int j = 0; j < 4; ++j) { const int nn = (lane >> 3) + 8 * j; const LAS float* s = scr + (8 * c) * 33 + nn;
        u32x4 o; o.x = pk2(s[0 * 33], s[1 * 33]); o.y = pk2(s[2 * 33], s[3 * 33]); o.z = pk2(s[4 * 33], s[5 * 33]); o.w = pk2(s[6 * 33], s[7 * 33]);
        *(u32x4*)(WT + (row0 + nn) * Kp + k0 + 8 * c) = o; }
    LDS_WAIT(); asm volatile("" ::: "memory");
}
struct CvItem { const float* src; unsigned char* dst; };
__device__ __forceinline__ CvItem cv_decode(const Args& a, unsigned char* ws, int it) {
    const int e = it / 3072, rr = it % 3072, which = rr >> 10, ri = rr & 1023, kb = ri & 31, nb = ri >> 5, n0 = 64 * nb, k0 = 64 * kb;
    CvItem c;
    const float* W = a.in[which == 0 ? I_EWG : (which == 1 ? I_EWU : I_EWD)] + (size_t)e * D * D;
    c.src = W + (size_t)k0 * D + n0;
    const size_t row0 = which == 2 ? (size_t)e * 2048 + n0 : (size_t)e * 4096 + (n0 >> 7) * 256 + (which == 1 ? 128 : 0) + (n0 & 127);
    c.dst = (unsigned char*)(ws + (which == 2 ? WS_WDN : WS_WGU)) + row0 * D + k0;
    return c;
}
__device__ __forceinline__ void cv_load(const CvItem& c, f32x4 (&v)[16], int lane) {
    const int kr = lane >> 4, n4 = (lane & 15) * 4;
#pragma unroll
    for (int i = 0; i < 16; ++i) v[i] = __builtin_nontemporal_load((const f32x4*)(c.src + (size_t)(4 * i + kr) * D + n4));
}
__device__ __forceinline__ void cv_store(const CvItem& cc, const f32x4 (&v)[16], int lane) {
    const int R = lane >> 4, c16 = lane & 15;
    unsigned od[16];
#pragma unroll
    for (int i = 0; i < 16; ++i) {
        unsigned x0 = __float_as_uint(v[i].x), x1 = __float_as_uint(v[i].y), x2 = __float_as_uint(v[i].z), x3 = __float_as_uint(v[i].w);
        { const auto q = __builtin_amdgcn_permlane16_swap(x0, x1, false, false); x0 = q[0]; x1 = q[1]; }
        { const auto q = __builtin_amdgcn_permlane16_swap(x2, x3, false, false); x2 = q[0]; x3 = q[1]; }
        { const auto q = __builtin_amdgcn_permlane32_swap(x0, x2, false, false); x0 = q[0]; x2 = q[1]; }
        { const auto q = __builtin_amdgcn_permlane32_swap(x1, x3, false, false); x1 = q[0]; x3 = q[1]; }
        od[i] = pk_fp8x4(__uint_as_float(x0) * FP8_SW, __uint_as_float(x1) * FP8_SW, __uint_as_float(x2) * FP8_SW, __uint_as_float(x3) * FP8_SW);
    }
    unsigned char* dp = cc.dst + (size_t)(4 * c16 + R) * D;
#pragma unroll
    for (int j = 0; j < 4; ++j) *(u32x4*)(dp + 16 * j) = (u32x4){od[4 * j], od[4 * j + 1], od[4 * j + 2], od[4 * j + 3]};
}
__device__ __forceinline__ void tb_load(const float* W, int N, int k0, int n0, f32x4 (&v)[16], int lane) {
    const int kr = lane >> 4, n4 = n0 + (lane & 15) * 4; const bool ok = n4 < N;
#pragma unroll
    for (int i = 0; i < 16; ++i) v[i] = ok ? __builtin_nontemporal_load((const f32x4*)(W + (size_t)(k0 + 4 * i + kr) * N + n4)) : (f32x4){0.f, 0.f, 0.f, 0.f};
}
__device__ __forceinline__ void tb_store(bf16* WT, int Kp, int k0, int n0, const f32x4 (&v)[16], int lane) {
    const int R = lane >> 4, c16 = lane & 15;
    unsigned od[32];
#pragma unroll
    for (int i = 0; i < 16; ++i) {
        unsigned x0 = __float_as_uint(v[i].x), x1 = __float_as_uint(v[i].y), x2 = __float_as_uint(v[i].z), x3 = __float_as_uint(v[i].w);
        { const auto q = __builtin_amdgcn_permlane16_swap(x0, x1, false, false); x0 = q[0]; x1 = q[1]; }
        { const auto q = __builtin_amdgcn_permlane16_swap(x2, x3, false, false); x2 = q[0]; x3 = q[1]; }
        { const auto q = __builtin_amdgcn_permlane32_swap(x0, x2, false, false); x0 = q[0]; x2 = q[1]; }
        { const auto q = __builtin_amdgcn_permlane32_swap(x1, x3, false, false); x1 = q[0]; x3 = q[1]; }
        od[2 * i] = pk2(__uint_as_float(x0), __uint_as_float(x1)); od[2 * i + 1] = pk2(__uint_as_float(x2), __uint_as_float(x3));
    }
    bf16* dp = WT + (size_t)(n0 + 4 * c16 + R) * Kp + k0;
#pragma unroll
    for (int j = 0; j < 8; ++j) *(u32x4*)(dp + 8 * j) = (u32x4){od[4 * j], od[4 * j + 1], od[4 * j + 2], od[4 * j + 3]};
}
__device__ __forceinline__ void p0_prologue(Frame& F, const Args& a) {
    LAS float* scr = (LAS float*)(F.lds + F.wave * 16384);
    unsigned char* ws = F.ws;
    const int gw = F.bid * 8 + F.wave, NGW = F.G * 8;
    {
        constexpr int NB0 = 96 * 32, NB1 = 32 * 32, NBIG = NB0 + 2 * NB1;
        f32x4 va[16];
        for (int it = gw; it < NBIG; it += NGW) {
            const float* W; bf16* WT; int N, r = it;
            if (r < NB0) { W = a.in[I_WIN]; WT = (bf16*)(ws + WS_WIN); N = INC; }
            else if (r < NB0 + NB1) { r -= NB0; W = a.in[I_WOUT]; WT = (bf16*)(ws + WS_WOUT); N = D; }
            else { r -= NB0 + NB1; const int kb = r & 31, nb = r >> 5;
                CvItem ci; ci.src = a.in[I_PLEG] + (size_t)(64 * kb) * D + 64 * nb; ci.dst = (unsigned char*)(ws + WS_WPG) + (size_t)(64 * nb) * D + 64 * kb; cv_load(ci, va, F.lane); cv_store(ci, va, F.lane); continue; }
            const int kb = r & 31, nb = r >> 5;
            tb_load(W, N, 64 * kb, 64 * nb, va, F.lane); tb_store(WT, D, 64 * kb, 64 * nb, va, F.lane);
        }
    }
    constexpr int I3 = 4 * 64, I4 = 4 * 32, I5 = 4 * 32, I6 = 4 * 32, I7 = 32 * 8, I8 = 32 * 8;
    constexpr int NITEMS = I3 + I4 + I5 + I6 + I7 + I8;
    for (int it = gw; it < NITEMS; it += NGW) {
        int r = it;
#define TR_SIMPLE(cnt, W, K, N, WT, Kp, nblk) if (r < (cnt)) { const int kb = r / (nblk), nb = r % (nblk); transpose_item((W), (K), (N), (bf16*)(WT), (Kp), (size_t)(32 * nb), 64 * kb, 32 * nb, scr, F.lane); continue; } r -= (cnt);
        TR_SIMPLE(I3, a.in[I_PLEW], 256, 2048, ws + WS_WPL, 256, 64)
        TR_SIMPLE(I4, a.in[I_WUP], 96, 1024, ws + WS_WUP, 256, 32)
        TR_SIMPLE(I5, a.in[I_AUP], 96, 1024, ws + WS_AUP, 256, 32)
        TR_SIMPLE(I6, a.in[I_GUP], 256, 1024, ws + WS_GUP, 256, 32)
        TR_SIMPLE(I7, a.in[I_W1K], 2048, 64, ws + WS_CW1K, 2048, 8)
        TR_SIMPLE(I8, a.in[I_W1V], 2048, 64, ws + WS_CW1V, 2048, 8)
#undef TR_SIMPLE
        (void)r;
    }
    const size_t gt = (size_t)F.bid * 512 + F.tid, NT = (size_t)F.G * 512;
    { const float* x = a.in[I_X]; bf16* xb = (bf16*)(ws + WS_XB);
      constexpr size_t NV = (size_t)M * D / 8;
      for (size_t i = gt; i < NV; i += 4 * NT) {
          f32x4 v0[4], v1[4];
#pragma unroll
          for (int q = 0; q < 4; ++q) { const size_t j = i + q * NT; if (j < NV) { v0[q] = __builtin_nontemporal_load((const f32x4*)(x + j * 8)); v1[q] = __builtin_nontemporal_load((const f32x4*)(x + j * 8 + 4)); } }
#pragma unroll
          for (int q = 0; q < 4; ++q) { const size_t j = i + q * NT; if (j < NV) { u32x4 o; o.x = pk2(v0[q].x, v0[q].y); o.y = pk2(v0[q].z, v0[q].w); o.z = pk2(v1[q].x, v1[q].y); o.w = pk2(v1[q].z, v1[q].w); *(u32x4*)(xb + j * 8) = o; } } } }
    { const float* p = a.in[I_P]; bf16* pb = (bf16*)(ws + WS_PB);
      for (size_t i = gt; i < (size_t)M * 256 / 8; i += NT) { const f32x4 v0 = *(const f32x4*)(p + i * 8), v1 = *(const f32x4*)(p + i * 8 + 4);
          u32x4 o; o.x = pk2(v0.x, v0.y); o.y = pk2(v0.z, v0.w); o.z = pk2(v1.x, v1.y); o.w = pk2(v1.z, v1.w); *(u32x4*)(pb + i * 8) = o; } }
    { int* rt = (int*)(ws + WS_ROWTOK); for (size_t i = gt; i < (size_t)MAXROWS; i += NT) rt[i] = 0; }
    if (gt < 192) ((int*)(ws + WS_BLKE + 4096))[gt] = (int)(gt >> 6);
    { const float* rw = a.in[I_RW]; bf16* rwt = (bf16*)(ws + WS_RWT);
      for (size_t i = gt; i < (size_t)32 * D; i += NT) { const int e = (int)(i >> 11), k = (int)(i & 2047); const float w = rw[(size_t)k * 32 + e]; const unsigned hi = f2bf(w); rwt[i] = (bf16)hi; rwt[(size_t)32 * D + i] = (bf16)f2bf(w - bf2f(hi)); } }
}

__device__ __forceinline__ void unpack8(const u32x4 w, float (&f)[8]) { f[0] = bflo(w.x); f[1] = bfhi(w.x); f[2] = bflo(w.y); f[3] = bfhi(w.y); f[4] = bflo(w.z); f[5] = bfhi(w.z); f[6] = bflo(w.w); f[7] = bfhi(w.w); }
__device__ __forceinline__ u32x4 pack8(const float (&f)[8]) { u32x4 o; o.x = pk2(f[0], f[1]); o.y = pk2(f[2], f[3]); o.z = pk2(f[4], f[5]); o.w = pk2(f[6], f[7]); return o; }
__device__ __forceinline__ void ld8f(const float* p, float (&f)[8]) { const f32x4 a = *(const f32x4*)p, b = *(const f32x4*)(p + 4); f[0] = a.x; f[1] = a.y; f[2] = a.z; f[3] = a.w; f[4] = b.x; f[5] = b.y; f[6] = b.z; f[7] = b.w; }
__device__ __forceinline__ void st8f(float* p, const float (&f)[8]) { *(f32x4*)p = (f32x4){f[0], f[1], f[2], f[3]}; *(f32x4*)(p + 4) = (f32x4){f[4], f[5], f[6], f[7]}; }
__device__ __forceinline__ float dpp_sum8(float x) {
    x += __builtin_bit_cast(float, __builtin_amdgcn_update_dpp(0, __builtin_bit_cast(int, x), 0xB1, 0xF, 0xF, true));
    x += __builtin_bit_cast(float, __builtin_amdgcn_update_dpp(0, __builtin_bit_cast(int, x), 0x4E, 0xF, 0xF, true));
    x += __builtin_bit_cast(float, __builtin_amdgcn_update_dpp(0, __builtin_bit_cast(int, x), 0x141, 0xF, 0xF, true));
    return x;
}
__device__ __forceinline__ void shift8(const bf16* Z, size_t zo, int c, bool has_prev, const float* mu, float (&o)[8]) {
    float zc[8], zp[8], m8[8];
    unpack8(*(const u32x4*)(Z + zo + c), zc);
    if (has_prev) unpack8(*(const u32x4*)(Z + zo - NZ + c), zp); else {
#pragma unroll
        for (int i = 0; i < 8; ++i) zp[i] = 0.f; }
    ld8f(mu + (c - ZRW), m8);
#pragma unroll
    for (int i = 0; i < 8; ++i) o[i] = zc[i] + (zp[i] - zc[i]) * m8[i];
}

__device__ __forceinline__ void p2_prep(Frame& F, const Args& a) {
    unsigned char* ws = F.ws;
    const bf16* Z = (const bf16*)(ws + WS_Z);
    const int gw = F.bid * 8 + F.wave, NGW = F.G * 8, lane = F.lane;
    for (int it = gw; it < 2 * 4096; it += NGW) {
        const int kv = it >> 12, row = it & 4095, g = row & 3, c = (row >> 2) & 255, b = row >> 10;
        bf16* dst = (bf16*)(ws + (kv ? WS_ACV : WS_ACK)) + (size_t)row * 2048;
        const float* pe = a.in[kv ? I_PEV : I_PEK];
        const int col0 = (kv ? ZVC : ZKC) + g * 64;
#pragma unroll
        for (int q = 0; q < 4; ++q) {
            const int idx = q * 64 + lane, i = idx >> 3, d8 = (idx & 7) * 8;
            u32x4 o = (u32x4){0u, 0u, 0u, 0u};
            if (c < NCMP) { float z8[8], p8[8]; unpack8(*(const u32x4*)(Z + (size_t)(b * T + 16 * c + i) * NZ + col0 + d8), z8); ld8f(pe + i * 64 + d8, p8);
#pragma unroll
                for (int e = 0; e < 8; ++e) z8[e] += p8[e];
                o = pack8(z8); }
            *(u32x4*)(dst + i * 64 + d8) = o;
        }
    }
    const float* mu = a.in[I_MU];
    bf16* WL = (bf16*)(ws + WS_WL); bf16* AL = (bf16*)(ws + WS_AL); bf16* GLS = (bf16*)(ws + WS_GLS);
    for (int m = gw; m < M; m += NGW) {
        const int t = m & (T - 1);
        float zs[8];
#pragma unroll
        for (int e = 0; e < 8; ++e) zs[e] = 0.f;
        if (lane < 56) shift8(Z, (size_t)m * NZ, ZWL + lane * 8, t != 0, mu, zs);
        if (lane < 32) { float o[8];
#pragma unroll
            for (int e = 0; e < 8; ++e) o[e] = lane < 12 ? tanhf(zs[e]) : 0.f;
            *(u32x4*)(WL + (size_t)m * 256 + lane * 8) = pack8(o); }
        if (lane >= 12 && lane < 44) { float o[8];
#pragma unroll
            for (int e = 0; e < 8; ++e) o[e] = lane < 24 ? zs[e] : 0.f;
            *(u32x4*)(AL + (size_t)m * 256 + (lane - 12) * 8) = pack8(o); }
        if (lane >= 24 && lane < 56) { float o[8];
#pragma unroll
            for (int e = 0; e < 8; ++e) o[e] = sigmoidf_(zs[e]);
            *(u32x4*)(GLS + (size_t)m * 256 + (lane - 24) * 8) = pack8(o); }
    }
}

__device__ __forceinline__ void p4_prep(Frame& F, const Args& a) {
    unsigned char* ws = F.ws;
    const int gw = F.bid * 8 + F.wave, NGW = F.G * 8, lane = F.lane;
    for (int it = gw; it < 2 * 4096; it += NGW) {
        const int kv = it >> 12, row = it & 4095;
        const float* H = (const float*)(ws + (kv ? WS_HCMPV : WS_HCMPK)) + (size_t)row * 64;
        const float* w2 = a.in[kv ? I_W2V : I_W2K];
        const float hv = gelu_tanh(H[lane] + H[(size_t)4096 * 64 + lane]); float o = 0.f;
#pragma unroll 8
        for (int j = 0; j < 64; ++j) o += __shfl(hv, j) * w2[j * 64 + lane];
        ((bf16*)(ws + (kv ? WS_VCMP : WS_KCMP)))[(size_t)row * 64 + lane] = (bf16)f2bf(o);
    }
    const bf16* Z = (const bf16*)(ws + WS_Z);
    const float* mu = a.in[I_MU]; const float* DEC = (const float*)(ws + WS_DEC); const float* ASIG = (const float*)(ws + WS_ASIG);
    const float* kk_w = a.in[I_KK]; const float* ka_w = a.in[I_KA];
    float* SC = (float*)(ws + WS_SC);
    for (int it = gw; it < M * 2; it += NGW) {
        const int m = it >> 1, half = it & 1, t = m & (T - 1), b = m >> 12, col = (half * 64 + lane) * 8, h = col >> 6, j8 = col & 63;
        const size_t zo = (size_t)m * NZ;
        float r[8], k[8], v[8], av[8], w[8], kkw[8], kaw[8];
        shift8(Z, zo, ZR + col, t != 0, mu, r); shift8(Z, zo, ZK + col, t != 0, mu, k); shift8(Z, zo, ZV + col, t != 0, mu, v);
        unpack8(*(const u32x4*)((const bf16*)ASIG + (size_t)m * 1024 + col), av); ld8f(DEC + (size_t)m * 1024 + col, w); ld8f(kk_w + col, kkw); ld8f(ka_w + col, kaw);
        float kk[8], ss = 0.f;
#pragma unroll
        for (int e = 0; e < 8; ++e) { kk[e] = k[e] * kkw[e]; ss += kk[e] * kk[e]; }
        const float inv = 1.0f / fmaxf(sqrtf(dpp_sum8(ss)), 1e-12f);
        float k2[8], na[8], bb[8];
#pragma unroll
        for (int e = 0; e < 8; ++e) { kk[e] *= inv; k2[e] = k[e] * (1.0f + (av[e] - 1.0f) * kaw[e]); na[e] = -kk[e]; bb[e] = kk[e] * av[e]; }
        { const size_t ti = (size_t)(b * 16 + h) * T + t; st8f(SC + ti * 64 + j8, w);
          bf16* sb16 = (bf16*)(ws + WS_SC + (size_t)64 * MiB) + ti * 320 + j8;
          *(u32x4*)(sb16) = pack8(r); *(u32x4*)(sb16 + 64) = pack8(k2); *(u32x4*)(sb16 + 128) = pack8(v); *(u32x4*)(sb16 + 192) = pack8(na); *(u32x4*)(sb16 + 256) = pack8(bb); }
        { float rk8[8], sb = 0.f; ld8f(a.in[I_RK] + col, rk8);
#pragma unroll
          for (int e = 0; e < 8; ++e) sb += r[e] * k2[e] * rk8[e];
          const float bonus = dpp_sum8(sb); float bv[8];
#pragma unroll
          for (int e = 0; e < 8; ++e) bv[e] = bonus * v[e];
          *(u32x4*)((bf16*)(ws + WS_ACK) + (size_t)m * 1024 + col) = pack8(bv); }
    }
}

__device__ __forceinline__ float dpp_sum16(float x) {
    x += __builtin_bit_cast(float, __builtin_amdgcn_update_dpp(0, __builtin_bit_cast(int, x), 0xB1, 0xF, 0xF, true));
    x += __builtin_bit_cast(float, __builtin_amdgcn_update_dpp(0, __builtin_bit_cast(int, x), 0x4E, 0xF, 0xF, true));
    x += __builtin_bit_cast(float, __builtin_amdgcn_update_dpp(0, __builtin_bit_cast(int, x), 0x141, 0xF, 0xF, true));
    x += __builtin_bit_cast(float, __builtin_amdgcn_update_dpp(0, __builtin_bit_cast(int, x), 0x140, 0xF, 0xF, true));
    return x;
}
__device__ __forceinline__ void p5_scan_conv(Frame& F, const Args& a, int mode) {
#ifndef SCAN_TC
#define SCAN_TC 32
#endif
    constexpr int TC = SCAN_TC, CHF = TC * 384, NLD = CHF / 1024;
    LAS float* buf = (LAS float*)F.lds;
    LAS unsigned* cnt = (LAS unsigned*)(F.lds + 2 * CHF * 4);
    const int tid = F.tid, lane = F.lane, wave = F.wave;
    if (tid == 0) *cnt = 0u;
    __syncthreads();
    if (wave < 4) { if (mode & 1) {
        const float* SC = (const float*)(F.ws + WS_SC);
        float* Y = (float*)(F.ws + WS_Y);
        const int kq = lane & 15, rl = lane >> 4;
        unsigned target = 0u;
        __builtin_amdgcn_s_setprio(3);
#define BAR4() do { LDS_WAIT(); asm volatile("" ::: "memory"); target += 4u; if (lane == 0) __hip_atomic_fetch_add(cnt, 1u, __ATOMIC_RELAXED, __HIP_MEMORY_SCOPE_WORKGROUP); \
        while (__hip_atomic_load(cnt, __ATOMIC_RELAXED, __HIP_MEMORY_SCOPE_WORKGROUP) < target) __builtin_amdgcn_s_sleep(1); asm volatile("" ::: "memory"); } while (0)
        for (int task = F.bid; task < 256; task += F.G) {
            const int bh = task >> 2, quarter = task & 3, b = bh >> 4, h = bh & 15;
            const int row = (quarter * 4 + wave) * 4 + rl;
            static_assert(TC == 32, "the compact staging below is written for 32-step chunks");
            const float* srcw = SC + (size_t)bh * T * 64;
            const bf16* srcb = (const bf16*)(F.ws + WS_SC + (size_t)64 * MiB) + (size_t)bh * T * 320;
            int wofs[2], bofs[5];
#pragma unroll
            for (int i = 0; i < 2; ++i) { const int p = tid + 256 * i; wofs[i] = (p >> 4) * 384 + 64 + (p & 15) * 4; }
#pragma unroll
            for (int i = 0; i < 5; ++i) { const int p = tid + 256 * i, tt = p / 40, q = p - tt * 40, comp = q >> 3; bofs[i] = tt * 384 + (comp == 0 ? 0 : 64 + 64 * comp) + (q & 7) * 8; }
#define SCAN_STAGE_LOAD(cc) do { _Pragma("unroll") for (int i = 0; i < 2; ++i) nw[i] = *(const f32x4*)(srcw + (size_t)(cc) * TC * 64 + (size_t)(tid + 256 * i) * 4); \
                _Pragma("unroll") for (int i = 0; i < 5; ++i) nb[i] = *(const u32x4*)(srcb + (size_t)(cc) * TC * 320 + (size_t)(tid + 256 * i) * 8); } while (0)
#define SCAN_STAGE_STORE(bufp) do { _Pragma("unroll") for (int i = 0; i < 2; ++i) *(LAS f32x4*)((bufp) + wofs[i]) = nw[i]; \
                _Pragma("unroll") for (int i = 0; i < 5; ++i) { *(LAS f32x4*)((bufp) + bofs[i]) = (f32x4){bflo(nb[i].x), bfhi(nb[i].x), bflo(nb[i].y), bfhi(nb[i].y)}; \
                    *(LAS f32x4*)((bufp) + bofs[i] + 4) = (f32x4){bflo(nb[i].z), bfhi(nb[i].z), bflo(nb[i].w), bfhi(nb[i].w)}; } } while (0)
            f32x4 nw[2]; u32x4 nb[5];
            BAR4();
            SCAN_STAGE_LOAD(0); SCAN_STAGE_STORE(buf);
            BAR4();
            f32x4 S = (f32x4){0.f, 0.f, 0.f, 0.f};
            for (int c = 0; c < T / TC; ++c) {
                const bool more = (c + 1 < T / TC);
                if (more) SCAN_STAGE_LOAD(c + 1);
                const LAS float* cb = buf + (c & 1) * CHF;
                f32x4 r4[2], w4[2], k4[2], a4[2], b4[2]; float vv[2];
                r4[0] = *(const LAS f32x4*)(cb + kq * 4); w4[0] = *(const LAS f32x4*)(cb + 64 + kq * 4); k4[0] = *(const LAS f32x4*)(cb + 128 + kq * 4);
                a4[0] = *(const LAS f32x4*)(cb + 256 + kq * 4); b4[0] = *(const LAS f32x4*)(cb + 320 + kq * 4); vv[0] = cb[192 + row];
                float ykeep[TC / 16], yprev = 0.f;
#pragma unroll
                for (int q = 0; q < TC / 16; ++q) ykeep[q] = 0.f;
#pragma unroll
                for (int tt = 0; tt < TC; ++tt) {
                    const int cu = tt & 1, nx1 = cu ^ 1;
                    if (tt + 1 < TC) { const LAS float* sp = cb + (tt + 1) * 384;
                        r4[nx1] = *(const LAS f32x4*)(sp + kq * 4); w4[nx1] = *(const LAS f32x4*)(sp + 64 + kq * 4); k4[nx1] = *(const LAS f32x4*)(sp + 128 + kq * 4);
                        a4[nx1] = *(const LAS f32x4*)(sp + 256 + kq * 4); b4[nx1] = *(const LAS f32x4*)(sp + 320 + kq * 4); vv[nx1] = sp[192 + row]; }
                    __builtin_amdgcn_sched_barrier(0);
                    float sa = (S.x * a4[cu].x + S.y * a4[cu].y) + (S.z * a4[cu].z + S.w * a4[cu].w);
                    sa = dpp_sum16(sa);
                    if (tt > 0) { const float yr = dpp_sum16(yprev); ykeep[(tt - 1) >> 4] = (kq == ((tt - 1) & 15)) ? yr : ykeep[(tt - 1) >> 4]; }
                    S = S * w4[cu] + sa * b4[cu] + vv[cu] * k4[cu];
                    yprev = (S.x * r4[cu].x + S.y * r4[cu].y) + (S.z * r4[cu].z + S.w * r4[cu].w);
                    __builtin_amdgcn_sched_barrier(0);
                }
                { const float yr = dpp_sum16(yprev); ykeep[(TC - 1) >> 4] = (kq == ((TC - 1) & 15)) ? yr : ykeep[(TC - 1) >> 4]; }
#pragma unroll
                for (int q = 0; q < TC / 16; ++q) Y[((size_t)(b * T) + c * TC + 16 * q + kq) * 1024 + h * 64 + row] = ykeep[q];
                if (more) SCAN_STAGE_STORE(buf + ((c + 1) & 1) * CHF);
                BAR4();
            }
        }
#undef BAR4
#undef SCAN_STAGE_LOAD
#undef SCAN_STAGE_STORE
        __builtin_amdgcn_s_setprio(0);
    } } else if (mode & 2) {
        unsigned char* ws = F.ws;
        const int gw = F.bid * 4 + (wave - 4), NGW = F.G * 4;
        constexpr int NIT = NE * 3 * 1024;
        f32x4 va[16], vb[16];
        int it = gw;
        CvItem ca = cv_decode(a, ws, it < NIT ? it : 0), cb = ca;
        if (it < NIT) cv_load(ca, va, lane);
        for (; it < NIT; it += 2 * NGW) {
            const int it1 = it + NGW, it2 = it + 2 * NGW;
            if (it1 < NIT) { cb = cv_decode(a, ws, it1); cv_load(cb, vb, lane); }
            cv_store(ca, va, lane);
            if (it1 < NIT) {
                if (it2 < NIT) { ca = cv_decode(a, ws, it2); cv_load(ca, va, lane); }
                cv_store(cb, vb, lane);
            }
        }
    }
    __syncthreads();
}

__device__ __forceinline__ void softmax_lds(LAS float* ps, int nk, int lane) {
    float mx = -INFINITY;
    for (int i = lane; i < nk; i += 64) mx = fmaxf(mx, ps[i]);
    mx = wave_max(mx);
    if (mx == -INFINITY) { for (int i = lane; i < nk; i += 64) ps[i] = 0.f; LDS_WAIT(); return; }
    float sum = 0.f;
    for (int i = lane; i < nk; i += 64) { const float e = __expf(ps[i] - mx); ps[i] = e; sum += e; }
    sum = wave_sum(sum);
    const float inv = 1.0f / fmaxf(sum, 1e-30f);
    for (int i = lane; i < nk; i += 64) ps[i] *= inv;
    LDS_WAIT();
}
__device__ __forceinline__ float dot64(const LAS float* q, const bf16* krow) {
    float s = 0.f;
#pragma unroll
    for (int j = 0; j < 8; ++j) { const u32x4 kv = *(const u32x4*)(krow + 8 * j); const f32x4 q0 = *(const LAS f32x4*)(q + 8 * j), q1 = *(const LAS f32x4*)(q + 8 * j + 4);
        s += q0.x * bflo(kv.x) + q0.y * bfhi(kv.x) + q0.z * bflo(kv.y) + q0.w * bfhi(kv.y) + q1.x * bflo(kv.z) + q1.y * bfhi(kv.z) + q1.z * bflo(kv.w) + q1.w * bfhi(kv.w); }
    return s;
}
__device__ __forceinline__ void p5_attn_naive(Frame& F) {
    unsigned char* ws = F.ws;
    const bf16* Z = (const bf16*)(ws + WS_Z);
    const bf16* KC = (const bf16*)(ws + WS_KCMP); const bf16* VC = (const bf16*)(ws + WS_VCMP);
    bf16* CAT = (bf16*)(ws + WS_CAT);
    const int lane = F.lane, gw = F.bid * 8 + F.wave, NGW = F.G * 8;
    LAS float* qs = (LAS float*)(F.lds + F.wave * 5120);
    LAS float* ps = qs + 256;
    for (int it = gw; it < NB * 4 * T; it += NGW) {
        const int t = it & (T - 1), g = (it >> 12) & 3, b = it >> 14, m = b * T + t, cur = t >> 6;
        const size_t zo = (size_t)m * NZ;
#pragma unroll
        for (int r = 0; r < 4; ++r) qs[r * 64 + lane] = bf2f(Z[zo + ZQ + (4 * g + r) * 64 + lane]);
        LDS_WAIT();
        float imp = 0.f, oacc[4];
        const int ncv = t >= 31 ? ((t - 31) >> 4) + 1 : 0;
#pragma unroll
        for (int r = 0; r < 4; ++r) {
            const int h = 4 * g + r; const float slope = exp2f(-0.5f * (float)(h + 1));
#pragma unroll
            for (int ch = 0; ch < 4; ++ch) { const int c = ch * 64 + lane; float s = -INFINITY;
                if (c < ncv) s = dot64(qs + r * 64, KC + ((size_t)(b * 256 + c) * 4 + g) * 64) * 0.125f - slope * (float)(t - (16 * c + 31));
                ps[c] = s; }
            LDS_WAIT();
            softmax_lds(ps, 256, lane);
            float o = 0.f;
            for (int c = 0; c < ncv; ++c) o += ps[c] * bf2f(VC[((size_t)(b * 256 + c) * 4 + g) * 64 + lane]);
            { const int j = lane; float v = 32.0f * (ps[4 * j] + ps[4 * j + 1] + ps[4 * j + 2]);
              if (j > 0) v += 16.0f * ps[4 * j - 1];
              v += 16.0f * ps[4 * j + 3];
              imp += v; }
            oacc[r] = sigmoidf_(bf2f(Z[zo + ZGL + h * 3 + 0])) * o;
            LDS_WAIT();
        }
        float v = imp;
        if (lane == 0 || lane == cur || lane == cur - 1) v = INFINITY; else if (lane > cur) v = -INFINITY;
        int rank = 0;
        for (int jj = 0; jj < 64; ++jj) { const float vv = __shfl(v, jj); rank += (vv > v || (vv == v && jj < lane)) ? 1 : 0; }
        const unsigned long long selmask = __ballot(rank < 16) & (cur >= 63 ? ~0ull : ((1ull << (cur + 1)) - 1ull));
#pragma unroll
        for (int r = 0; r < 4; ++r) {
            const int h = 4 * g + r; const float slope = exp2f(-0.5f * (float)(h + 1));
            int n = 0;
            for (unsigned long long mm = selmask; mm; mm &= mm - 1, ++n) { const int j = __builtin_ctzll(mm); const int pos = 64 * j + lane; float s = -INFINITY;
                if (pos <= t) s = dot64(qs + r * 64, Z + (size_t)(b * T + pos) * NZ + ZKS + g * 64) * 0.125f - slope * (float)(t - pos);
                ps[n * 64 + lane] = s; }
            LDS_WAIT();
            softmax_lds(ps, n * 64, lane);
            float o = 0.f; n = 0;
            for (unsigned long long mm = selmask; mm; mm &= mm - 1, ++n) { const int j = __builtin_ctzll(mm);
                const int lim = (64 * j + 63 <= t) ? 64 : (t - 64 * j + 1);
                const bf16* vb = Z + (size_t)(b * T + 64 * j) * NZ + ZVS + g * 64 + lane;
                for (int i = 0; i < lim; ++i) o += ps[n * 64 + i] * bf2f(vb[(size_t)i * NZ]); }
            oacc[r] += sigmoidf_(bf2f(Z[zo + ZGL + h * 3 + 1])) * o;
            LDS_WAIT();
        }
#pragma unroll
        for (int r = 0; r < 4; ++r) {
            const int h = 4 * g + r; const float slope = exp2f(-0.5f * (float)(h + 1));
#pragma unroll
            for (int ch = 0; ch < 8; ++ch) { const int pos = t - 511 + ch * 64 + lane; float s = -INFINITY;
                if (pos >= 0) s = dot64(qs + r * 64, Z + (size_t)(b * T + pos) * NZ + ZKW + g * 64) * 0.125f - slope * (float)(t - pos);
                ps[ch * 64 + lane] = s; }
            LDS_WAIT();
            softmax_lds(ps, 512, lane);
            float o = 0.f;
            const int i0 = t >= 511 ? 0 : 511 - t;
            const bf16* vb = Z + ZVW + g * 64 + lane;
            for (int i = i0; i < 512; ++i) o += ps[i] * bf2f(vb[(size_t)(b * T + t - 511 + i) * NZ]);
            oacc[r] += sigmoidf_(bf2f(Z[zo + ZGL + h * 3 + 2])) * o;
            CAT[(size_t)m * D + h * 64 + lane] = (bf16)f2bf(oacc[r]);
            LDS_WAIT();
        }
    }
}

namespace nsa {
typedef short bf16x8 __attribute__((ext_vector_type(8)));
typedef float f32x16 __attribute__((ext_vector_type(16)));
typedef __bf16 bf2_t __attribute__((ext_vector_type(2)));
typedef float f2_t __attribute__((ext_vector_type(2)));
__device__ __forceinline__ unsigned pkbf(float a, float b) { f2_t v; v.x = a; v.y = b; return __builtin_bit_cast(unsigned, __builtin_convertvector(v, bf2_t)); }
constexpr int KP = 144, TILE_B = 64 * KP;
constexpr int IMP_LD = 65;
constexpr int L_IMP = 8 * TILE_B;
constexpr int L_INVL = L_IMP + 4 * 64 * IMP_LD * 4;
constexpr int L_SEL = L_INVL + 1024;
constexpr int L_UNI = L_SEL + 512;
constexpr int L_UNIT = L_UNI + 64;
static_assert(L_UNIT + 64 <= LDS_MISC, "attention LDS map");
constexpr float LOG2E = 1.4426950408889634f, SCL = 0.125f * LOG2E, NEGBIG = -1e30f;

struct StageRegs { u32x4 k, v; };
__device__ __forceinline__ void stage_load(StageRegs& r, const bf16* kb, const bf16* vb, size_t pitch, int tid) {
    const int key = tid >> 3, ch = tid & 7;
    r.k = *(const u32x4*)(kb + (size_t)key * pitch + ch * 8);
    r.v = *(const u32x4*)(vb + (size_t)key * pitch + ch * 8);
}
__device__ __forceinline__ void stage_store(const StageRegs& r, LAS unsigned char* lds, int slot, int tid) {
    const int key = tid >> 3, ch = tid & 7;
    *(LAS u32x4*)(lds + slot * TILE_B + key * KP + ch * 16) = r.k;
    const int kl = key & 15, vpos = (key & 48) + (kl & 3) + 4 * (kl >> 3) + 8 * ((kl >> 2) & 1);
    LAS unsigned char* vp = lds + (4 + slot) * TILE_B + (ch * 8) * KP + vpos * 2;
#pragma unroll
    for (int e = 0; e < 8; ++e) { const unsigned w = r.v[e >> 1]; *(LAS unsigned short*)(vp + e * KP) = (unsigned short)((e & 1) ? (w >> 16) : (w & 0xffffu)); }
}
template <int MODE>
__device__ __forceinline__ void tile_core(const LAS unsigned char* Kl, const LAS unsigned char* Vl, const bf16x8 (&qf)[4], const float (&bias)[16], float sl32, f32x16 (&O)[2], float& m, float& l,
                                          float off, bool need_mask, bool use_lo, int lo, int hi, bool lv, int lane, float (&p)[2][16]) {
    const int n = lane & 31, h = lane >> 5;
    f32x16 st[2];
#pragma unroll
    for (int kt = 0; kt < 2; ++kt) {
#pragma unroll
        for (int i = 0; i < 16; ++i) st[kt][i] = 0.f;
#pragma unroll
        for (int s = 0; s < 4; ++s) { const bf16x8 a = *(const LAS bf16x8*)(Kl + (32 * kt + n) * KP + (16 * s + 8 * h) * 2); st[kt] = __builtin_amdgcn_mfma_f32_32x32x16_bf16(a, qf[s], st[kt], 0, 0, 0); }
    }
#pragma unroll
    for (int kt = 0; kt < 2; ++kt)
#pragma unroll
        for (int i = 0; i < 16; ++i) p[kt][i] = fmaf(st[kt][i], SCL, bias[i]);
    if (need_mask) {
#pragma unroll
        for (int kt = 0; kt < 2; ++kt)
#pragma unroll
            for (int i = 0; i < 16; ++i) { const int c = 32 * kt + (i & 3) + 8 * (i >> 2); p[kt][i] = (c <= hi) ? p[kt][i] : -INFINITY; }
        if (use_lo) {
#pragma unroll
            for (int kt = 0; kt < 2; ++kt)
#pragma unroll
                for (int i = 0; i < 16; ++i) { const int c = 32 * kt + (i & 3) + 8 * (i >> 2); p[kt][i] = (c >= lo) ? p[kt][i] : -INFINITY; }
        }
    }
    float mrel;
    if constexpr (MODE != 1) {
        float tm0 = p[0][0], tm1 = p[1][0];
#pragma unroll
        for (int i = 1; i < 16; ++i) { tm0 = fmaxf(tm0, p[0][i]); tm1 = fmaxf(tm1, p[1][i]); }
        float tm = fmaxf(tm0, tm1 + sl32);
        tm = lv ? tm : -INFINITY;
        { const auto sw_ = __builtin_amdgcn_permlane32_swap(__float_as_uint(tm), __float_as_uint(tm), false, false); tm = fmaxf(__uint_as_float(sw_[0]), __uint_as_float(sw_[1])); }
        const float mn = fmaxf(m, tm + off);
        if constexpr (MODE == 0) { m = mn; return; }
        const float alpha = __builtin_amdgcn_exp2f(m - mn);
        m = mn; l *= alpha; O[0] = O[0] * alpha; O[1] = O[1] * alpha;
        mrel = lv ? mn - off : INFINITY;
    } else mrel = m - off;
    float ps = 0.f;
#pragma unroll
    for (int kt = 0; kt < 2; ++kt)
#pragma unroll
        for (int i = 0; i < 16; ++i) { p[kt][i] = __builtin_amdgcn_exp2f(p[kt][i] - (kt ? mrel - sl32 : mrel)); ps += p[kt][i]; }
    l += ps;
#pragma unroll
    for (int g16 = 0; g16 < 4; ++g16) {
        const int kt = g16 >> 1, s8 = (g16 & 1) * 8;
        u32x4 pw; pw.x = pkbf(p[kt][s8 + 0], p[kt][s8 + 1]); pw.y = pkbf(p[kt][s8 + 2], p[kt][s8 + 3]); pw.z = pkbf(p[kt][s8 + 4], p[kt][s8 + 5]); pw.w = pkbf(p[kt][s8 + 6], p[kt][s8 + 7]);
        const bf16x8 pb = __builtin_bit_cast(bf16x8, pw);
#pragma unroll
        for (int dt = 0; dt < 2; ++dt) { const bf16x8 a = *(const LAS bf16x8*)(Vl + (32 * dt + n) * KP + (16 * g16 + 8 * h) * 2); O[dt] = __builtin_amdgcn_mfma_f32_32x32x16_bf16(a, pb, O[dt], 0, 0, 0); }
    }
}
__device__ __forceinline__ void set_bias(float (&bias)[16], float sl, int h) {
#pragma unroll
    for (int i = 0; i < 16; ++i) bias[i] = sl * (float)((i & 3) + 8 * (i >> 2) + 4 * h);
}

__device__ __forceinline__ void attn_phase(Frame& F, int rep) {
    unsigned char* ws = F.ws;
    const bf16* Z = (const bf16*)(ws + WS_Z);
    const bf16* KC = (const bf16*)(ws + WS_KCMP); const bf16* VC = (const bf16*)(ws + WS_VCMP);
    bf16* CAT = (bf16*)(ws + WS_CAT);
    LAS unsigned char* lds = F.lds;
    LAS float* imph = (LAS float*)(lds + L_IMP); LAS float* invl = (LAS float*)(lds + L_INVL);
    LAS unsigned long long* selm = (LAS unsigned long long*)(lds + L_SEL); LAS unsigned long long* unis = (LAS unsigned long long*)(lds + L_UNI);
    unsigned* ctr = (unsigned*)(ws + WS_CTL) + CW_ATTNQ + 64 * rep;
    const int tid = F.tid, lane = F.lane, wave = F.wave, n = lane & 31, h = lane >> 5, r = wave >> 1, th = wave & 1, tq = 32 * th + n;
    for (;;) {
        __syncthreads();
        if (tid == 0) *(LAS int*)(lds + L_UNIT) = (int)atomicAdd(ctr, 1u);
        __syncthreads();
        const int u = *(LAS int*)(lds + L_UNIT);
        if (u >= NB * 4 * 64) break;
        const int qt = 63 - (u >> 4), b = (u >> 2) & 3, g = u & 3, t0 = 64 * qt, head = 4 * g + r, t = t0 + tq;
        const size_t zrow = (size_t)(b * T + t) * NZ;
        bf16x8 qf[4];
#pragma unroll
        for (int s = 0; s < 4; ++s) qf[s] = *(const bf16x8*)(Z + zrow + ZQ + head * 64 + 16 * s + 8 * h);
        const float slope2 = exp2f(-0.5f * (float)(head + 1)) * LOG2E;
        const float g0 = sigmoidf_(bf2f(Z[zrow + ZGL + head * 3 + 0])), g1 = sigmoidf_(bf2f(Z[zrow + ZGL + head * 3 + 1])), g2 = sigmoidf_(bf2f(Z[zrow + ZGL + head * 3 + 2]));
        const int ncmax = (4 * qt + 3) < NCMP ? (4 * qt + 3) : NCMP, ntc = (ncmax + 63) >> 6;
        for (int tau = 0; tau < ntc; ++tau) { StageRegs sr; const size_t ro = ((size_t)(b * 256 + 64 * tau) * 4 + g) * 64; stage_load(sr, KC + ro, VC + ro, 256, tid); stage_store(sr, lds, tau, tid); }
        __syncthreads();
        float bias[16], p[2][16];
        f32x16 O[2];
        set_bias(bias, slope2 * 16.0f, h);
        float sl32 = slope2 * 512.0f;
        const int ncv = t >= 31 ? ((t - 31) >> 4) + 1 : 0;
        float m = NEGBIG, l = 0.f;
#pragma unroll
        for (int i = 0; i < 16; ++i) { O[0][i] = 0.f; O[1][i] = 0.f; }
        for (int tau = 0; tau < ntc; ++tau)
            tile_core<0>(lds + tau * TILE_B, lds + (4 + tau) * TILE_B, qf, bias, sl32, O, m, l, slope2 * (float)(1024 * tau + 31 - t), true, false, 0, ncv - 1 - 64 * tau - 4 * h, true, lane, p);
        float carry = 0.f;
        for (int tau = 0; tau < ntc; ++tau) {
            tile_core<1>(lds + tau * TILE_B, lds + (4 + tau) * TILE_B, qf, bias, sl32, O, m, l, slope2 * (float)(1024 * tau + 31 - t), true, false, 0, ncv - 1 - 64 * tau - 4 * h, true, lane, p);
            float recv[8];
#pragma unroll
            for (int f = 0; f < 8; ++f) recv[f] = __shfl_xor(16.0f * p[f >> 2][4 * (f & 3) + 3], 32);
#pragma unroll
            for (int f = 0; f < 8; ++f) { const int kt = f >> 2, q4 = f & 3;
                const float gsum = 32.0f * (p[kt][4 * q4] + p[kt][4 * q4 + 1] + p[kt][4 * q4 + 2]) + 16.0f * p[kt][4 * q4 + 3];
                const float prev0 = (f == 0) ? carry : recv[f == 0 ? 0 : f - 1];
                const float prev = h ? recv[f] : prev0;
                imph[(r * 64 + tq) * IMP_LD + 16 * tau + 8 * kt + 2 * q4 + h] = gsum + prev; }
            carry = recv[7];
        }
        { const float lt = l + __shfl_xor(l, 32); const float inv = 1.0f / fmaxf(lt, 1e-30f); if (h == 0) invl[r * 64 + tq] = inv; O[0] = O[0] * (inv * g0); O[1] = O[1] * (inv * g0); }
        __syncthreads();
        { unsigned long long uw = 0ull; const unsigned long long vmask = qt >= 63 ? ~0ull : ((1ull << (qt + 1)) - 1ull);
          for (int qq = 0; qq < 8; ++qq) { const int q = 8 * wave + qq;
              float v = 0.f;
#pragma unroll
              for (int rr = 0; rr < 4; ++rr) v += imph[(rr * 64 + q) * IMP_LD + lane] * invl[rr * 64 + q];
              if (lane == 0 || lane == qt || lane == qt - 1) v = INFINITY; else if (lane > qt) v = -INFINITY;
              int rank = 0;
#pragma unroll
              for (int jj = 0; jj < 64; ++jj) { const float vv = __shfl(v, jj); rank += (vv > v || (vv == v && jj < lane)) ? 1 : 0; }
              const unsigned long long mk = __ballot(rank < 16) & vmask;
              if (lane == 0) selm[q] = mk;
              uw |= mk; }
          if (lane == 0) unis[wave] = uw; }
        __syncthreads();
        unsigned long long uni = 0ull;
#pragma unroll
        for (int w8 = 0; w8 < 8; ++w8) uni |= unis[w8];
        uni = __builtin_amdgcn_readfirstlane((unsigned)uni) | ((unsigned long long)__builtin_amdgcn_readfirstlane((unsigned)(uni >> 32)) << 32);
        const unsigned long long selq = selm[tq];
        LAS float* oacc = (LAS float*)(lds + L_IMP) + wave * 2048 + lane;
#pragma unroll
        for (int i = 0; i < 16; ++i) { oacc[i * 64] = O[0][i]; oacc[(16 + i) * 64] = O[1][i]; }
        set_bias(bias, slope2, h); sl32 = slope2 * 32.0f;
        m = NEGBIG; l = 0.f;
#pragma unroll
        for (int i = 0; i < 16; ++i) { O[0][i] = 0.f; O[1][i] = 0.f; }
        {
            unsigned long long mm = uni; int j = __builtin_ctzll(mm); mm &= mm - 1; int cb = 0;
            { StageRegs sr; const bf16* kb = Z + (size_t)(b * T + 64 * j) * NZ + g * 64; stage_load(sr, kb + ZKS, kb + ZVS, NZ, tid); stage_store(sr, lds, 0, tid); }
            __syncthreads();
            for (;;) {
                const bool more = mm != 0ull; int jn = 0; StageRegs sr;
                if (more) { jn = __builtin_ctzll(mm); mm &= mm - 1; const bf16* kb = Z + (size_t)(b * T + 64 * jn) * NZ + g * 64; stage_load(sr, kb + ZKS, kb + ZVS, NZ, tid); }
                const bool lv = (selq >> j) & 1ull; const bool diag = (j == qt);
                tile_core<2>(lds + cb * TILE_B, lds + (4 + cb) * TILE_B, qf, bias, sl32, O, m, l, slope2 * (float)(64 * j - t), diag, false, 0, tq - 4 * h, lv, lane, p);
                if (more) stage_store(sr, lds, cb ^ 1, tid);
                __syncthreads();
                if (!more) break;
                j = jn; cb ^= 1;
            }
        }
        { const float lt = l + __shfl_xor(l, 32); const float inv = 1.0f / fmaxf(lt, 1e-30f) * g1;
#pragma unroll
          for (int i = 0; i < 16; ++i) { oacc[i * 64] += O[0][i] * inv; oacc[(16 + i) * 64] += O[1][i] * inv; } }
        m = NEGBIG; l = 0.f;
#pragma unroll
        for (int i = 0; i < 16; ++i) { O[0][i] = 0.f; O[1][i] = 0.f; }
        {
            int j = qt >= 8 ? qt - 8 : 0; int cb = 0;
            { StageRegs sr; const bf16* kb = Z + (size_t)(b * T + 64 * j) * NZ + g * 64; stage_load(sr, kb + ZKW, kb + ZVW, NZ, tid); stage_store(sr, lds, 0, tid); }
            __syncthreads();
            for (;;) {
                const bool more = j < qt; StageRegs sr;
                if (more) { const bf16* kb = Z + (size_t)(b * T + 64 * (j + 1)) * NZ + g * 64; stage_load(sr, kb + ZKW, kb + ZVW, NZ, tid); }
                const bool left = (j == qt - 8), diag = (j == qt);
                const int lo = (left ? tq + 1 : -1000) - 4 * h, hi = (diag ? tq : 1000) - 4 * h;
                tile_core<2>(lds + cb * TILE_B, lds + (4 + cb) * TILE_B, qf, bias, sl32, O, m, l, slope2 * (float)(64 * j - t), left || diag, left, lo, hi, true, lane, p);
                if (more) stage_store(sr, lds, cb ^ 1, tid);
                __syncthreads();
                if (!more) break;
                ++j; cb ^= 1;
            }
        }
        { const float lt = l + __shfl_xor(l, 32); const float inv = 1.0f / fmaxf(lt, 1e-30f) * g2;
#pragma unroll
          for (int i = 0; i < 16; ++i) { O[0][i] = oacc[i * 64] + O[0][i] * inv; O[1][i] = oacc[(16 + i) * 64] + O[1][i] * inv; } }
        bf16* orow = CAT + (size_t)(b * T + t) * D + head * 64;
#pragma unroll
        for (int dt = 0; dt < 2; ++dt)
#pragma unroll
            for (int q4 = 0; q4 < 4; ++q4) { u32x2 w; w.x = pkbf(O[dt][4 * q4], O[dt][4 * q4 + 1]); w.y = pkbf(O[dt][4 * q4 + 2], O[dt][4 * q4 + 3]); *(u32x2*)(orow + 32 * dt + 8 * q4 + 4 * h) = w; }
    }
    __syncthreads();
}
}

__device__ __forceinline__ void p6_rwkv_out(Frame& F, const Args& a) {
    unsigned char* ws = F.ws;
    const float* Y = (const float*)(ws + WS_Y); const float* SC = (const float*)(ws + WS_SC); const float* G = (const float*)(ws + WS_G);
    const float* rk = a.in[I_RK]; const float* lng = a.in[I_LNG]; const float* lnb = a.in[I_LNB];
    bf16* CAT = (bf16*)(ws + WS_CAT);
    const int lane = F.lane, gw = F.bid * 8 + F.wave, NGW = F.G * 8;
    for (int it = gw; it < M * 2; it += NGW) {
        const int m = it >> 1, half = it & 1, t = m & (T - 1), b = m >> 12, col = (half * 64 + lane) * 8, h = col >> 6, j8 = col & 63;
        float y[8], bv[8], gg[8], lg8[8], lb8[8];
        ld8f(Y + (size_t)m * 1024 + col, y);
        unpack8(*(const u32x4*)((const bf16*)(ws + WS_ACK) + (size_t)m * 1024 + col), bv); unpack8(*(const u32x4*)((const bf16*)(ws + WS_G) + (size_t)m * 1024 + col), gg);
        ld8f(lng + col, lg8); ld8f(lnb + col, lb8);
        float s1 = 0.f;
#pragma unroll
        for (int e = 0; e < 8; ++e) s1 += y[e];
        const float mean = dpp_sum8(s1) * (1.0f / 64.0f);
        float s2 = 0.f;
#pragma unroll
        for (int e = 0; e < 8; ++e) { y[e] -= mean; s2 += y[e] * y[e]; }
        const float rstd = rsqrtf(dpp_sum8(s2) * (1.0f / 64.0f) + GN_EPS);
        float o[8];
#pragma unroll
        for (int e = 0; e < 8; ++e) o[e] = (y[e] * rstd * lg8[e] + lb8[e] + bv[e]) * gg[e];
        *(u32x4*)(CAT + (size_t)m * D + 1024 + col) = pack8(o);
    }
}

__device__ __forceinline__ void p8_ln_router(Frame& F, const Args& a) {
    typedef short bf16x8_t __attribute__((ext_vector_type(8)));
    unsigned char* ws = F.ws;
    const float* PRE = F.out; float* H1 = (float*)(ws + WS_H1); unsigned char* H1Q = (unsigned char*)(ws + WS_H1B);
    const float* g1 = a.in[I_LN1G]; const float* b1 = a.in[I_LN1B]; const float* rb = a.in[I_RB];
    const bf16* RWT = (const bf16*)(ws + WS_RWT);
    int* TOPE = (int*)(ws + WS_TOPE); float* TOPW = (float*)(ws + WS_TOPW); int* SLOT = (int*)(ws + WS_SLOT); int* HIST = (int*)(ws + WS_HIST);
    const int lane = F.lane, wave = F.wave, tid = F.tid;
    LAS float* part = (LAS float*)F.lds;
    LAS int* es = (LAS int*)(F.lds + 2 * 64 * 33 * 4);
    for (int ch = F.bid; ch < M / 64; ch += F.G) {
        {
            const int tb = 16 * (wave & 3), kh = wave >> 2, row = lane & 15, g = lane >> 4;
            const int m = ch * 64 + tb + row;
            const float* xp = PRE + (size_t)m * D + kh * 1024 + 8 * g;
            float s1 = 0.f, s2 = 0.f;
#pragma unroll 8
            for (int ks = 0; ks < 32; ++ks) { float x[8]; ld8f(xp + 32 * ks, x);
#pragma unroll
                for (int e = 0; e < 8; ++e) { s1 += x[e]; s2 += x[e] * x[e]; } }
            { auto q = __builtin_amdgcn_permlane16_swap(__float_as_uint(s1), __float_as_uint(s1), false, false); s1 = __uint_as_float(q[0]) + __uint_as_float(q[1]);
              q = __builtin_amdgcn_permlane32_swap(__float_as_uint(s1), __float_as_uint(s1), false, false); s1 = __uint_as_float(q[0]) + __uint_as_float(q[1]);
              q = __builtin_amdgcn_permlane16_swap(__float_as_uint(s2), __float_as_uint(s2), false, false); s2 = __uint_as_float(q[0]) + __uint_as_float(q[1]);
              q = __builtin_amdgcn_permlane32_swap(__float_as_uint(s2), __float_as_uint(s2), false, false); s2 = __uint_as_float(q[0]) + __uint_as_float(q[1]); }
            LAS float* st = (LAS float*)(F.lds + 2 * 64 * 33 * 4 + 1024);
            if (g == 0) { st[(kh * 64 + tb + row) * 2] = s1; st[(kh * 64 + tb + row) * 2 + 1] = s2; }
            __syncthreads();
            const float t1 = st[(tb + row) * 2] + st[(64 + tb + row) * 2], t2 = st[(tb + row) * 2 + 1] + st[(64 + tb + row) * 2 + 1];
            const float mean = t1 * (1.0f / D), rstd = rsqrtf(fmaxf(t2 * (1.0f / D) - mean * mean, 0.f) + LN_EPS);
            f32x4 acc0 = (f32x4){0.f, 0.f, 0.f, 0.f}, acc1 = acc0;
            const bf16* w0 = RWT + (size_t)row * D + kh * 1024 + 8 * g;
            bf16* hp = (bf16*)H1 + (size_t)m * D + kh * 1024 + 8 * g; unsigned char* qp = H1Q + (size_t)m * D + kh * 1024 + 8 * g;
            const float* gp = g1 + kh * 1024 + 8 * g; const float* bp = b1 + kh * 1024 + 8 * g;
#pragma unroll 4
            for (int ks = 0; ks < 32; ++ks) {
                float x[8], g8[8], b8[8]; ld8f(xp + 32 * ks, x); ld8f(gp + 32 * ks, g8); ld8f(bp + 32 * ks, b8);
#pragma unroll
                for (int e = 0; e < 8; ++e) x[e] = (x[e] - mean) * rstd * g8[e] + b8[e];
                *(u32x4*)(hp + 32 * ks) = pack8(x);
                { u32x2 q; q.x = pk_fp8x4(x[0] * FP8_SA1, x[1] * FP8_SA1, x[2] * FP8_SA1, x[3] * FP8_SA1); q.y = pk_fp8x4(x[4] * FP8_SA1, x[5] * FP8_SA1, x[6] * FP8_SA1, x[7] * FP8_SA1); *(u32x2*)(qp + 32 * ks) = q; }
                float hi[8], lo[8];
#pragma unroll
                for (int e = 0; e < 8; ++e) { hi[e] = bf2f(f2bf(x[e])); lo[e] = x[e] - hi[e]; }
                const bf16x8_t ah = __builtin_bit_cast(bf16x8_t, pack8(hi)), al = __builtin_bit_cast(bf16x8_t, pack8(lo));
                const bf16x8_t b0h = *(const bf16x8_t*)(w0 + 32 * ks), b1h = *(const bf16x8_t*)(w0 + 16 * D + 32 * ks);
                const bf16x8_t b0l = *(const bf16x8_t*)(w0 + 32 * D + 32 * ks), b1l = *(const bf16x8_t*)(w0 + 48 * D + 32 * ks);
                acc0 = __builtin_amdgcn_mfma_f32_16x16x32_bf16(ah, b0h, acc0, 0, 0, 0); acc1 = __builtin_amdgcn_mfma_f32_16x16x32_bf16(ah, b1h, acc1, 0, 0, 0);
                acc0 = __builtin_amdgcn_mfma_f32_16x16x32_bf16(ah, b0l, acc0, 0, 0, 0); acc1 = __builtin_amdgcn_mfma_f32_16x16x32_bf16(ah, b1l, acc1, 0, 0, 0);
                acc0 = __builtin_amdgcn_mfma_f32_16x16x32_bf16(al, b0h, acc0, 0, 0, 0); acc1 = __builtin_amdgcn_mfma_f32_16x16x32_bf16(al, b1h, acc1, 0, 0, 0);
            }
#pragma unroll
            for (int q = 0; q < 4; ++q) { part[(kh * 64 + tb + 4 * g + q) * 33 + row] = acc0[q]; part[(kh * 64 + tb + 4 * g + q) * 33 + 16 + row] = acc1[q]; }
        }
        __syncthreads();
        for (int i = 0; i < 8; ++i) {
            const int tl_ = wave * 8 + i, m = ch * 64 + tl_;
            float lg = -INFINITY;
            if (lane < 32) lg = part[tl_ * 33 + lane] + part[(64 + tl_) * 33 + lane] + rb[lane];
            float tl[4]; int te[4];
#pragma unroll
            for (int k = 0; k < 4; ++k) { const float mx = wave_max(lg); const unsigned long long bm = __ballot(lg == mx); const int idx = __builtin_ctzll(bm); tl[k] = mx; te[k] = idx; if (lane == idx) lg = -INFINITY; }
            const float e1 = __expf(tl[1] - tl[0]), e2 = __expf(tl[2] - tl[0]), e3 = __expf(tl[3] - tl[0]); const float inv = 1.0f / (1.0f + e1 + e2 + e3);
            if (lane == 0) { *(int4*)(TOPE + (size_t)m * 4) = make_int4(te[0], te[1], te[2], te[3]); *(f32x4*)(TOPW + (size_t)m * 4) = (f32x4){inv, e1 * inv, e2 * inv, e3 * inv};
                es[tl_ * 4 + 0] = te[0]; es[tl_ * 4 + 1] = te[1]; es[tl_ * 4 + 2] = te[2]; es[tl_ * 4 + 3] = te[3]; }
        }
        __syncthreads();
        if (tid < 256) { const int e = es[tid]; int slot = 0; for (int q = 0; q < tid; ++q) slot += (es[q] == e) ? 1 : 0; SLOT[(size_t)ch * 256 + tid] = slot; }
        if (tid >= 256 && tid < 288) { const int e = tid - 256; int cnt = 0; for (int q = 0; q < 256; ++q) cnt += (es[q] == e) ? 1 : 0; HIST[ch * 32 + e] = cnt; }
        __syncthreads();
    }
}

__device__ __forceinline__ void p9_offsets(Frame& F) {
    unsigned char* ws = F.ws;
    const int* HIST = (const int*)(ws + WS_HIST); const int* TOPE = (const int*)(ws + WS_TOPE); const int* SLOT = (const int*)(ws + WS_SLOT);
    int* TOKROW = (int*)(ws + WS_TOKROW); int* ROWTOK = (int*)(ws + WS_ROWTOK); int* BLKE = (int*)(ws + WS_BLKE);
    LAS int* part = (LAS int*)F.lds;
    LAS int* tot = part + 512;
    LAS int* pre = tot + 32;
    LAS int* startp = pre + 32;
    LAS int* dsts = startp + 64;
    const int tid = F.tid, e = tid & 31, pg = tid >> 5;
    for (int ch = F.bid; ch < M / 64; ch += F.G) {
        __syncthreads();
        { int s = 0; for (int c = pg * 16; c < pg * 16 + 16; ++c) s += HIST[c * 32 + e]; part[pg * 32 + e] = s; }
        __syncthreads();
        if (tid < 32) { int s = 0; for (int q = 0; q < 16; ++q) s += part[q * 32 + tid]; tot[tid] = s; }
        __syncthreads();
        { int s = 0; for (int c = pg * 16; c < pg * 16 + 16; ++c) if (c < ch) s += HIST[c * 32 + e]; part[pg * 32 + e] = s; }
        __syncthreads();
        if (tid < 32) { int s = 0; for (int q = 0; q < 16; ++q) s += part[q * 32 + tid]; pre[tid] = s; }
        if (tid == 32) { int s = 0; for (int q = 0; q < 32; ++q) { startp[q] = s; s += (tot[q] + 255) / 256 * 256; } startp[32] = s; }
        __syncthreads();
        if (tid < 256) { const int m = ch * 64 + (tid >> 2); const int ee = TOPE[(size_t)m * 4 + (tid & 3)]; const int dest = startp[ee] + pre[ee] + SLOT[(size_t)ch * 256 + tid];
            ROWTOK[dest] = m; TOKROW[(size_t)m * 4 + (tid & 3)] = dest; dsts[tid] = dest; }
        __syncthreads();
        { const unsigned char* H1Q = (const unsigned char*)(ws + WS_H1B); unsigned char* XG = (unsigned char*)(ws + WS_XG);
          for (int a = F.wave; a < 256; a += 8) { const int m = ch * 64 + (a >> 2); const int dest = dsts[a];
              const u32x4 v0 = *(const u32x4*)(H1Q + (size_t)m * D + F.lane * 32), v1 = *(const u32x4*)(H1Q + (size_t)m * D + F.lane * 32 + 16);
              *(u32x4*)(XG + (size_t)dest * D + F.lane * 32) = v0; *(u32x4*)(XG + (size_t)dest * D + F.lane * 32 + 16) = v1; } }
        if (ch == 0) {
            const int nblk = startp[32] >> 8;
            if (tid < MAXBLK) { int be = -1; if (tid < nblk) { for (int q = 0; q < 32; ++q) if (startp[q] <= tid * 256 && tid * 256 < startp[q + 1]) be = q; } BLKE[tid] = be < 0 ? 0 : be; }
            if (tid == 0) BLKE[MAXBLK] = nblk;
        }
    }
    __syncthreads();
}

__device__ __forceinline__ void p12_combine_ln2(Frame& F, const Args& a) {
    unsigned char* ws = F.ws;
    const float* H1 = (const float*)(ws + WS_H1); const bf16* EO = (const bf16*)(ws + WS_EO); const int* TOKROW = (const int*)(ws + WS_TOKROW); const float* TOPW = (const float*)(ws + WS_TOPW);
    float* H2 = F.out; bf16* H2B = (bf16*)(ws + WS_H2B);
    const float* g2 = a.in[I_LN2G]; const float* b2 = a.in[I_LN2B];
    const int lane = F.lane, gw = F.bid * 8 + F.wave, NGW = F.G * 8;
    for (int m = gw; m < M; m += NGW) {
        const int4 rows = *(const int4*)(TOKROW + (size_t)m * 4); const f32x4 tw = *(const f32x4*)(TOPW + (size_t)m * 4);
        const int rr[4] = {rows.x, rows.y, rows.z, rows.w};
        float v[4][8]; float s = 0.f;
#pragma unroll
        for (int j = 0; j < 4; ++j) {
            const int c0 = 512 * j + 8 * lane;
            float h8[8]; unpack8(*(const u32x4*)((const bf16*)H1 + (size_t)m * D + c0), h8);
#pragma unroll
            for (int e = 0; e < 8; ++e) v[j][e] = ALPHA * h8[e];
#pragma unroll
            for (int k = 0; k < 4; ++k) { float e8[8]; unpack8(*(const u32x4*)(EO + (size_t)rr[k] * D + c0), e8); const float wk = tw[k];
#pragma unroll
                for (int e = 0; e < 8; ++e) v[j][e] += wk * e8[e]; }
#pragma unroll
            for (int e = 0; e < 8; ++e) s += v[j][e];
        }
        const float mean = wave_sum(s) * (1.0f / D); float s2 = 0.f;
#pragma unroll
        for (int j = 0; j < 4; ++j)
#pragma unroll
            for (int e = 0; e < 8; ++e) { v[j][e] -= mean; s2 += v[j][e] * v[j][e]; }
        const float rstd = rsqrtf(wave_sum(s2) * (1.0f / D) + LN_EPS);
#pragma unroll
        for (int j = 0; j < 4; ++j) { const int c0 = 512 * j + 8 * lane; float g8[8], b8[8], o[8]; ld8f(g2 + c0, g8); ld8f(b2 + c0, b8);
#pragma unroll
            for (int e = 0; e < 8; ++e) o[e] = v[j][e] * rstd * g8[e] + b8[e];
            { u32x2 q; q.x = pk_fp8x4(o[0] * FP8_SA1, o[1] * FP8_SA1, o[2] * FP8_SA1, o[3] * FP8_SA1); q.y = pk_fp8x4(o[4] * FP8_SA1, o[5] * FP8_SA1, o[6] * FP8_SA1, o[7] * FP8_SA1); *(u32x2*)((unsigned char*)(ws + WS_H2Q) + (size_t)m * D + c0) = q; }
            *(u32x4*)(H2B + (size_t)m * D + c0) = pack8(o); }
    }
}

__global__ void __launch_bounds__(512, 2) hymba_fwd(Args args) {
    extern __shared__ __attribute__((aligned(16))) unsigned char lds_raw[];
    Frame F;
    F.lds = (LAS unsigned char*)lds_raw; F.ws = args.ws; F.out = args.out;
    F.tid = threadIdx.x; F.lane = F.tid & 63; F.wave = __builtin_amdgcn_readfirstlane(F.tid >> 6); F.bid = blockIdx.x; F.G = gridDim.x;
    unsigned char* ws = args.ws;
    volatile LAS unsigned* MISC = (volatile LAS unsigned*)(F.lds + LDS_MISC);
    if (F.tid < 32) MISC[F.tid] = 0u;
    __syncthreads();
    XcdBarrier bar; bar.bar = (unsigned*)(ws + WS_CTL) + CW_BAR; bar.x = 0; bar.st = nullptr;
    const int lo = args.ph_lo, hi = args.ph_hi;
    const bool one_launch = (hi - lo) > 1;
    if (one_launch) bar = xcd_barrier_post((unsigned*)(ws + WS_CTL) + CW_BAR, MISC + 8);
#ifdef ONLYPH
#define IN(k) ((k) == ONLYPH && lo <= (k) && (k) < hi)
#else
#define IN(k) (lo <= (k) && (k) < hi)
#endif
#ifndef PROF_IDX
#define PROF_IDX -1
#endif
#ifndef PROF_SCALE
#define PROF_SCALE 4
#endif
    unsigned long long* prof = (unsigned long long*)(ws + WS_CTL + 512 * 1024);
#define STAMP(i) do { if (PROF_IDX >= 0 && F.bid == 0 && F.tid == 0) { __builtin_amdgcn_s_waitcnt(0); prof[(i)] = __builtin_amdgcn_s_memrealtime(); } } while (0)
#define SEAM(k) do { if (IN(k) && IN((k) + 1)) { xcd_barrier(bar); STAMP((k) + 1); } } while (0)
    STAMP(0);
#ifndef PROBE_MASK
#define PROBE_MASK 0ull
#endif
#ifndef PROBE_MODE
#define PROBE_MODE 3
#endif
#define REPS(k) for (int rp_ = 0; rp_ < ((((PROBE_MASK) >> (k)) & 1ull) ? 2 : 1); ++rp_)

    if (IN(0)) REPS(0) { p0_prologue(F, args); } SEAM(0);
    if (IN(1)) REPS(1) { GemmDesc g{(const bf16*)(ws + WS_XB), D, nullptr, (const bf16*)(ws + WS_WIN), D, M, NZ, D, nullptr, 0, nullptr, 127, 127, 0}; EpiZ E{(bf16*)(ws + WS_Z)}; gemm_run<false>(F, g, E); } SEAM(1);
    if (IN(2)) REPS(2) { p2_prep(F, args); } SEAM(2);
    if (IN(3)) {
        static_assert(WS_AL == WS_WL + (size_t)M * 256 * 2 && WS_GLS == WS_AL + (size_t)M * 256 * 2 && WS_AUP == WS_WUP + 1024 * 256 * 2 && WS_GUP == WS_AUP + 1024 * 256 * 2, "the three LoRA operand sets are stacked");
        GemmDesc gl{(const bf16*)(ws + WS_WL), 256, nullptr, (const bf16*)(ws + WS_WUP), 256, 3 * M, 1024, 256, (const int*)(ws + WS_BLKE + 4096), (size_t)1024 * 256, nullptr, 127, 127, 0};
        EpiLora El{(float*)(ws + WS_DEC), (float*)(ws + WS_ASIG), (bf16*)(ws + WS_G), args.in[I_W0], args.in[I_A0]};
        const bool split = F.G >= 128;
        if (split && F.bid < 64) {
            const int grp = F.bid >> 4, kv = grp >> 1, kh = grp & 1;
            GemmDesc gc{(const bf16*)(ws + (kv ? WS_ACV : WS_ACK)) + kh * 1024, D, nullptr, (const bf16*)(ws + (kv ? WS_CW1V : WS_CW1K)) + kh * 1024, D, 4096, 256, D, nullptr, 0, nullptr, 127, 127, 1024};
            EpiCmpPart Ec{(float*)(ws + (kv ? WS_HCMPV : WS_HCMPK)) + (size_t)kh * 4096 * 64};
            gemm_run_part(F, gc, Ec, 16, F.bid & 15);
        } else {
            const int Gp = split ? F.G - 64 : F.G, cp = split ? F.bid - 64 : F.bid;
            if (!split) { for (int q = 0; q < 4; ++q) { const int kv = q >> 1, kh = q & 1;
                GemmDesc gc{(const bf16*)(ws + (kv ? WS_ACV : WS_ACK)) + kh * 1024, D, nullptr, (const bf16*)(ws + (kv ? WS_CW1V : WS_CW1K)) + kh * 1024, D, 4096, 256, D, nullptr, 0, nullptr, 127, 127, 1024};
                EpiCmpPart Ec{(float*)(ws + (kv ? WS_HCMPV : WS_HCMPK)) + (size_t)kh * 4096 * 64}; gemm_run_part(F, gc, Ec, Gp, cp); } }
            gemm_run_part(F, gl, El, Gp, cp); }
    } SEAM(3);
    if (IN(4)) REPS(4) { p4_prep(F, args); } SEAM(4);
    #ifndef NAIVE_ATTN
#define NAIVE_ATTN 0
#endif
    if (IN(5)) { REPS(50) p5_scan_conv(F, args, rp_ == 0 ? 3 : PROBE_MODE);
#if PROF_IDX == 15
        if (one_launch) { xcd_barrier(bar); STAMP(16); if (F.bid == 0 && F.tid == 0) { __builtin_amdgcn_s_waitcnt(0); prof[15] = prof[5]; } }
#endif
#if NAIVE_ATTN
        p5_attn_naive(F);
#else
        REPS(51) nsa::attn_phase(F, rp_);
#endif
    } SEAM(5);
    if (IN(6)) REPS(6) { p6_rwkv_out(F, args); } SEAM(6);
    if (IN(7)) REPS(7) { GemmDesc g{(const bf16*)(ws + WS_CAT), D, nullptr, (const bf16*)(ws + WS_WOUT), D, M, D, D, nullptr, 0, nullptr, 127, 127, 0}; EpiPre1 E{F.out, args.in[I_X]}; gemm_run<false>(F, g, E); } SEAM(7);
    if (IN(8)) REPS(8) { p8_ln_router(F, args); } SEAM(8);
    if (IN(9)) REPS(9) { p9_offsets(F); } SEAM(9);
    if (IN(10)) REPS(10) { GemmDesc g{(const bf16*)(ws + WS_XG), D, nullptr, (const bf16*)(ws + WS_WGU), D, MAXROWS, 4096, D, (const int*)(ws + WS_BLKE), (size_t)4096 * D, (const int*)(ws + WS_BLKE) + MAXBLK, FP8_EA1, FP8_EW, 0};
        EpiSwiglu E{(unsigned char*)(ws + WS_HACT), args.in[I_EBG], args.in[I_EBU]}; gemm_run<true, EpiSwiglu, true>(F, g, E); } SEAM(10);
    if (IN(11)) REPS(11) {
        { GemmDesc g{(const bf16*)(ws + WS_HACT), D, nullptr, (const bf16*)(ws + WS_WDN), D, MAXROWS, D, D, (const int*)(ws + WS_BLKE), (size_t)D * D, (const int*)(ws + WS_BLKE) + MAXBLK, FP8_EA2, FP8_EW, 0};
          EpiDown E{(bf16*)(ws + WS_EO), args.in[I_EBD]}; gemm_run<false, EpiDown, true>(F, g, E); }
        { GemmDesc g{(const bf16*)(ws + WS_PB), 256, nullptr, (const bf16*)(ws + WS_WPL), 256, M, D, 256, nullptr, 0, nullptr, 127, 127, 0}; EpiBf16 E{(bf16*)(ws + WS_PL), D}; gemm_run<false>(F, g, E); }
    } SEAM(11);
    if (IN(12)) REPS(12) { p12_combine_ln2(F, args); } SEAM(12);
    if (IN(13)) { GemmDesc g{(const bf16*)(ws + WS_H2Q), D, nullptr, (const bf16*)(ws + WS_WPG), D, M, D, D, nullptr, 0, nullptr, FP8_EA1, FP8_EW, 0}; EpiFinal E{F.out, (const bf16*)(ws + WS_PL), (const bf16*)(ws + WS_H2B)}; gemm_run<false, EpiFinal, true>(F, g, E); }
    if (PROF_IDX >= 0 && one_launch) {
        xcd_barrier(bar); STAMP(14);
        if (F.bid == 0 && F.tid == 0) { asm volatile("s_waitcnt vmcnt(0)" ::: "memory");
            const unsigned long long d = (__hip_atomic_load(prof + PROF_IDX + 1, __ATOMIC_RELAXED, __HIP_MEMORY_SCOPE_AGENT) - __hip_atomic_load(prof + PROF_IDX, __ATOMIC_RELAXED, __HIP_MEMORY_SCOPE_AGENT)) * PROF_SCALE;
            const unsigned long long t0 = __builtin_amdgcn_s_memrealtime(); while (__builtin_amdgcn_s_memrealtime() - t0 < d) __builtin_amdgcn_s_sleep(8); }
    }
#undef IN
#undef SEAM
}

extern "C" void kernel_launch(void* const* d_in, const int* in_sizes, int n_in, void* d_out, int out_size, void* d_ws, size_t ws_size, hipStream_t stream) {
    static int grid = 0;
    if (grid == 0) {
        if (n_in != 35 || out_size != M * D || ws_size < WS_END) { fprintf(stderr, "kernel_launch: unexpected problem (n_in %d, out %d, ws %zu < %zu)\n", n_in, out_size, ws_size, (size_t)WS_END); grid = -1; return; }
        int dev = 0, cus = 0, per_cu = 0;
        if (hipGetDevice(&dev) != hipSuccess || hipDeviceGetAttribute(&cus, hipDeviceAttributeMultiprocessorCount, dev) != hipSuccess) { grid = -1; return; }
        if (hipFuncSetAttribute((const void*)hymba_fwd, hipFuncAttributeMaxDynamicSharedMemorySize, LDS_BYTES) != hipSuccess) { fprintf(stderr, "kernel_launch: hipFuncSetAttribute failed\n"); grid = -1; return; }
        if (hipOccupancyMaxActiveBlocksPerMultiprocessor(&per_cu, (const void*)hymba_fwd, 512, LDS_BYTES) != hipSuccess || per_cu < 1) fprintf(stderr, "kernel_launch: occupancy query reports %d\n", per_cu);
        (void)hipGetLastError();
        grid = cus;
    }
    if (grid < 0) return;
    if (hipMemsetAsync((char*)d_ws + WS_CTL, 0, CTL_ZERO_BYTES, stream) != hipSuccess) return;
    Args a{};
    for (int i = 0; i < 35; ++i) a.in[i] = (const float*)d_in[i];
    a.out = (float*)d_out; a.ws = (unsigned char*)d_ws;
#if MK_LAUNCH_PER_PHASE
    for (int ph = 0; ph < NPHASE; ++ph) { a.ph_lo = ph; a.ph_hi = ph + 1; a.li = ph; hipLaunchKernelGGL(hymba_fwd, dim3(grid), dim3(512), LDS_BYTES, stream, a); }
#else
    a.ph_lo = 0; a.ph_hi = NPHASE; a.li = 0;
    hipLaunchKernelGGL(hymba_fwd, dim3(grid), dim3(512), LDS_BYTES, stream, a);
#endif
}
```

```cpp
#include <hip/hip_runtime.h>
#include <cstdio>
#include <cstdint>

#ifndef MK_LAUNCH_PER_PHASE
#define MK_LAUNCH_PER_PHASE 0
#endif

#define GAS __attribute__((address_space(1)))
#define LAS __attribute__((address_space(3)))
typedef unsigned short bf16;
typedef float f32x4 __attribute__((ext_vector_type(4)));
typedef unsigned u32x4 __attribute__((ext_vector_type(4)));
typedef unsigned u32x2 __attribute__((ext_vector_type(2)));
#define LDS_WAIT() asm volatile("s_waitcnt lgkmcnt(0)" ::: "memory")

constexpr int NB = 4, T = 4096, D = 2048, M = NB * T;
constexpr int NZ = 6144;
constexpr int ZQ = 0, ZKC = 1024, ZVC = 1280, ZKS = 1536, ZVS = 1792, ZKW = 2048, ZVW = 2304, ZGL = 2560, ZRW = 2608;
constexpr int ZR = 2608, ZK = 3632, ZV = 4656, ZWL = 5680, ZAL = 5776, ZGLO = 5872, INC = 6128;
constexpr int NCMP = 255, NE = 32, MAXBLK = 288, MAXROWS = MAXBLK * 256;
constexpr float LN_EPS = 1e-5f, GN_EPS = 64e-5f, ALPHA = 1.189207115002721f;
constexpr int NPHASE = 14;

constexpr size_t MiB = 1u << 20;
constexpr size_t WS_CTL = 0, CTL_ZERO_BYTES = 1 * MiB;
constexpr size_t WS_HIST = 1 * MiB;
constexpr size_t WS_BLKE = 1 * MiB + 64 * 1024;
constexpr size_t WS_TOPE = 2 * MiB;
constexpr size_t WS_TOPW = WS_TOPE + 256 * 1024;
constexpr size_t WS_SLOT = WS_TOPW + 256 * 1024;
constexpr size_t WS_TOKROW = WS_SLOT + 256 * 1024;
constexpr size_t WS_ROWTOK = 3 * MiB;
constexpr size_t WS_RWT = 3 * MiB + 512 * 1024;
constexpr size_t WS_WPL = 4 * MiB;
constexpr size_t WS_WUP = 5 * MiB;
constexpr size_t WS_AUP = WS_WUP + 512 * 1024;
constexpr size_t WS_GUP = 6 * MiB;
constexpr size_t WS_CW1K = 7 * MiB;
constexpr size_t WS_CW1V = 8 * MiB;
constexpr size_t WS_HCMPK = 1844 * MiB;
constexpr size_t WS_HCMPV = 1846 * MiB;
constexpr size_t WS_KCMP = 11 * MiB;
constexpr size_t WS_VCMP = 11 * MiB + 512 * 1024;
constexpr size_t WS_WIN = 12 * MiB;
constexpr size_t WS_WOUT = 36 * MiB;
constexpr size_t WS_WPG = 44 * MiB;
constexpr size_t WS_PB = 52 * MiB;
constexpr size_t WS_WGU = 60 * MiB;
constexpr size_t WS_WDN = 572 * MiB;
constexpr size_t WS_S = 828 * MiB;
constexpr size_t WS_XB = WS_S;
constexpr size_t WS_Z = WS_S + 64 * MiB;
constexpr size_t WS_ACK = WS_S + 256 * MiB;
constexpr size_t WS_ACV = WS_S + 272 * MiB;
constexpr size_t WS_WL = WS_S + 288 * MiB;
constexpr size_t WS_AL = WS_S + 296 * MiB;
constexpr size_t WS_GLS = WS_S + 304 * MiB;
constexpr size_t WS_DEC = WS_S + 312 * MiB;
constexpr size_t WS_ASIG = WS_S + 376 * MiB;
constexpr size_t WS_G = WS_S + 440 * MiB;
constexpr size_t WS_SC = WS_S + 504 * MiB;
constexpr size_t WS_Y = WS_S + 888 * MiB;
constexpr size_t WS_CAT = WS_S + 952 * MiB;
constexpr size_t WS_H1 = WS_S;
constexpr size_t WS_H1B = WS_S + 128 * MiB;
constexpr size_t WS_XG = WS_S + 160 * MiB;
constexpr size_t WS_HACT = WS_S + 304 * MiB;
constexpr size_t WS_EO = WS_S + 480 * MiB;
constexpr size_t WS_H2B = WS_S + 768 * MiB;
constexpr size_t WS_PL = WS_S + 832 * MiB;
constexpr size_t WS_H2Q = WS_S + 896 * MiB;
constexpr size_t WS_END = 1848 * MiB;
static_assert(WS_S + 1016 * MiB <= WS_HCMPK, "d_ws map");
constexpr int CW_BAR = 4096;

constexpr int LDS_BYTES = 147456;
constexpr int LDS_MISC = 147456 - 128;
constexpr int CW_ATTNQ = 8192;

__device__ __forceinline__ unsigned f2bf(float f) { unsigned u = __float_as_uint(f); return (u + 0x7fffu + ((u >> 16) & 1u)) >> 16; }
typedef __bf16 bf2v_t __attribute__((ext_vector_type(2)));
typedef float f2v_t __attribute__((ext_vector_type(2)));
__device__ __forceinline__ unsigned pk2(float lo, float hi) { f2v_t v; v.x = lo; v.y = hi; return __builtin_bit_cast(unsigned, __builtin_convertvector(v, bf2v_t)); }
__device__ __forceinline__ float bf2f(unsigned h) { return __uint_as_float(h << 16); }
__device__ __forceinline__ float bflo(unsigned w) { return __uint_as_float(w << 16); }
__device__ __forceinline__ float bfhi(unsigned w) { return __uint_as_float(w & 0xffff0000u); }
#define DPPF(x, ctrl) __builtin_bit_cast(float, __builtin_amdgcn_update_dpp(0, __builtin_bit_cast(int, (x)), (ctrl), 0xF, 0xF, true))
__device__ __forceinline__ float wave_sum(float v) {
    v += DPPF(v, 0xB1); v += DPPF(v, 0x4E); v += DPPF(v, 0x141); v += DPPF(v, 0x140);
    { const auto q = __builtin_amdgcn_permlane16_swap(__float_as_uint(v), __float_as_uint(v), false, false); v = __uint_as_float(q[0]) + __uint_as_float(q[1]); }
    { const auto q = __builtin_amdgcn_permlane32_swap(__float_as_uint(v), __float_as_uint(v), false, false); v = __uint_as_float(q[0]) + __uint_as_float(q[1]); }
    return v;
}
__device__ __forceinline__ float wave_max(float v) {
    v = fmaxf(v, DPPF(v, 0xB1)); v = fmaxf(v, DPPF(v, 0x4E)); v = fmaxf(v, DPPF(v, 0x141)); v = fmaxf(v, DPPF(v, 0x140));
    { const auto q = __builtin_amdgcn_permlane16_swap(__float_as_uint(v), __float_as_uint(v), false, false); v = fmaxf(__uint_as_float(q[0]), __uint_as_float(q[1])); }
    { const auto q = __builtin_amdgcn_permlane32_swap(__float_as_uint(v), __float_as_uint(v), false, false); v = fmaxf(__uint_as_float(q[0]), __uint_as_float(q[1])); }
    return v;
}
__device__ __forceinline__ unsigned pk_fp8x4(float a, float b, float c, float d) {
    a = __builtin_amdgcn_fmed3f(a, -448.f, 448.f); b = __builtin_amdgcn_fmed3f(b, -448.f, 448.f); c = __builtin_amdgcn_fmed3f(c, -448.f, 448.f); d = __builtin_amdgcn_fmed3f(d, -448.f, 448.f);
    int w = 0; w = __builtin_amdgcn_cvt_pk_fp8_f32(a, b, w, false); w = __builtin_amdgcn_cvt_pk_fp8_f32(c, d, w, true); return (unsigned)w; }
constexpr float FP8_SO = 32.0f, FP8_SO_INV = 1.0f / 32.0f;
__device__ __forceinline__ void unpack_fp8x8(const u32x2 w, float (&f)[8]) { typedef float f2_ __attribute__((ext_vector_type(2)));
    const f2_ a = __builtin_amdgcn_cvt_pk_f32_fp8((int)w.x, false), b = __builtin_amdgcn_cvt_pk_f32_fp8((int)w.x, true), c = __builtin_amdgcn_cvt_pk_f32_fp8((int)w.y, false), d = __builtin_amdgcn_cvt_pk_f32_fp8((int)w.y, true);
    f[0] = a.x; f[1] = a.y; f[2] = b.x; f[3] = b.y; f[4] = c.x; f[5] = c.y; f[6] = d.x; f[7] = d.y; }
constexpr float FP8_SW = 64.0f, FP8_SA1 = 16.0f, FP8_SA2 = 4.0f;
constexpr int FP8_EW = 127 - 6, FP8_EA1 = 127 - 4, FP8_EA2 = 127 - 2;
__device__ __forceinline__ float sigmoidf_(float x) { return __builtin_amdgcn_rcpf(1.0f + __builtin_amdgcn_exp2f(-1.4426950408889634f * x)); }
__device__ __forceinline__ float gelu_tanh(float x) { const float u = 0.7978845608028654f * (x + 0.044715f * x * x * x); return x * sigmoidf_(2.0f * u); }

#define XB_TMO      128
#define XB_XCNT(j)  (256  + 64 * (j))
#define XB_XSUB(j)  (1280 + 64 * (j))
#define XB_XGEN(j)  (2304 + 64 * (j))
#define XB_TOP      3328
#define XB_TOPGEN   3392
#define XCD_BAR_WORDS 3456
#define XB_SPIN_CAP (1u << 22)
__device__ __forceinline__ unsigned xb_ld(unsigned* p)              { return __hip_atomic_load(p, __ATOMIC_RELAXED, __HIP_MEMORY_SCOPE_AGENT); }
__device__ __forceinline__ unsigned xb_add(unsigned* p, unsigned v) { return __hip_atomic_fetch_add(p, v, __ATOMIC_RELAXED, __HIP_MEMORY_SCOPE_AGENT); }
__device__ __forceinline__ unsigned xb_xcc_id() { return (unsigned)__builtin_amdgcn_s_getreg((3 << 11) | 20) & 0xFu; }
#define XB_SPIN(cond, bar) do { unsigned _sp = 0; while (cond) { __builtin_amdgcn_s_sleep(1); \
    if ((++_sp & 255u) == 0u) { if (xb_ld(&(bar)[XB_TMO])) break; if (_sp > XB_SPIN_CAP) { atomicAdd(&(bar)[XB_TMO], 1u); break; } } } } while (0)
struct XcdBarrier { unsigned* bar; unsigned x; volatile LAS unsigned* st; };
__device__ __forceinline__ XcdBarrier xcd_barrier_post(unsigned* bar, volatile LAS unsigned* st) {
    XcdBarrier b; b.bar = bar; b.x = xb_xcc_id(); b.st = st;
    if (threadIdx.x == 0) (void)xb_add(&bar[XB_XCNT(b.x)], 1u);
    return b;
}
__device__ __forceinline__ void xcd_barrier_complete(unsigned* bar, unsigned x, unsigned& nloc, unsigned& nx) {
    const unsigned G = gridDim.x * gridDim.y * gridDim.z;
    unsigned sum, cnt, mine, sp = 0u;
    for (;;) {
        sum = 0u; cnt = 0u; mine = 0u;
#pragma unroll
        for (unsigned j = 0; j < 16; ++j) { const unsigned c = xb_ld(&bar[XB_XCNT(j)]); sum += c; cnt += (c > 0u) ? 1u : 0u; mine = (j == x) ? c : mine; }
        if (sum == G) break;
        __builtin_amdgcn_s_sleep(1);
        if ((++sp & 255u) == 0u) { if (xb_ld(&bar[XB_TMO])) break; if (sp > XB_SPIN_CAP) { atomicAdd(&bar[XB_TMO], 1u); break; } }
    }
    nloc = mine > 0u ? mine : 1u; nx = cnt > 0u ? cnt : 1u;
}
__device__ __forceinline__ void xcd_barrier(const XcdBarrier& b) {
    asm volatile("s_waitcnt vmcnt(0)" ::: "memory");
    __syncthreads();
    if (threadIdx.x == 0) {
        unsigned* bar = b.bar;
        __builtin_amdgcn_s_waitcnt(0);
        unsigned nloc = b.st[0], nx = b.st[1];
        if (nloc == 0u) { xcd_barrier_complete(bar, b.x, nloc, nx); b.st[0] = nloc; b.st[1] = nx; }
        const unsigned old = xb_add(&bar[XB_XSUB(b.x)], 1u);
        const unsigned gen = old / nloc;
        if (old + 1u == (gen + 1u) * nloc) {
            __builtin_amdgcn_fence(__ATOMIC_RELEASE, "agent");
            asm volatile("s_waitcnt vmcnt(0)" ::: "memory");
            const unsigned og = xb_add(&bar[XB_TOP], 1u);
            const unsigned tg = og / nx;
            if (og + 1u == (tg + 1u) * nx) xb_add(&bar[XB_TOPGEN], 1u);
            else XB_SPIN(xb_ld(&bar[XB_TOPGEN]) == tg, bar);
            __builtin_amdgcn_fence(__ATOMIC_ACQUIRE, "agent");
            xb_add(&bar[XB_XGEN(b.x)], 1u);
            asm volatile("s_waitcnt vmcnt(0)" ::: "memory");
        } else {
            XB_SPIN(xb_ld(&bar[XB_XGEN(b.x)]) == gen, bar);
            __builtin_amdgcn_fence(__ATOMIC_ACQUIRE, "agent");
            asm volatile("s_waitcnt vmcnt(0)" ::: "memory");
        }
    }
    __syncthreads();
}

struct Args { const float* in[35]; float* out; unsigned char* ws; int ph_lo, ph_hi, li, pad; };
struct Frame {
    LAS unsigned char* lds;
    unsigned char* ws; float* out;
    int tid, lane, wave, bid, G;
};
enum { I_X = 0, I_P, I_WIN, I_PEK, I_W1K, I_W2K, I_PEV, I_W1V, I_W2V, I_MU, I_W0, I_WUP, I_A0, I_AUP, I_GUP, I_KK, I_KA, I_RK, I_LNG, I_LNB, I_WOUT,
       I_LN1G, I_LN1B, I_RW, I_RB, I_EWG, I_EBG, I_EWU, I_EBU, I_EWD, I_EBD, I_LN2G, I_LN2B, I_PLEW, I_PLEG };

struct GemmDesc {
    const bf16* A; int lda; const int* rowidx;
    const bf16* Bt; int ldb;
    int Mrows, N, K;
    const int* block_e; size_t bstride; const int* nblk;
    int ea, eb;
    int kext;
    int panel;
};
template <bool PAIR, class Epi>
__device__ __forceinline__ void ngemm_phase(Frame& F, const GemmDesc& g, const Epi& E) {
    LAS float* As = (LAS float*)F.lds;
    LAS float* Bs = As + 32 * 132;
    LAS float* Bu = Bs + 32 * 132;
    const int tid = F.tid, ty = tid >> 5, tx = tid & 31;
    const int lrow = tid >> 2, lkc = (tid & 3) * 8;
    const int ntm = g.Mrows / 128, ntn = PAIR ? g.N / 256 : g.N / 128;
    const int mlive = g.nblk ? (*g.nblk) * 256 : g.Mrows;
    for (int tile = F.bid; tile < ntm * ntn; tile += F.G) {
        const int tm = tile / ntn, tn = tile % ntn, m0 = tm * 128;
        if (m0 >= mlive) continue;
        const int e = g.block_e ? g.block_e[m0 >> 8] : 0;
        const bf16* Bt = g.Bt + (size_t)e * g.bstride;
        const int arow = g.rowidx ? g.rowidx[m0 + lrow] : (m0 + lrow);
        const bf16* ap = g.A + (size_t)arow * g.lda + lkc;
        const bf16* bp = Bt + (size_t)((PAIR ? tn * 256 : tn * 128) + lrow) * g.ldb + lkc;
        const bf16* bup = bp + (size_t)128 * g.ldb;
        f32x4 acc[8], accu[8];
#pragma unroll
        for (int i = 0; i < 8; ++i) { acc[i] = (f32x4){0.f, 0.f, 0.f, 0.f}; accu[i] = (f32x4){0.f, 0.f, 0.f, 0.f}; }
        for (int k0 = 0; k0 < g.K; k0 += 32) {
            const u32x4 av = *(const u32x4*)(ap + k0), bv = *(const u32x4*)(bp + k0);
            u32x4 uv = (u32x4){0u, 0u, 0u, 0u}; if (PAIR) uv = *(const u32x4*)(bup + k0);
            __syncthreads();
#pragma unroll
            for (int j = 0; j < 4; ++j) {
                As[(lkc + 2 * j) * 132 + lrow] = bflo(av[j]); As[(lkc + 2 * j + 1) * 132 + lrow] = bfhi(av[j]);
                Bs[(lkc + 2 * j) * 132 + lrow] = bflo(bv[j]); Bs[(lkc + 2 * j + 1) * 132 + lrow] = bfhi(bv[j]);
                if (PAIR) { Bu[(lkc + 2 * j) * 132 + lrow] = bflo(uv[j]); Bu[(lkc + 2 * j + 1) * 132 + lrow] = bfhi(uv[j]); }
            }
            __syncthreads();
#pragma unroll 4
            for (int k = 0; k < 32; ++k) {
                const f32x4 a0 = *(const LAS f32x4*)(As + k * 132 + ty * 8), a1 = *(const LAS f32x4*)(As + k * 132 + ty * 8 + 4);
                const f32x4 b = *(const LAS f32x4*)(Bs + k * 132 + tx * 4);
                acc[0] += a0.x * b; acc[1] += a0.y * b; acc[2] += a0.z * b; acc[3] += a0.w * b;
                acc[4] += a1.x * b; acc[5] += a1.y * b; acc[6] += a1.z * b; acc[7] += a1.w * b;
                if (PAIR) { const f32x4 u = *(const LAS f32x4*)(Bu + k * 132 + tx * 4);
                    accu[0] += a0.x * u; accu[1] += a0.y * u; accu[2] += a0.z * u; accu[3] += a0.w * u;
                    accu[4] += a1.x * u; accu[5] += a1.y * u; accu[6] += a1.z * u; accu[7] += a1.w * u; }
            }
        }
        const int col = (PAIR ? tn * 128 : tn * 128) + tx * 4;
#pragma unroll
        for (int i = 0; i < 8; ++i) { const int row = m0 + ty * 8 + i;
            if constexpr (PAIR) E.stp(row, col, acc[i], accu[i], e); else E.st(row, col, acc[i], e); }
    }
    __syncthreads();
}

__device__ __forceinline__ void st_bf16x4(bf16* p, f32x4 v) { u32x2 w; w.x = pk2(v.x, v.y); w.y = pk2(v.z, v.w); *(u32x2*)p = w; }
__device__ __forceinline__ void st_bf16x8(bf16* p, f32x4 a, f32x4 b) { u32x4 w; w.x = pk2(a.x, a.y); w.y = pk2(a.z, a.w); w.z = pk2(b.x, b.y); w.w = pk2(b.z, b.w); *(u32x4*)p = w; }
struct EpiZ { static constexpr bool PERM = true; bf16* Z; bf16* KC; __device__ __forceinline__ void st(int r, int c, f32x4 v, int) const { st_bf16x4(Z + (size_t)r * NZ + c, v); }
    __device__ __forceinline__ void st8(int r, int c, f32x4 a, f32x4 b, int) const {
        if (c >= ZKC && c < ZKS) { const int cc = c - ZKC;
            st_bf16x8(KC + (size_t)(cc >> 8) * (8u << 20) + ((size_t)((r >> 12) * 4 + ((cc >> 6) & 3)) * T + (r & (T - 1))) * 64 + (cc & 63), a, b); }
        else st_bf16x8(Z + (size_t)r * NZ + c, a, b); } };
struct EpiCmp { float* H; __device__ __forceinline__ void st(int r, int c, f32x4 v, int) const { if (c < 64) { f32x4 o; o.x = gelu_tanh(v.x); o.y = gelu_tanh(v.y); o.z = gelu_tanh(v.z); o.w = gelu_tanh(v.w); *(f32x4*)(H + (size_t)r * 64 + c) = o; } } };
struct EpiCmpPart { float* H; __device__ __forceinline__ void st(int r, int c, f32x4 v, int) const { if (c < 64) *(f32x4*)(H + (size_t)r * 64 + c) = v; } };
struct EpiDecay { float* O; const float* w0;
    __device__ __forceinline__ float f(float x) const { const float y = -x; const float sp = fmaxf(y, 0.f) + __logf(1.0f + __expf(-fabsf(y))); return __expf(-__expf(-sp - 0.5f)); }
    __device__ __forceinline__ void st(int r, int c, f32x4 v, int) const { const f32x4 b = *(const f32x4*)(w0 + c); f32x4 o; o.x = f(v.x + b.x); o.y = f(v.y + b.y); o.z = f(v.z + b.z); o.w = f(v.w + b.w); *(f32x4*)(O + (size_t)r * 1024 + c) = o; } };
struct EpiASig { float* O; const float* a0;
    __device__ __forceinline__ void st(int r, int c, f32x4 v, int) const { const f32x4 b = *(const f32x4*)(a0 + c); f32x4 o; o.x = sigmoidf_(v.x + b.x); o.y = sigmoidf_(v.y + b.y); o.z = sigmoidf_(v.z + b.z); o.w = sigmoidf_(v.w + b.w); *(f32x4*)(O + (size_t)r * 1024 + c) = o; } };
struct EpiLora { static constexpr bool PERM = true; float* DEC; float* ASIG; bf16* G; const float* w0; const float* a0;
    __device__ __forceinline__ float fd(float x) const { const float y = -x; const float sp = fmaxf(y, 0.f) + __logf(1.0f + __expf(-fabsf(y))); return __expf(-__expf(-sp - 0.5f)); }
    __device__ __forceinline__ void st8(int r, int c, f32x4 a, f32x4 b, int e) const { const int m = r - e * M;
        if (e == 0) { const f32x4 b0 = *(const f32x4*)(w0 + c), b1 = *(const f32x4*)(w0 + c + 4); f32x4 o0, o1; o0.x = fd(a.x + b0.x); o0.y = fd(a.y + b0.y); o0.z = fd(a.z + b0.z); o0.w = fd(a.w + b0.w); o1.x = fd(b.x + b1.x); o1.y = fd(b.y + b1.y); o1.z = fd(b.z + b1.z); o1.w = fd(b.w + b1.w);
            *(f32x4*)(DEC + (size_t)m * 1024 + c) = o0; *(f32x4*)(DEC + (size_t)m * 1024 + c + 4) = o1; }
        else if (e == 1) { const f32x4 b0 = *(const f32x4*)(a0 + c), b1 = *(const f32x4*)(a0 + c + 4); f32x4 o0, o1; o0.x = sigmoidf_(a.x + b0.x); o0.y = sigmoidf_(a.y + b0.y); o0.z = sigmoidf_(a.z + b0.z); o0.w = sigmoidf_(a.w + b0.w); o1.x = sigmoidf_(b.x + b1.x); o1.y = sigmoidf_(b.y + b1.y); o1.z = sigmoidf_(b.z + b1.z); o1.w = sigmoidf_(b.w + b1.w);
            st_bf16x8((bf16*)ASIG + (size_t)m * 1024 + c, o0, o1); }
        else st_bf16x8(G + (size_t)m * 1024 + c, a, b); }
    __device__ __forceinline__ void st(int, int, f32x4, int) const {} };
struct EpiF32 { float* O; int ld; __device__ __forceinline__ void st(int r, int c, f32x4 v, int) const { *(f32x4*)(O + (size_t)r * ld + c) = v; } };
struct EpiPre1 { float* O; const bf16* x; static constexpr bool PRE = true, PERM = true; struct Pre { u32x4 xw; };
    __device__ __forceinline__ Pre pre(int r, int c, int) const { Pre p; p.xw = *(const u32x4*)(x + (size_t)r * D + c); return p; }
    __device__ __forceinline__ void st8(int r, int c, f32x4 a, f32x4 b, int, const Pre& p) const { const f32x4 x0 = (f32x4){bflo(p.xw.x), bfhi(p.xw.x), bflo(p.xw.y), bfhi(p.xw.y)}, x1 = (f32x4){bflo(p.xw.z), bfhi(p.xw.z), bflo(p.xw.w), bfhi(p.xw.w)};
        st_bf16x8((bf16*)O + (size_t)r * D + c, ALPHA * x0 + a, ALPHA * x1 + b); }
    __device__ __forceinline__ void st(int r, int c, f32x4 v, int) const { const u32x2 xw = *(const u32x2*)(x + (size_t)r * D + c); const f32x4 xv = (f32x4){bflo(xw.x), bfhi(xw.x), bflo(xw.y), bfhi(xw.y)};     st_bf16x4((bf16*)O + (size_t)r * D + c, ALPHA * xv + v); } };
struct EpiSwiglu { static constexpr bool PERM = true; unsigned char* H; const float* bg; const float* bu;
    __device__ __forceinline__ float f(float g, float u) const { g = fminf(g, 7.0f); u = fminf(fmaxf(u, -7.0f), 7.0f); return g * sigmoidf_(1.702f * g) * (u + 1.0f); }
    __device__ __forceinline__ void stp(int r, int c, f32x4 g, f32x4 u, int e) const { const f32x4 b0 = *(const f32x4*)(bg + (size_t)e * D + c), b1 = *(const f32x4*)(bu + (size_t)e * D + c);
        f32x4 o; o.x = f(g.x + b0.x, u.x + b1.x); o.y = f(g.y + b0.y, u.y + b1.y); o.z = f(g.z + b0.z, u.z + b1.z); o.w = f(g.w + b0.w, u.w + b1.w); *(unsigned*)(H + (size_t)r * D + c) = pk_fp8x4(o.x * FP8_SA2, o.y * FP8_SA2, o.z * FP8_SA2, o.w * FP8_SA2); }
    __device__ __forceinline__ unsigned q4(int c, f32x4 g, f32x4 u, int e) const { const f32x4 b0 = *(const f32x4*)(bg + (size_t)e * D + c), b1 = *(const f32x4*)(bu + (size_t)e * D + c);
        return pk_fp8x4(f(g.x + b0.x, u.x + b1.x) * FP8_SA2, f(g.y + b0.y, u.y + b1.y) * FP8_SA2, f(g.z + b0.z, u.z + b1.z) * FP8_SA2, f(g.w + b0.w, u.w + b1.w) * FP8_SA2); }
    __device__ __forceinline__ void stp8(int r, int c, f32x4 g0, f32x4 g1, f32x4 u0, f32x4 u1, int e) const { u32x2 w; w.x = q4(c, g0, u0, e); w.y = q4(c + 4, g1, u1, e); *(u32x2*)(H + (size_t)r * D + c) = w; }
    static constexpr bool PRE = true; struct Pre { f32x4 g0, g1, u0, u1; };
    __device__ __forceinline__ Pre pre(int, int c, int e) const { Pre p; p.g0 = *(const f32x4*)(bg + (size_t)e * D + c); p.g1 = *(const f32x4*)(bg + (size_t)e * D + c + 4); p.u0 = *(const f32x4*)(bu + (size_t)e * D + c); p.u1 = *(const f32x4*)(bu + (size_t)e * D + c + 4); return p; }
    __device__ __forceinline__ unsigned q4p(f32x4 g, f32x4 u, f32x4 b0, f32x4 b1) const { return pk_fp8x4(f(g.x + b0.x, u.x + b1.x) * FP8_SA2, f(g.y + b0.y, u.y + b1.y) * FP8_SA2, f(g.z + b0.z, u.z + b1.z) * FP8_SA2, f(g.w + b0.w, u.w + b1.w) * FP8_SA2); }
    __device__ __forceinline__ void stp8(int r, int c, f32x4 g0, f32x4 g1, f32x4 u0, f32x4 u1, int, const Pre& p) const { u32x2 w; w.x = q4p(g0, u0, p.g0, p.u0); w.y = q4p(g1, u1, p.g1, p.u1); *(u32x2*)(H + (size_t)r * D + c) = w; } };
struct EpiDown { static constexpr bool PERM = true; unsigned char* O; const float* bd; __device__ __forceinline__ void st(int, int, f32x4, int) const {}
    __device__ __forceinline__ void st8(int r, int c, f32x4 a, f32x4 b, int e) const { const f32x4 b0 = *(const f32x4*)(bd + (size_t)e * D + c), b1 = *(const f32x4*)(bd + (size_t)e * D + c + 4); const f32x4 x = (a + b0) * FP8_SO, y = (b + b1) * FP8_SO;
        u32x2 w; w.x = pk_fp8x4(x.x, x.y, x.z, x.w); w.y = pk_fp8x4(y.x, y.y, y.z, y.w); *(u32x2*)(O + (size_t)r * D + c) = w; }
    static constexpr bool PRE = true; struct Pre { f32x4 b0, b1; };
    __device__ __forceinline__ Pre pre(int, int c, int e) const { Pre p; p.b0 = *(const f32x4*)(bd + (size_t)e * D + c); p.b1 = *(const f32x4*)(bd + (size_t)e * D + c + 4); return p; }
    __device__ __forceinline__ void st8(int r, int c, f32x4 a, f32x4 b, int, const Pre& p) const { const f32x4 x = (a + p.b0) * FP8_SO, y = (b + p.b1) * FP8_SO;
        u32x2 w; w.x = pk_fp8x4(x.x, x.y, x.z, x.w); w.y = pk_fp8x4(y.x, y.y, y.z, y.w); *(u32x2*)(O + (size_t)r * D + c) = w; } };
struct EpiBf16 { static constexpr bool PERM = true; bf16* O; int ld; __device__ __forceinline__ void st(int r, int c, f32x4 v, int) const { st_bf16x4(O + (size_t)r * ld + c, v); }
    __device__ __forceinline__ void st8(int r, int c, f32x4 a, f32x4 b, int) const { st_bf16x8(O + (size_t)r * ld + c, a, b); } };
struct EpiFinal { float* out; const bf16* PL; const bf16* H2; static constexpr bool PRE = true, PERM = true; struct Pre { u32x4 hw, pw; };
    __device__ __forceinline__ Pre pre(int r, int c, int) const { const size_t o = (size_t)r * D + c; Pre p; p.hw = *(const u32x4*)(H2 + o); p.pw = *(const u32x4*)(PL + o); return p; }
    __device__ __forceinline__ void st8(int r, int c, f32x4 a, f32x4 b, int, const Pre& p) const { const size_t o = (size_t)r * D + c; const u32x4 hw = p.hw, pw = p.pw;
        f32x4 q; q.x = bflo(hw.x) + sigmoidf_(a.x) * bflo(pw.x); q.y = bfhi(hw.x) + sigmoidf_(a.y) * bfhi(pw.x); q.z = bflo(hw.y) + sigmoidf_(a.z) * bflo(pw.y); q.w = bfhi(hw.y) + sigmoidf_(a.w) * bfhi(pw.y); *(f32x4*)(out + o) = q;
        f32x4 t; t.x = bflo(hw.z) + sigmoidf_(b.x) * bflo(pw.z); t.y = bfhi(hw.z) + sigmoidf_(b.y) * bfhi(pw.z); t.z = bflo(hw.w) + sigmoidf_(b.z) * bflo(pw.w); t.w = bfhi(hw.w) + sigmoidf_(b.w) * bfhi(pw.w); *(f32x4*)(out + o + 4) = t; }
    __device__ __forceinline__ void st(int r, int c, f32x4 v, int) const { const size_t o = (size_t)r * D + c; const u32x2 hw = *(const u32x2*)(H2 + o); const u32x2 pw = *(const u32x2*)(PL + o);
        f32x4 q; q.x = bflo(hw.x) + sigmoidf_(v.x) * bflo(pw.x); q.y = bfhi(hw.x) + sigmoidf_(v.y) * bfhi(pw.x); q.z = bflo(hw.y) + sigmoidf_(v.z) * bflo(pw.y); q.w = bfhi(hw.y) + sigmoidf_(v.w) * bfhi(pw.y); *(f32x4*)(out + o) = q; } };


namespace pg8 {
#ifdef PROF_GEMM
__device__ unsigned long long g_prof[64];
#endif
typedef short bf16x8 __attribute__((ext_vector_type(8)));
constexpr int BM = 256, BK = 64, HALF = 128, HTB = HALF * BK * 2, STAGE_BYTES = 8 * HTB, NXCD = 8, WGM = 8;
__device__ __forceinline__ int lds_byte(int r, int c) { const int st = (r >> 4) * 2 + (c >> 5), rr = r & 15, cc = c & 31, ob = rr * 64 + cc * 2; return st * 1024 + (ob ^ (((ob >> 9) & 1) << 5)); }
__device__ __forceinline__ void stage_rc(int b, int& R, int& C) { const int st = b / 1024, sb = b % 1024, swz = sb ^ (((sb >> 9) & 1) << 5); R = (st >> 1) * 16 + swz / 64; C = (st & 1) * 32 + (swz % 64) / 2; }
struct Unit { int pm, pn; };
struct StaticOrder {
    int nM, nN, nwg, G, c;
    int panel;
    __device__ void init(int nM_, int nN_, int G_, int c_) { nM = nM_; nN = nN_; nwg = nM * nN; G = G_; c = c_; panel = 0; }
    __device__ bool next(int i, Unit& u) const {
        if (panel) { const int rp = i / nN; const long pm_ = (long)rp * G + c; if (pm_ >= nM) return false; u.pm = (int)pm_; u.pn = i - rp * nN; return true; }
        const long L = (long)i * G + c; if (L >= nwg) return false;
        int wgid = (int)L; { const int q = nwg / NXCD, r = nwg % NXCD, xcd = wgid % NXCD, off = wgid / NXCD; wgid = (xcd < r ? xcd * (q + 1) : r * (q + 1) + (xcd - r) * q) + off; }
        const int nig = WGM * nN, gid = wgid / nig, fm = gid * WGM, gsz = (nM - fm) < WGM ? (nM - fm) : WGM;
        u.pm = fm + ((wgid % nig) % gsz); u.pn = (wgid % nig) / gsz; return true;
    }
};
template <class E, class = void> struct epi_pre { static constexpr bool value = false; };
template <class E> struct epi_pre<E, decltype((void)E::PRE)> { static constexpr bool value = E::PRE; };
template <class E, class = void> struct epi_perm { static constexpr bool value = false; };
template <class E> struct epi_perm<E, decltype((void)E::PERM)> { static constexpr bool value = E::PERM; };
__device__ __forceinline__ int perm32(int rho) { const int n = rho >> 4, i = rho & 15; return 8 * (i >> 2) + 4 * n + (i & 3); }
template <bool PAIR, class Epi>
__device__ __forceinline__ void epilogue(const f32x4 (&acc)[2][2][4][2], const Unit& u, int e, const Epi& E, int wr, int wc, int fr, int fq) {
    const int row0 = u.pm * BM + wr * 64 + fr;
    if constexpr (epi_pre<Epi>::value) {
#pragma unroll
        for (int ai = 0; ai < 2; ++ai) {
            if constexpr (PAIR) {
                static_assert(epi_perm<Epi>::value, "prefetching PAIR epilogues are PERM");
                typename Epi::Pre pf[4];
#pragma unroll
                for (int m = 0; m < 4; ++m) pf[m] = E.pre(row0 + ai * HALF + m * 16, u.pn * HALF + wc * 32 + 8 * fq, e);
#pragma unroll
                for (int m = 0; m < 4; ++m) E.stp8(row0 + ai * HALF + m * 16, u.pn * HALF + wc * 32 + 8 * fq, acc[ai][0][m][0], acc[ai][0][m][1], acc[ai][1][m][0], acc[ai][1][m][1], e, pf[m]);
            } else if constexpr (epi_perm<Epi>::value) {
                typename Epi::Pre pf[4][2];
#pragma unroll
                for (int m = 0; m < 4; ++m)
#pragma unroll
                    for (int bj = 0; bj < 2; ++bj) pf[m][bj] = E.pre(row0 + ai * HALF + m * 16, u.pn * BM + bj * HALF + wc * 32 + 8 * fq, e);
#pragma unroll
                for (int m = 0; m < 4; ++m)
#pragma unroll
                    for (int bj = 0; bj < 2; ++bj) E.st8(row0 + ai * HALF + m * 16, u.pn * BM + bj * HALF + wc * 32 + 8 * fq, acc[ai][bj][m][0], acc[ai][bj][m][1], e, pf[m][bj]);
            } else {
                typename Epi::Pre pf[4][2][2];
#pragma unroll
                for (int m = 0; m < 4; ++m)
#pragma unroll
                    for (int bj = 0; bj < 2; ++bj)
#pragma unroll
                        for (int n = 0; n < 2; ++n) pf[m][bj][n] = E.pre(row0 + ai * HALF + m * 16, u.pn * BM + bj * HALF + wc * 32 + n * 16 + 4 * fq, e);
#pragma unroll
                for (int m = 0; m < 4; ++m)
#pragma unroll
                    for (int bj = 0; bj < 2; ++bj)
#pragma unroll
                        for (int n = 0; n < 2; ++n) E.st(row0 + ai * HALF + m * 16, u.pn * BM + bj * HALF + wc * 32 + n * 16 + 4 * fq, acc[ai][bj][m][n], e, pf[m][bj][n]);
            }
        }
    } else {
#pragma unroll
    for (int ai = 0; ai < 2; ++ai)
#pragma unroll
        for (int m = 0; m < 4; ++m) { const int row = row0 + ai * HALF + m * 16;
            if constexpr (PAIR) {
                if constexpr (epi_perm<Epi>::value) E.stp8(row, u.pn * HALF + wc * 32 + 8 * fq, acc[ai][0][m][0], acc[ai][0][m][1], acc[ai][1][m][0], acc[ai][1][m][1], e);
                else {
#pragma unroll
                    for (int n = 0; n < 2; ++n) E.stp(row, u.pn * HALF + wc * 32 + n * 16 + 4 * fq, acc[ai][0][m][n], acc[ai][1][m][n], e); }
            } else if constexpr (epi_perm<Epi>::value) {
#pragma unroll
                for (int bj = 0; bj < 2; ++bj) E.st8(row, u.pn * BM + bj * HALF + wc * 32 + 8 * fq, acc[ai][bj][m][0], acc[ai][bj][m][1], e);
            } else {
#pragma unroll
                for (int bj = 0; bj < 2; ++bj)
#pragma unroll
                    for (int n = 0; n < 2; ++n) E.st(row, u.pn * BM + bj * HALF + wc * 32 + n * 16 + 4 * fq, acc[ai][bj][m][n], e);
            } }
    }
}
typedef int i32x8 __attribute__((ext_vector_type(8)));
__device__ __forceinline__ i32x8 cat8(const bf16x8& lo, const bf16x8& hi) { const u32x4 a = __builtin_bit_cast(u32x4, lo), b = __builtin_bit_cast(u32x4, hi); i32x8 r; r[0] = (int)a.x; r[1] = (int)a.y; r[2] = (int)a.z; r[3] = (int)a.w; r[4] = (int)b.x; r[5] = (int)b.y; r[6] = (int)b.z; r[7] = (int)b.w; return r; }
template <bool PAIR, bool FP8, class Epi>
__device__ __forceinline__ void gemm_phase(LAS unsigned char* lds, const GemmDesc& g, const Epi& E, int G, int cid) {
    const int tid = threadIdx.x, wid = __builtin_amdgcn_readfirstlane(tid >> 6), lane = tid & 63, wr = wid >> 2, wc = wid & 3, fr = lane & 15, fq = lane >> 4;
    const unsigned pitchB = FP8 ? (unsigned)g.K : (unsigned)g.K * 2u;
    const unsigned pitchA = FP8 ? (unsigned)g.lda : (unsigned)g.lda * 2u;
    const int nt = g.kext ? (int)((FP8 ? (unsigned)g.kext : (unsigned)g.kext * 2u) / 128u) : (int)(pitchB / 128u);
    const int sc_a = g.ea, sc_b = g.eb;
    StaticOrder S; S.init(g.nblk ? *g.nblk : g.Mrows / BM, g.N / BM, G, cid); S.panel = g.panel;
    unsigned voffA[2], voffB[2];
#pragma unroll
    for (int i = 0; i < 2; ++i) { int R, C; stage_rc(tid * 16 + i * 8192, R, C); const int Rb = epi_perm<Epi>::value ? ((R & ~31) + perm32(R & 31)) : R;
        voffA[i] = (unsigned)R * pitchA + (unsigned)C * 2u; voffB[i] = (unsigned)Rb * pitchB + (unsigned)C * 2u; }
    const size_t kstep = (size_t)(BK * 2);
    const size_t hstep = (size_t)HALF * pitchB;
    const size_t tstep = 2 * hstep;
    const size_t hstepA = (size_t)HALF * pitchA, tstepA = 2 * hstepA;
    const unsigned ldsw = (unsigned)wid * 1024u;
    const int aoff = lds_byte(wr * 64 + fr, fq * 8), boff = lds_byte(wc * 32 + fr, fq * 8);
    const char* gA = (const char*)g.A;
#define PG8_SA(b, h) (((b) * 2 + (h)) * HTB)
#define PG8_SB(b, h) ((4 + (b) * 2 + (h)) * HTB)
#define PG8_STAGE(bufoff, gbase, voff) do { _Pragma("unroll") for (int _i = 0; _i < 2; ++_i) \
        __builtin_amdgcn_global_load_lds((const unsigned*)((const char*)(gbase) + (voff)[_i]), (LAS unsigned*)(lds + (bufoff) + ldsw + _i * 8192), 16, 0, 0); } while (0)
#define PG8_LD8(dst, off) do { const u32x4 lo_ = *(const LAS u32x4*)(lds + (off)), hi_ = *(const LAS u32x4*)(lds + (off) + 1024); \
        dst[0] = (int)lo_.x; dst[1] = (int)lo_.y; dst[2] = (int)lo_.z; dst[3] = (int)lo_.w; dst[4] = (int)hi_.x; dst[5] = (int)hi_.y; dst[6] = (int)hi_.z; dst[7] = (int)hi_.w; } while (0)
#define PG8_LDA(dst, b, h) do { _Pragma("unroll") for (int m = 0; m < 4; ++m) { if constexpr (FP8) PG8_LD8(dst##8[m], PG8_SA(b, h) + aoff + m * 2048); else { _Pragma("unroll") for (int k = 0; k < 2; ++k) dst[m][k] = *(const LAS bf16x8*)(lds + PG8_SA(b, h) + aoff + m * 2048 + k * 1024); } } } while (0)
#define PG8_LDB(dst, b, h) do { _Pragma("unroll") for (int n = 0; n < 2; ++n) { if constexpr (FP8) PG8_LD8(dst##8[n], PG8_SB(b, h) + boff + n * 2048); else { _Pragma("unroll") for (int k = 0; k < 2; ++k) dst[n][k] = *(const LAS bf16x8*)(lds + PG8_SB(b, h) + boff + n * 2048 + k * 1024); } } } while (0)
#define PG8_MMA(ai, bj, At, Bt) do { __builtin_amdgcn_s_setprio(1); _Pragma("unroll") for (int m = 0; m < 4; ++m) _Pragma("unroll") for (int n = 0; n < 2; ++n) { \
        if constexpr (FP8) asm volatile("v_mfma_scale_f32_16x16x128_f8f6f4 %0, %1, %2, %0, %3, %4 op_sel_hi:[0,0,0]" : "+v"(acc[ai][bj][m][n]) : "v"(Bt##8[n]), "v"(At##8[m]), "v"(sc_b), "v"(sc_a));   \
        else { _Pragma("unroll") for (int k = 0; k < 2; ++k) acc[ai][bj][m][n] = __builtin_amdgcn_mfma_f32_16x16x32_bf16(Bt[n][k], At[m][k], acc[ai][bj][m][n], 0, 0, 0); } } __builtin_amdgcn_s_setprio(0); } while (0)
#define PG8_WAIT_V(n) asm volatile("s_waitcnt vmcnt(" #n ")" ::: "memory")
#define PG8_WAIT_L(n) asm volatile("s_waitcnt lgkmcnt(" #n ")" ::: "memory")
#define PG8_BAR __builtin_amdgcn_s_barrier()
#define PG8_SCHED __builtin_amdgcn_sched_barrier(0)
    Unit cur, nxt; int ui = 0;
    if (!S.next(0, cur)) return;
    f32x4 acc[2][2][4][2];
#pragma unroll
    for (int a = 0; a < 2; ++a)
#pragma unroll
        for (int b = 0; b < 2; ++b)
#pragma unroll
            for (int m = 0; m < 4; ++m)
#pragma unroll
                for (int n = 0; n < 2; ++n) acc[a][b][m][n] = (f32x4){0.f, 0.f, 0.f, 0.f};
    bf16x8 At[4][2], B0[2][2], B1[2][2];
    i32x8 At8[4], B08[2], B18[2];
    int ecur = g.block_e ? g.block_e[cur.pm] : 0;
    const char* cA = gA + (size_t)cur.pm * tstepA;
    const char* cB = (const char*)g.Bt + (size_t)ecur * g.bstride * (FP8 ? 1 : 2) + (size_t)cur.pn * tstep;
    PG8_STAGE(PG8_SB(0, 0), cB, voffB); PG8_STAGE(PG8_SB(0, 1), cB + hstep, voffB); PG8_STAGE(PG8_SA(0, 0), cA, voffA); PG8_STAGE(PG8_SA(0, 1), cA + hstepA, voffA);
    if (wr == 1) PG8_BAR;
    PG8_WAIT_V(2); PG8_BAR;
    PG8_STAGE(PG8_SB(1, 0), cB + kstep, voffB); PG8_STAGE(PG8_SA(1, 0), cA + kstep, voffA); PG8_STAGE(PG8_SB(1, 1), cB + hstep + kstep, voffB);
    PG8_WAIT_V(6); PG8_BAR;
    for (;;) {
        const bool has_next = S.next(ui + 1, nxt);
        int enxt = ecur; const char* nB = cB; const char* nA = cA;
        if (has_next) { enxt = g.block_e ? g.block_e[nxt.pm] : 0; nA = gA + (size_t)nxt.pm * tstepA; nB = (const char*)g.Bt + (size_t)enxt * g.bstride * (FP8 ? 1 : 2) + (size_t)nxt.pn * tstep; }
        for (int t = 0; t < nt; t += 2) {
            const bool last = (t == nt - 2);
            const char* a1 = cA + (size_t)(t + 1) * kstep;
            const char* a2 = last ? nA : cA + (size_t)(t + 2) * kstep; const char* b2 = last ? nB : cB + (size_t)(t + 2) * kstep;
            const char* a3 = a2 + kstep; const char* b3 = b2 + kstep;
            PG8_LDB(B0, 0, 0); PG8_LDB(B1, 0, 1); PG8_SCHED; PG8_LDA(At, 0, 0); PG8_STAGE(PG8_SA(1, 1), a1 + hstepA, voffA);
            PG8_WAIT_V(8); PG8_WAIT_L(0); PG8_BAR; PG8_MMA(0, 0, At, B0); PG8_MMA(0, 1, At, B1); PG8_BAR; PG8_SCHED;
            PG8_LDA(At, 0, 1); PG8_STAGE(PG8_SB(0, 0), b2, voffB); PG8_STAGE(PG8_SB(0, 1), b2 + hstep, voffB); PG8_STAGE(PG8_SA(0, 0), a2, voffA);
            PG8_WAIT_V(8); PG8_WAIT_L(0); PG8_BAR; PG8_MMA(1, 0, At, B0); PG8_MMA(1, 1, At, B1); PG8_BAR; PG8_SCHED;
            PG8_LDB(B0, 1, 0); PG8_LDB(B1, 1, 1); PG8_SCHED; PG8_LDA(At, 1, 0); PG8_STAGE(PG8_SA(0, 1), a2 + hstepA, voffA);
            PG8_WAIT_V(8); PG8_WAIT_L(0); PG8_BAR; PG8_MMA(0, 0, At, B0); PG8_MMA(0, 1, At, B1); PG8_BAR; PG8_SCHED;
            PG8_LDA(At, 1, 1); PG8_STAGE(PG8_SB(1, 0), b3, voffB); PG8_STAGE(PG8_SB(1, 1), b3 + hstep, voffB); PG8_STAGE(PG8_SA(1, 0), a3, voffA);
            PG8_WAIT_V(8); PG8_WAIT_L(0); PG8_BAR; PG8_MMA(1, 0, At, B0); PG8_MMA(1, 1, At, B1); PG8_BAR; PG8_SCHED;
        }
#ifdef PROF_GEMM
        if (g.panel && blockIdx.x == PROF_GEMM && tid == 0 && ui < 8) { __builtin_amdgcn_s_waitcnt(0); g_prof[40 + 2 * ui] = __builtin_amdgcn_s_memrealtime(); }
#endif
        if constexpr (FP8) asm volatile("s_nop 15\n\ts_nop 15" ::: "memory");
        if (wr == 0) PG8_BAR;
        epilogue<PAIR, Epi>(acc, cur, ecur, E, wr, wc, fr, fq);
#ifdef PROF_GEMM
        if (g.panel && blockIdx.x == PROF_GEMM && tid == 0 && ui < 8) { __builtin_amdgcn_s_waitcnt(0); g_prof[41 + 2 * ui] = __builtin_amdgcn_s_memrealtime(); }
#endif
        if (!has_next) break;
#pragma unroll
        for (int a = 0; a < 2; ++a)
#pragma unroll
            for (int b = 0; b < 2; ++b)
#pragma unroll
                for (int m = 0; m < 4; ++m)
#pragma unroll
                    for (int n = 0; n < 2; ++n) acc[a][b][m][n] = (f32x4){0.f, 0.f, 0.f, 0.f};
        cur = nxt; cA = nA; cB = nB; ecur = enxt; ++ui;
        if (wr == 1) PG8_BAR;
    }
    PG8_WAIT_V(0);
    PG8_BAR;
#undef PG8_SA
#undef PG8_SB
#undef PG8_STAGE
#undef PG8_LDA
#undef PG8_LD8
#undef PG8_LDB
#undef PG8_MMA
#undef PG8_WAIT_V
#undef PG8_WAIT_L
#undef PG8_BAR
#undef PG8_SCHED
}
}

#ifndef NAIVE_GEMM
#define NAIVE_GEMM 0
#endif
template <class Epi> __device__ __forceinline__ void gemm_run_part(Frame& F, const GemmDesc& g, const Epi& E, int G, int cid) {
    pg8::gemm_phase<false, false, Epi>(F.lds, g, E, G, cid);
    __syncthreads();
}
template <bool PAIR, class Epi, bool FP8 = false> __device__ __forceinline__ void gemm_run(Frame& F, const GemmDesc& g, const Epi& E) {
#if NAIVE_GEMM
    static_assert(!FP8, "the naive GEMM has no fp8 path");
    ngemm_phase<PAIR, Epi>(F, g, E);
#else
    pg8::gemm_phase<PAIR, FP8, Epi>(F.lds, g, E, F.G, F.bid);
    __syncthreads();
#endif
}

__device__ __forceinline__ void transpose_item(const float* W, int K, int N, bf16* WT, int Kp, size_t row0, int k0, int n0, LAS float* scr, int lane) {
    const int n = n0 + (lane & 31);
#pragma unroll 8
    for (int i = 0; i < 32; ++i) { const int kk = 2 * i + (lane >> 5), k = k0 + kk; scr[kk * 33 + (lane & 31)] = (k < K && n < N) ? W[(size_t)k * N + n] : 0.f; }
    LDS_WAIT(); asm volatile("" ::: "memory");
    const int c = lane & 7;
#pragma unroll
    for (int j = 0; j < 4; ++j) { const int nn = (lane >> 3) + 8 * j; const LAS float* s = scr + (8 * c) * 33 + nn;
        u32x4 o; o.x = pk2(s[0 * 33], s[1 * 33]); o.y = pk2(s[2 * 33], s[3 * 33]); o.z = pk2(s[4 * 33], s[5 * 33]); o.w = pk2(s[6 * 33], s[7 * 33]);
        *(u32x4*)(WT + (row0 + nn) * Kp + k0 + 8 * c) = o; }
    LDS_WAIT(); asm volatile("" ::: "memory");
}
struct CvItem { const float* src; unsigned char* dst; };
__device__ __forceinline__ CvItem cv_decode(const Args& a, unsigned char* ws, int it) {
    const int e = it / 3072, rr = it % 3072, which = rr >> 10, ri = rr & 1023, kb = ri & 31, nb = ri >> 5, n0 = 64 * nb, k0 = 64 * kb;
    CvItem c;
    const float* W = a.in[which == 0 ? I_EWG : (which == 1 ? I_EWU : I_EWD)] + (size_t)e * D * D;
    c.src = W + (size_t)k0 * D + n0;
    const size_t row0 = which == 2 ? (size_t)e * 2048 + n0 : (size_t)e * 4096 + (n0 >> 7) * 256 + (which == 1 ? 128 : 0) + (n0 & 127);
    c.dst = (unsigned char*)(ws + (which == 2 ? WS_WDN : WS_WGU)) + row0 * D + k0;
    return c;
}
__device__ __forceinline__ void cv_load(const CvItem& c, f32x4 (&v)[16], int lane) {
    const int kr = lane >> 4, n4 = (lane & 15) * 4;
#pragma unroll
    for (int i = 0; i < 16; ++i) v[i] = __builtin_nontemporal_load((const f32x4*)(c.src + (size_t)(4 * i + kr) * D + n4));
}
__device__ __forceinline__ void cv_store(const CvItem& cc, const f32x4 (&v)[16], int lane) {
    const int R = lane >> 4, c16 = lane & 15;
    unsigned od[16];
#pragma unroll
    for (int i = 0; i < 16; ++i) {
        unsigned x0 = __float_as_uint(v[i].x), x1 = __float_as_uint(v[i].y), x2 = __float_as_uint(v[i].z), x3 = __float_as_uint(v[i].w);
        { const auto q = __builtin_amdgcn_permlane16_swap(x0, x1, false, false); x0 = q[0]; x1 = q[1]; }
        { const auto q = __builtin_amdgcn_permlane16_swap(x2, x3, false, false); x2 = q[0]; x3 = q[1]; }
        { const auto q = __builtin_amdgcn_permlane32_swap(x0, x2, false, false); x0 = q[0]; x2 = q[1]; }
        { const auto q = __builtin_amdgcn_permlane32_swap(x1, x3, false, false); x1 = q[0]; x3 = q[1]; }
        od[i] = pk_fp8x4(__uint_as_float(x0) * FP8_SW, __uint_as_float(x1) * FP8_SW, __uint_as_float(x2) * FP8_SW, __uint_as_float(x3) * FP8_SW);
    }
    unsigned char* dp = cc.dst + (size_t)(4 * c16 + R) * D;
#pragma unroll
    for (int j = 0; j < 4; ++j) *(u32x4*)(dp + 16 * j) = (u32x4){od[4 * j], od[4 * j + 1], od[4 * j + 2], od[4 * j + 3]};
}
__device__ __forceinline__ void cv_pack(const f32x4 (&v)[16], unsigned (&od)[16]) {
#pragma unroll
    for (int i = 0; i < 16; ++i) {
        unsigned x0 = __float_as_uint(v[i].x), x1 = __float_as_uint(v[i].y), x2 = __float_as_uint(v[i].z), x3 = __float_as_uint(v[i].w);
        { const auto q = __builtin_amdgcn_permlane16_swap(x0, x1, false, false); x0 = q[0]; x1 = q[1]; }
        { const auto q = __builtin_amdgcn_permlane16_swap(x2, x3, false, false); x2 = q[0]; x3 = q[1]; }
        { const auto q = __builtin_amdgcn_permlane32_swap(x0, x2, false, false); x0 = q[0]; x2 = q[1]; }
        { const auto q = __builtin_amdgcn_permlane32_swap(x1, x3, false, false); x1 = q[0]; x3 = q[1]; }
        od[i] = pk_fp8x4(__uint_as_float(x0) * FP8_SW, __uint_as_float(x1) * FP8_SW, __uint_as_float(x2) * FP8_SW, __uint_as_float(x3) * FP8_SW);
    }
}
__device__ __forceinline__ void cv_pair(const Args& a, unsigned char* ws, int jp, int lane) {
    const CvItem c0 = cv_decode(a, ws, 2 * jp), c1 = cv_decode(a, ws, 2 * jp + 1);
    f32x4 va[16], vb[16];
    cv_load(c0, va, lane); cv_load(c1, vb, lane);
    unsigned oa[16], ob[16];
    cv_pack(va, oa); cv_pack(vb, ob);
    unsigned char* dp = c0.dst + (size_t)(4 * (lane & 15) + (lane >> 4)) * D;
#pragma unroll
    for (int j = 0; j < 4; ++j) *(u32x4*)(dp + 16 * j) = (u32x4){oa[4 * j], oa[4 * j + 1], oa[4 * j + 2], oa[4 * j + 3]};
#pragma unroll
    for (int j = 0; j < 4; ++j) *(u32x4*)(dp + 64 + 16 * j) = (u32x4){ob[4 * j], ob[4 * j + 1], ob[4 * j + 2], ob[4 * j + 3]};
}
__device__ __forceinline__ void tb_load(const float* W, int N, int k0, int n0, f32x4 (&v)[16], int lane) {
    const int kr = lane >> 4, n4 = n0 + (lane & 15) * 4; const bool ok = n4 < N;
#pragma unroll
    for (int i = 0; i < 16; ++i) v[i] = ok ? __builtin_nontemporal_load((const f32x4*)(W + (size_t)(k0 + 4 * i + kr) * N + n4)) : (f32x4){0.f, 0.f, 0.f, 0.f};
}
__device__ __forceinline__ void tb_store(bf16* WT, int Kp, int k0, int n0, const f32x4 (&v)[16], int lane) {
    const int R = lane >> 4, c16 = lane & 15;
    unsigned od[32];
#pragma unroll
    for (int i = 0; i < 16; ++i) {
        unsigned x0 = __float_as_uint(v[i].x), x1 = __float_as_uint(v[i].y), x2 = __float_as_uint(v[i].z), x3 = __float_as_uint(v[i].w);
        { const auto q = __builtin_amdgcn_permlane16_swap(x0, x1, false, false); x0 = q[0]; x1 = q[1]; }
        { const auto q = __builtin_amdgcn_permlane16_swap(x2, x3, false, false); x2 = q[0]; x3 = q[1]; }
        { const auto q = __builtin_amdgcn_permlane32_swap(x0, x2, false, false); x0 = q[0]; x2 = q[1]; }
        { const auto q = __builtin_amdgcn_permlane32_swap(x1, x3, false, false); x1 = q[0]; x3 = q[1]; }
        od[2 * i] = pk2(__uint_as_float(x0), __uint_as_float(x1)); od[2 * i + 1] = pk2(__uint_as_float(x2), __uint_as_float(x3));
    }
    bf16* dp = WT + (size_t)(n0 + 4 * c16 + R) * Kp + k0;
#pragma unroll
    for (int j = 0; j < 8; ++j) *(u32x4*)(dp + 8 * j) = (u32x4){od[4 * j], od[4 * j + 1], od[4 * j + 2], od[4 * j + 3]};
}
__device__ __forceinline__ void p0_prologue(Frame& F, const Args& a) {
    LAS float* scr = (LAS float*)(F.lds + F.wave * 16384);
    unsigned char* ws = F.ws;
    const int gw = F.bid * 8 + F.wave, NGW = F.G * 8;
    {
        constexpr int NB0 = 96 * 32, NB1 = 32 * 32, NBIG = NB0 + 2 * NB1;
        f32x4 va[16];
        for (int it = gw; it < NBIG; it += NGW) {
            const float* W; bf16* WT; int N, r = it;
            if (r < NB0) { W = a.in[I_WIN]; WT = (bf16*)(ws + WS_WIN); N = INC; }
            else if (r < NB0 + NB1) { r -= NB0; W = a.in[I_WOUT]; WT = (bf16*)(ws + WS_WOUT); N = D; }
            else { r -= NB0 + NB1; const int kb = r & 31, nb = r >> 5;
                CvItem ci; ci.src = a.in[I_PLEG] + (size_t)(64 * kb) * D + 64 * nb; ci.dst = (unsigned char*)(ws + WS_WPG) + (size_t)(64 * nb) * D + 64 * kb; cv_load(ci, va, F.lane); cv_store(ci, va, F.lane); continue; }
            const int kb = r & 31, nb = r >> 5;
            tb_load(W, N, 64 * kb, 64 * nb, va, F.lane); tb_store(WT, D, 64 * kb, 64 * nb, va, F.lane);
        }
    }
    constexpr int I3 = 4 * 64, I4 = 4 * 32, I5 = 4 * 32, I6 = 4 * 32, I7 = 32 * 8, I8 = 32 * 8;
    constexpr int NITEMS = I3 + I4 + I5 + I6 + I7 + I8;
    for (int it = gw; it < NITEMS; it += NGW) {
        int r = it;
#define TR_SIMPLE(cnt, W, K, N, WT, Kp, nblk) if (r < (cnt)) { const int kb = r / (nblk), nb = r % (nblk); transpose_item((W), (K), (N), (bf16*)(WT), (Kp), (size_t)(32 * nb), 64 * kb, 32 * nb, scr, F.lane); continue; } r -= (cnt);
        TR_SIMPLE(I3, a.in[I_PLEW], 256, 2048, ws + WS_WPL, 256, 64)
        TR_SIMPLE(I4, a.in[I_WUP], 96, 1024, ws + WS_WUP, 256, 32)
        TR_SIMPLE(I5, a.in[I_AUP], 96, 1024, ws + WS_AUP, 256, 32)
        TR_SIMPLE(I6, a.in[I_GUP], 256, 1024, ws + WS_GUP, 256, 32)
        TR_SIMPLE(I7, a.in[I_W1K], 2048, 64, ws + WS_CW1K, 2048, 8)
        TR_SIMPLE(I8, a.in[I_W1V], 2048, 64, ws + WS_CW1V, 2048, 8)
#undef TR_SIMPLE
        (void)r;
    }
    const size_t gt = (size_t)F.bid * 512 + F.tid, NT = (size_t)F.G * 512;
    { const float* x = a.in[I_X]; bf16* xb = (bf16*)(ws + WS_XB);
      constexpr size_t NV = (size_t)M * D / 8;
      for (size_t i = gt; i < NV; i += 4 * NT) {
          f32x4 v0[4], v1[4];
#pragma unroll
          for (int q = 0; q < 4; ++q) { const size_t j = i + q * NT; if (j < NV) { v0[q] = __builtin_nontemporal_load((const f32x4*)(x + j * 8)); v1[q] = __builtin_nontemporal_load((const f32x4*)(x + j * 8 + 4)); } }
#pragma unroll
          for (int q = 0; q < 4; ++q) { const size_t j = i + q * NT; if (j < NV) { u32x4 o; o.x = pk2(v0[q].x, v0[q].y); o.y = pk2(v0[q].z, v0[q].w); o.z = pk2(v1[q].x, v1[q].y); o.w = pk2(v1[q].z, v1[q].w); *(u32x4*)(xb + j * 8) = o; } } } }
    { const float* p = a.in[I_P]; bf16* pb = (bf16*)(ws + WS_PB);
      constexpr size_t NVP = (size_t)M * 256 / 8;
      for (size_t i = gt; i < NVP; i += 4 * NT) {
          f32x4 v0[4], v1[4];
#pragma unroll
          for (int q = 0; q < 4; ++q) { const size_t j = i + q * NT; if (j < NVP) { v0[q] = *(const f32x4*)(p + j * 8); v1[q] = *(const f32x4*)(p + j * 8 + 4); } }
#pragma unroll
          for (int q = 0; q < 4; ++q) { const size_t j = i + q * NT; if (j < NVP) { u32x4 o; o.x = pk2(v0[q].x, v0[q].y); o.y = pk2(v0[q].z, v0[q].w); o.z = pk2(v1[q].x, v1[q].y); o.w = pk2(v1[q].z, v1[q].w); *(u32x4*)(pb + j * 8) = o; } } } }
    { int* rt = (int*)(ws + WS_ROWTOK); for (size_t i = gt; i < (size_t)MAXROWS; i += NT) rt[i] = 0; }
    if (gt < 192) ((int*)(ws + WS_BLKE + 4096))[gt] = (int)(gt >> 6);
    { const float* rw = a.in[I_RW]; bf16* rwt = (bf16*)(ws + WS_RWT);
      for (size_t i = gt; i < (size_t)32 * D; i += NT) { const int e = (int)(i >> 11), k = (int)(i & 2047); const float w = rw[(size_t)k * 32 + e]; const unsigned hi = f2bf(w); rwt[i] = (bf16)hi; rwt[(size_t)32 * D + i] = (bf16)f2bf(w - bf2f(hi)); } }
}

__device__ __forceinline__ void unpack8(const u32x4 w, float (&f)[8]) { f[0] = bflo(w.x); f[1] = bfhi(w.x); f[2] = bflo(w.y); f[3] = bfhi(w.y); f[4] = bflo(w.z); f[5] = bfhi(w.z); f[6] = bflo(w.w); f[7] = bfhi(w.w); }
__device__ __forceinline__ u32x4 pack8(const float (&f)[8]) { u32x4 o; o.x = pk2(f[0], f[1]); o.y = pk2(f[2], f[3]); o.z = pk2(f[4], f[5]); o.w = pk2(f[6], f[7]); return o; }
__device__ __forceinline__ void ld8f(const float* p, float (&f)[8]) { const f32x4 a = *(const f32x4*)p, b = *(const f32x4*)(p + 4); f[0] = a.x; f[1] = a.y; f[2] = a.z; f[3] = a.w; f[4] = b.x; f[5] = b.y; f[6] = b.z; f[7] = b.w; }
__device__ __forceinline__ void st8f(float* p, const float (&f)[8]) { *(f32x4*)p = (f32x4){f[0], f[1], f[2], f[3]}; *(f32x4*)(p + 4) = (f32x4){f[4], f[5], f[6], f[7]}; }
__device__ __forceinline__ float dpp_sum8(float x) {
    x += __builtin_bit_cast(float, __builtin_amdgcn_update_dpp(0, __builtin_bit_cast(int, x), 0xB1, 0xF, 0xF, true));
    x += __builtin_bit_cast(float, __builtin_amdgcn_update_dpp(0, __builtin_bit_cast(int, x), 0x4E, 0xF, 0xF, true));
    x += __builtin_bit_cast(float, __builtin_amdgcn_update_dpp(0, __builtin_bit_cast(int, x), 0x141, 0xF, 0xF, true));
    return x;
}
__device__ __forceinline__ void shift8(const bf16* Z, size_t zo, int c, bool has_prev, const float* mu, float (&o)[8]) {
    float zc[8], zp[8], m8[8];
    unpack8(*(const u32x4*)(Z + zo + c), zc);
    if (has_prev) unpack8(*(const u32x4*)(Z + zo - NZ + c), zp); else {
#pragma unroll
        for (int i = 0; i < 8; ++i) zp[i] = 0.f; }
    ld8f(mu + (c - ZRW), m8);
#pragma unroll
    for (int i = 0; i < 8; ++i) o[i] = zc[i] + (zp[i] - zc[i]) * m8[i];
}

constexpr size_t WS_PEB = WS_CTL + 768 * 1024;
__device__ __forceinline__ void pe_bias_part(Frame& F, const Args& a) {
    const int j = F.bid - 64, kv = j >> 3, part = j & 7, lane = F.lane, wave = F.wave;
    const float* pe = a.in[kv ? I_PEV : I_PEK]; const float* w1 = a.in[kv ? I_W1V : I_W1K];
    LAS float* red = (LAS float*)F.lds;
    const int k0 = part * 256 + wave * 32;
    float acc = 0.f;
#pragma unroll
    for (int k = 0; k < 32; ++k) acc += pe[k0 + k] * w1[(size_t)(k0 + k) * 64 + lane];
    red[wave * 64 + lane] = acc;
    __syncthreads();
    if (wave == 0) { float s_ = 0.f;
#pragma unroll
        for (int w = 0; w < 8; ++w) s_ += red[w * 64 + lane];
        ((float*)(F.ws + WS_PEB))[(kv * 8 + part) * 64 + lane] = s_; }
    __syncthreads();
}

constexpr int CW_P4 = 8192 + 512;
constexpr int CW_P3Q = 8192 + 256;
__device__ __forceinline__ void p3_rwkv_fused(Frame& F, const Args& a) {
    typedef short bf16x8_t __attribute__((ext_vector_type(8)));
    typedef float f32x16_t __attribute__((ext_vector_type(16)));
    constexpr int PW = 208, PG = 528, PA = 272;
    constexpr int L_AW = 0, L_AA = 32 * PW, L_AG = 64 * PW, L_AS = 64 * PW + 32 * PG, L_TILE = L_AS + 8 * 32 * PA;
    unsigned char* ws = F.ws; LAS unsigned char* lds = F.lds;
    const bf16* Z = (const bf16*)(ws + WS_Z);
    const float* mu = a.in[I_MU]; const float* kk_w = a.in[I_KK]; const float* ka_w = a.in[I_KA]; const float* w0 = a.in[I_W0]; const float* a0 = a.in[I_A0];
    float* DEC = (float*)(ws + WS_DEC); bf16* GG = (bf16*)(ws + WS_G);
    unsigned* ctr = (unsigned*)(ws + WS_CTL) + CW_P3Q;
    const int tid = F.tid, lane = F.lane, wave = F.wave, n = lane & 31, h2 = lane >> 5;
    for (;;) {
        __syncthreads();
        if (tid == 0) *(LAS int*)(lds + L_TILE) = (int)atomicAdd(ctr, 1u);
        __syncthreads();
        const int tile = *(const LAS int*)(lds + L_TILE);
        if (tile >= M / 32) break;
        const int m0 = tile * 32;
        for (int it = tid; it < 32 * 56; it += 512) {
            const int tok = it / 56, grp = it - tok * 56, m = m0 + tok, t = m & (T - 1);
            float zs[8]; shift8(Z, (size_t)m * NZ, ZWL + 8 * grp, t != 0, mu, zs);
            float o[8];
            if (grp < 12) {
#pragma unroll
                for (int e = 0; e < 8; ++e) o[e] = tanhf(zs[e]);
                *(LAS u32x4*)(lds + L_AW + tok * PW + grp * 16) = pack8(o);
            } else if (grp < 24) { *(LAS u32x4*)(lds + L_AA + tok * PW + (grp - 12) * 16) = pack8(zs);
            } else {
#pragma unroll
                for (int e = 0; e < 8; ++e) o[e] = sigmoidf_(zs[e]);
                *(LAS u32x4*)(lds + L_AG + tok * PG + (grp - 24) * 16) = pack8(o); }
        }
        __syncthreads();
        {
#pragma unroll 1
            for (int ct = 0; ct < 4; ++ct) {
                const int col = 128 * wave + 32 * ct + n;
                const bf16* bw = (const bf16*)(ws + WS_WUP) + (size_t)col * 256 + 8 * h2; const bf16* ba = (const bf16*)(ws + WS_AUP) + (size_t)col * 256 + 8 * h2; const bf16* bg = (const bf16*)(ws + WS_GUP) + (size_t)col * 256 + 8 * h2;
                bf16x8_t bwf[6], baf[6];
#pragma unroll
                for (int ks = 0; ks < 6; ++ks) { bwf[ks] = *(const bf16x8_t*)(bw + 16 * ks); baf[ks] = *(const bf16x8_t*)(ba + 16 * ks); }
                asm volatile("" ::: "memory");
                f32x16_t cw, ca, cg;
#pragma unroll
                for (int i = 0; i < 16; ++i) { cw[i] = 0.f; ca[i] = 0.f; cg[i] = 0.f; }
#pragma unroll
                for (int ks = 0; ks < 6; ++ks) { const bf16x8_t awf = *(const LAS bf16x8_t*)(lds + L_AW + n * PW + (16 * ks + 8 * h2) * 2), aaf = *(const LAS bf16x8_t*)(lds + L_AA + n * PW + (16 * ks + 8 * h2) * 2);
                    cw = __builtin_amdgcn_mfma_f32_32x32x16_bf16(awf, bwf[ks], cw, 0, 0, 0); ca = __builtin_amdgcn_mfma_f32_32x32x16_bf16(aaf, baf[ks], ca, 0, 0, 0); }
#pragma unroll
                for (int kh = 0; kh < 2; ++kh) {
                    bf16x8_t bgf[8];
#pragma unroll
                    for (int ks = 0; ks < 8; ++ks) bgf[ks] = *(const bf16x8_t*)(bg + 16 * (8 * kh + ks));
                    asm volatile("" ::: "memory");
#pragma unroll
                    for (int ks = 0; ks < 8; ++ks) { const bf16x8_t agf = *(const LAS bf16x8_t*)(lds + L_AG + n * PG + (16 * (8 * kh + ks) + 8 * h2) * 2); cg = __builtin_amdgcn_mfma_f32_32x32x16_bf16(agf, bgf[ks], cg, 0, 0, 0); }
                }
                const float bw0 = w0[col], ba0 = a0[col];
#pragma unroll
                for (int i = 0; i < 16; ++i) {
                    const int tok = (i & 3) + 8 * (i >> 2) + 4 * h2; const size_t mo = (size_t)(m0 + tok) * 1024 + col;
                    const float x = cw[i] + bw0, y = -x; const float sp = fmaxf(y, 0.f) + __logf(1.0f + __expf(-fabsf(y)));
                    DEC[mo] = __expf(-__expf(-sp - 0.5f));
                    *(LAS unsigned short*)(lds + L_AS + wave * (32 * PA) + tok * PA + (32 * ct + n) * 2) = (unsigned short)f2bf(sigmoidf_(ca[i] + ba0));
                    GG[mo] = (bf16)f2bf(cg[i]);
                }
            }
        }
        asm volatile("s_waitcnt lgkmcnt(0)" ::: "memory"); __builtin_amdgcn_sched_barrier(0);
#pragma unroll 1
        for (int qb = 0; qb < 4; ++qb) {
            u32x4 zc[2][3], zp[2][3];
#pragma unroll
            for (int qi = 0; qi < 2; ++qi) { const int q = 2 * qb + qi, tok = 4 * q + (lane >> 4), m = m0 + tok, t = m & (T - 1), col = 128 * wave + 64 * ((lane >> 3) & 1) + 8 * (lane & 7);
                const size_t zo = (size_t)m * NZ;
#pragma unroll
                for (int c3 = 0; c3 < 3; ++c3) { const int cc = (c3 == 0 ? ZR : (c3 == 1 ? ZK : ZV)) + col; zc[qi][c3] = *(const u32x4*)(Z + zo + cc); zp[qi][c3] = t ? *(const u32x4*)(Z + zo - NZ + cc) : (u32x4){0u, 0u, 0u, 0u}; } }
#pragma unroll
            for (int qi = 0; qi < 2; ++qi) {
                const int q = 2 * qb + qi, tok = 4 * q + (lane >> 4), m = m0 + tok, t = m & (T - 1), b = m >> 12, col = 128 * wave + 64 * ((lane >> 3) & 1) + 8 * (lane & 7), h = col >> 6, j8 = col & 63;
                float r[8], k[8], v[8], av[8], kkw[8], kaw[8];
                { float c8[8], p8[8], m8[8];
                  unpack8(zc[qi][0], c8); unpack8(zp[qi][0], p8); ld8f(mu + (ZR + col - ZRW), m8);
#pragma unroll
                  for (int e = 0; e < 8; ++e) r[e] = c8[e] + (p8[e] - c8[e]) * m8[e];
                  unpack8(zc[qi][1], c8); unpack8(zp[qi][1], p8); ld8f(mu + (ZK + col - ZRW), m8);
#pragma unroll
                  for (int e = 0; e < 8; ++e) k[e] = c8[e] + (p8[e] - c8[e]) * m8[e];
                  unpack8(zc[qi][2], c8); unpack8(zp[qi][2], p8); ld8f(mu + (ZV + col - ZRW), m8);
#pragma unroll
                  for (int e = 0; e < 8; ++e) v[e] = c8[e] + (p8[e] - c8[e]) * m8[e]; }
                unpack8(*(const LAS u32x4*)(lds + L_AS + wave * (32 * PA) + tok * PA + (col - 128 * wave) * 2), av); ld8f(kk_w + col, kkw); ld8f(ka_w + col, kaw);
                float kk[8], ss = 0.f;
#pragma unroll
                for (int e = 0; e < 8; ++e) { kk[e] = k[e] * kkw[e]; ss += kk[e] * kk[e]; }
                const float inv = 1.0f / fmaxf(sqrtf(dpp_sum8(ss)), 1e-12f);
                float k2[8], na[8], bb[8];
#pragma unroll
                for (int e = 0; e < 8; ++e) { kk[e] *= inv; k2[e] = k[e] * (1.0f + (av[e] - 1.0f) * kaw[e]); na[e] = -kk[e]; bb[e] = kk[e] * av[e]; }
                { const size_t ti = (size_t)(b * 16 + h) * T + t;
                  bf16* sb16 = (bf16*)(ws + WS_SC + (size_t)64 * MiB) + ti * 320 + j8;
                  *(u32x4*)(sb16) = pack8(r); *(u32x4*)(sb16 + 64) = pack8(k2); *(u32x4*)(sb16 + 128) = pack8(v); *(u32x4*)(sb16 + 192) = pack8(na); *(u32x4*)(sb16 + 256) = pack8(bb); }
                { float rk8[8], sb = 0.f; ld8f(a.in[I_RK] + col, rk8);
#pragma unroll
                  for (int e = 0; e < 8; ++e) sb += r[e] * k2[e] * rk8[e];
                  const float bonus = dpp_sum8(sb); float bv[8];
#pragma unroll
                  for (int e = 0; e < 8; ++e) bv[e] = bonus * v[e];
                  *(u32x4*)((bf16*)(ws + WS_ASIG) + (size_t)m * 1024 + col) = pack8(bv); }
            }
        }
    }
    __syncthreads();
}

__device__ __forceinline__ void p4_prep(Frame& F, const Args& a, const int gw, const int NGW) {
    unsigned char* ws = F.ws;
    const int lane = F.lane;
#pragma unroll 1
    for (int kv = 0; kv < 2; ++kv) {
        const float* w2 = a.in[kv ? I_W2V : I_W2K];
        float wc[64];
#pragma unroll
        for (int j = 0; j < 64; ++j) wc[j] = w2[j * 64 + lane];
        const float* pb = (const float*)(ws + WS_PEB) + kv * 512; float pbs = 0.f;
#pragma unroll
        for (int q = 0; q < 8; ++q) pbs += pb[q * 64 + lane];
#pragma unroll 1
        for (int row = gw; row < 4096; row += NGW) {
            const int g = row & 3, c = (row >> 2) & 255, b = row >> 10;
            const float* H = (const float*)(ws + (kv ? WS_HCMPV : WS_HCMPK)) + (size_t)((b * 4 + g) * 256 + c) * 64;
            float o = 0.f;
            if (c < NCMP) {
                const float hv = gelu_tanh(H[lane] + H[(size_t)4096 * 64 + lane] + pbs);
#pragma unroll
                for (int j = 0; j < 64; ++j) o += __builtin_bit_cast(float, __builtin_amdgcn_readlane(__builtin_bit_cast(int, hv), j)) * wc[j];
            }
            __hip_atomic_store(((bf16*)(ws + (kv ? WS_VCMP : WS_KCMP))) + (size_t)row * 64 + lane, (bf16)f2bf(o), __ATOMIC_RELAXED, __HIP_MEMORY_SCOPE_AGENT);
        }
    }
}

__device__ __forceinline__ float dpp_sum16(float x) {
    x += __builtin_bit_cast(float, __builtin_amdgcn_update_dpp(0, __builtin_bit_cast(int, x), 0xB1, 0xF, 0xF, true));
    x += __builtin_bit_cast(float, __builtin_amdgcn_update_dpp(0, __builtin_bit_cast(int, x), 0x4E, 0xF, 0xF, true));
    x += __builtin_bit_cast(float, __builtin_amdgcn_update_dpp(0, __builtin_bit_cast(int, x), 0x141, 0xF, 0xF, true));
    x += __builtin_bit_cast(float, __builtin_amdgcn_update_dpp(0, __builtin_bit_cast(int, x), 0x140, 0xF, 0xF, true));
    return x;
}
__device__ __forceinline__ void p5_scan_conv(Frame& F, const Args& a, int mode) {
#ifndef SCAN_TC
#define SCAN_TC 32
#endif
    constexpr int TC = SCAN_TC, CHF = TC * 384, NLD = CHF / 1024;
    LAS float* buf = (LAS float*)F.lds;
    LAS unsigned* cnt = (LAS unsigned*)(F.lds + 2 * CHF * 4);
    const int tid = F.tid, lane = F.lane, wave = F.wave;
    if (tid == 0) *cnt = 0u;
    __syncthreads();
    if (wave < 4) { if (mode & 1) {
        const float* SC = (const float*)(F.ws + WS_SC);
        float* Y = (float*)(F.ws + WS_Y);
        const int kq = lane & 15, rl = lane >> 4;
        unsigned target = 0u;
        __builtin_amdgcn_s_setprio(0);
#define BAR4() do { LDS_WAIT(); asm volatile("" ::: "memory"); target += 4u; if (lane == 0) __hip_atomic_fetch_add(cnt, 1u, __ATOMIC_RELAXED, __HIP_MEMORY_SCOPE_WORKGROUP); \
        while (__hip_atomic_load(cnt, __ATOMIC_RELAXED, __HIP_MEMORY_SCOPE_WORKGROUP) < target) __builtin_amdgcn_s_sleep(1); asm volatile("" ::: "memory"); } while (0)
        for (int task = F.bid; task < 256; task += F.G) {
            const int bh = task >> 2, quarter = task & 3, b = bh >> 4, h = bh & 15;
            const int row = (quarter * 4 + wave) * 4 + rl;
            static_assert(TC == 32, "the compact staging below is written for 32-step chunks");
            const float* srcw = (const float*)(F.ws + WS_DEC) + (size_t)(b * T) * 1024 + h * 64;
            const bf16* srcb = (const bf16*)(F.ws + WS_SC + (size_t)64 * MiB) + (size_t)bh * T * 320;
            int wofs[2], bofs[5];
#pragma unroll
            for (int i = 0; i < 2; ++i) { const int p = tid + 256 * i; wofs[i] = (p >> 4) * 384 + 64 + (p & 15) * 4; }
#pragma unroll
            for (int i = 0; i < 5; ++i) { const int p = tid + 256 * i, tt = p / 40, q = p - tt * 40, comp = q >> 3; bofs[i] = tt * 384 + (comp == 0 ? 0 : 64 + 64 * comp) + (q & 7) * 8; }
#define SCAN_STAGE_LOAD(cc) do { _Pragma("unroll") for (int i = 0; i < 2; ++i) { const int p_ = tid + 256 * i; nw[i] = *(const f32x4*)(srcw + (size_t)((cc) * TC + (p_ >> 4)) * 1024 + (p_ & 15) * 4); } \
                _Pragma("unroll") for (int i = 0; i < 5; ++i) nb[i] = *(const u32x4*)(srcb + (size_t)(cc) * TC * 320 + (size_t)(tid + 256 * i) * 8); } while (0)
#define SCAN_STAGE_STORE(bufp) do { _Pragma("unroll") for (int i = 0; i < 2; ++i) *(LAS f32x4*)((bufp) + wofs[i]) = nw[i]; \
                _Pragma("unroll") for (int i = 0; i < 5; ++i) { *(LAS f32x4*)((bufp) + bofs[i]) = (f32x4){bflo(nb[i].x), bfhi(nb[i].x), bflo(nb[i].y), bfhi(nb[i].y)}; \
                    *(LAS f32x4*)((bufp) + bofs[i] + 4) = (f32x4){bflo(nb[i].z), bfhi(nb[i].z), bflo(nb[i].w), bfhi(nb[i].w)}; } } while (0)
            f32x4 nw[2]; u32x4 nb[5];
            BAR4();
            SCAN_STAGE_LOAD(0); SCAN_STAGE_STORE(buf);
            BAR4();
            f32x4 S = (f32x4){0.f, 0.f, 0.f, 0.f};
            for (int c = 0; c < T / TC; ++c) {
                const bool more = (c + 1 < T / TC);
                if (more) SCAN_STAGE_LOAD(c + 1);
                const LAS float* cb = buf + (c & 1) * CHF;
                typedef float f2s __attribute__((ext_vector_type(2)));
#define FENCE() __builtin_amdgcn_sched_barrier(0)
#define DPPA(x, ctrl) x += __builtin_bit_cast(float, __builtin_amdgcn_update_dpp(0, __builtin_bit_cast(int, x), ctrl, 0xF, 0xF, true))
                f32x4 r4[4], w4[3], k4[3], a4[3], b4[3]; float vv[3];
#define SCAN_LDS(st, i3, i4) do { const LAS float* sp_ = cb + (st) * 384; r4[i4] = *(const LAS f32x4*)(sp_ + kq * 4); w4[i3] = *(const LAS f32x4*)(sp_ + 64 + kq * 4); \
                    k4[i3] = *(const LAS f32x4*)(sp_ + 128 + kq * 4); a4[i3] = *(const LAS f32x4*)(sp_ + 256 + kq * 4); b4[i3] = *(const LAS f32x4*)(sp_ + 320 + kq * 4); vv[i3] = sp_[192 + row]; } while (0)
                SCAN_LDS(0, 0, 0); SCAN_LDS(1, 1, 1);
                float ykeep[TC / 16];
#pragma unroll
                for (int q = 0; q < TC / 16; ++q) ykeep[q] = 0.f;
                f2s S01 = (f2s){S.x, S.y}, S23 = (f2s){S.z, S.w};
#pragma unroll
                for (int tt = 0; tt < TC; ++tt) {
                    const int cu = tt % 3, rc = tt & 3, rp = (tt + 3) & 3;
                    if (tt + 2 < TC) SCAN_LDS(tt + 2, (tt + 2) % 3, (tt + 2) & 3);
                    FENCE();
                    asm volatile("" : "+v"(a4[cu]), "+v"(b4[cu]), "+v"(w4[cu]), "+v"(k4[cu]), "+v"(r4[rc]), "+v"(vv[cu]));
                    FENCE();
                    const f2s a01 = (f2s){a4[cu].x, a4[cu].y}, a23 = (f2s){a4[cu].z, a4[cu].w}, w01 = (f2s){w4[cu].x, w4[cu].y}, w23 = (f2s){w4[cu].z, w4[cu].w};
                    const f2s k01 = (f2s){k4[cu].x, k4[cu].y}, k23 = (f2s){k4[cu].z, k4[cu].w}, b01 = (f2s){b4[cu].x, b4[cu].y}, b23 = (f2s){b4[cu].z, b4[cu].w};
                    const f2s q01 = (f2s){r4[rp].x, r4[rp].y}, q23 = (f2s){r4[rp].z, r4[rp].w}, vv2 = (f2s){vv[cu], vv[cu]};
                    f2s d2, yd = (f2s){0.f, 0.f}, u01, u23; float sa, y = 0.f;
                    d2 = S01 * a01; FENCE();
                    if (tt > 0) { yd = S01 * q01; FENCE(); }
                    d2 = __builtin_elementwise_fma(S23, a23, d2); FENCE();
                    if (tt > 0) { yd = __builtin_elementwise_fma(S23, q23, yd); FENCE(); }
                    sa = d2.x + d2.y; FENCE();
                    if (tt > 0) { y = yd.x + yd.y; FENCE(); }
                    u01 = S01 * w01; FENCE();
                    DPPA(sa, 0xB1); FENCE();
                    if (tt > 0) { DPPA(y, 0xB1); FENCE(); }
                    u23 = S23 * w23; FENCE();
                    DPPA(sa, 0x4E); FENCE();
                    if (tt > 0) { DPPA(y, 0x4E); FENCE(); }
                    u01 = __builtin_elementwise_fma(k01, vv2, u01); FENCE();
                    DPPA(sa, 0x141); FENCE();
                    if (tt > 0) { DPPA(y, 0x141); FENCE(); }
                    u23 = __builtin_elementwise_fma(k23, vv2, u23); FENCE();
                    DPPA(sa, 0x140); FENCE();
                    if (tt > 0) { DPPA(y, 0x140); FENCE(); }
                    { const f2s sa2 = (f2s){sa, sa}; S01 = __builtin_elementwise_fma(b01, sa2, u01); FENCE(); S23 = __builtin_elementwise_fma(b23, sa2, u23); FENCE(); }
                    if (tt > 0) { ykeep[(tt - 1) >> 4] = (kq == ((tt - 1) & 15)) ? y : ykeep[(tt - 1) >> 4]; FENCE(); }
                }
                S = (f32x4){S01.x, S01.y, S23.x, S23.y};
                { const f32x4 rl4 = r4[(TC - 1) & 3]; f2s yd = S01 * (f2s){rl4.x, rl4.y}; yd = __builtin_elementwise_fma(S23, (f2s){rl4.z, rl4.w}, yd);
                  const float yr = dpp_sum16(yd.x + yd.y); ykeep[(TC - 1) >> 4] = (kq == ((TC - 1) & 15)) ? yr : ykeep[(TC - 1) >> 4]; }
#undef FENCE
#undef DPPA
#undef SCAN_LDS
#pragma unroll
                for (int q = 0; q < TC / 16; ++q) Y[((size_t)(b * T) + c * TC + 16 * q + kq) * 1024 + h * 64 + row] = ykeep[q];
                if (more) SCAN_STAGE_STORE(buf + ((c + 1) & 1) * CHF);
                BAR4();
            }
        }
#undef BAR4
#undef SCAN_STAGE_LOAD
#undef SCAN_STAGE_STORE
        __builtin_amdgcn_s_setprio(0);
    } } else {
        unsigned char* ws = F.ws;
        const int gw = F.bid * 4 + (wave - 4), NGW = F.G * 4;
        p4_prep(F, a, gw, NGW);
        asm volatile("s_waitcnt vmcnt(0)" ::: "memory");
        if (lane == 0) __hip_atomic_fetch_add((unsigned*)(ws + WS_CTL) + CW_P4, 1u, __ATOMIC_RELAXED, __HIP_MEMORY_SCOPE_AGENT);
        if (mode & 2) {
        constexpr int NPAIR = NE * 3 * 512;
        for (int jp = gw; jp < NPAIR; jp += NGW) cv_pair(a, ws, jp, lane);
        }
    }
    __syncthreads();
}

__device__ __forceinline__ void softmax_lds(LAS float* ps, int nk, int lane) {
    float mx = -INFINITY;
    for (int i = lane; i < nk; i += 64) mx = fmaxf(mx, ps[i]);
    mx = wave_max(mx);
    if (mx == -INFINITY) { for (int i = lane; i < nk; i += 64) ps[i] = 0.f; LDS_WAIT(); return; }
    float sum = 0.f;
    for (int i = lane; i < nk; i += 64) { const float e = __expf(ps[i] - mx); ps[i] = e; sum += e; }
    sum = wave_sum(sum);
    const float inv = 1.0f / fmaxf(sum, 1e-30f);
    for (int i = lane; i < nk; i += 64) ps[i] *= inv;
    LDS_WAIT();
}
__device__ __forceinline__ float dot64(const LAS float* q, const bf16* krow) {
    float s = 0.f;
#pragma unroll
    for (int j = 0; j < 8; ++j) { const u32x4 kv = *(const u32x4*)(krow + 8 * j); const f32x4 q0 = *(const LAS f32x4*)(q + 8 * j), q1 = *(const LAS f32x4*)(q + 8 * j + 4);
        s += q0.x * bflo(kv.x) + q0.y * bfhi(kv.x) + q0.z * bflo(kv.y) + q0.w * bfhi(kv.y) + q1.x * bflo(kv.z) + q1.y * bfhi(kv.z) + q1.z * bflo(kv.w) + q1.w * bfhi(kv.w); }
    return s;
}
__device__ __forceinline__ void p5_attn_naive(Frame& F) {
    unsigned char* ws = F.ws;
    const bf16* Z = (const bf16*)(ws + WS_Z);
    const bf16* KC = (const bf16*)(ws + WS_KCMP); const bf16* VC = (const bf16*)(ws + WS_VCMP);
    bf16* CAT = (bf16*)(ws + WS_CAT);
    const int lane = F.lane, gw = F.bid * 8 + F.wave, NGW = F.G * 8;
    LAS float* qs = (LAS float*)(F.lds + F.wave * 5120);
    LAS float* ps = qs + 256;
    for (int it = gw; it < NB * 4 * T; it += NGW) {
        const int t = it & (T - 1), g = (it >> 12) & 3, b = it >> 14, m = b * T + t, cur = t >> 6;
        const size_t zo = (size_t)m * NZ;
#pragma unroll
        for (int r = 0; r < 4; ++r) qs[r * 64 + lane] = bf2f(Z[zo + ZQ + (4 * g + r) * 64 + lane]);
        LDS_WAIT();
        float imp = 0.f, oacc[4];
        const int ncv = t >= 31 ? ((t - 31) >> 4) + 1 : 0;
#pragma unroll
        for (int r = 0; r < 4; ++r) {
            const int h = 4 * g + r; const float slope = exp2f(-0.5f * (float)(h + 1));
#pragma unroll
            for (int ch = 0; ch < 4; ++ch) { const int c = ch * 64 + lane; float s = -INFINITY;
                if (c < ncv) s = dot64(qs + r * 64, KC + ((size_t)(b * 256 + c) * 4 + g) * 64) * 0.125f - slope * (float)(t - (16 * c + 31));
                ps[c] = s; }
            LDS_WAIT();
            softmax_lds(ps, 256, lane);
            float o = 0.f;
            for (int c = 0; c < ncv; ++c) o += ps[c] * bf2f(VC[((size_t)(b * 256 + c) * 4 + g) * 64 + lane]);
            { const int j = lane; float v = 32.0f * (ps[4 * j] + ps[4 * j + 1] + ps[4 * j + 2]);
              if (j > 0) v += 16.0f * ps[4 * j - 1];
              v += 16.0f * ps[4 * j + 3];
              imp += v; }
            oacc[r] = sigmoidf_(bf2f(Z[zo + ZGL + h * 3 + 0])) * o;
            LDS_WAIT();
        }
        float v = imp;
        if (lane == 0 || lane == cur || lane == cur - 1) v = INFINITY; else if (lane > cur) v = -INFINITY;
        int rank = 0;
        for (int jj = 0; jj < 64; ++jj) { const float vv = __shfl(v, jj); rank += (vv > v || (vv == v && jj < lane)) ? 1 : 0; }
        const unsigned long long selmask = __ballot(rank < 16) & (cur >= 63 ? ~0ull : ((1ull << (cur + 1)) - 1ull));
#pragma unroll
        for (int r = 0; r < 4; ++r) {
            const int h = 4 * g + r; const float slope = exp2f(-0.5f * (float)(h + 1));
            int n = 0;
            for (unsigned long long mm = selmask; mm; mm &= mm - 1, ++n) { const int j = __builtin_ctzll(mm); const int pos = 64 * j + lane; float s = -INFINITY;
                if (pos <= t) s = dot64(qs + r * 64, Z + (size_t)(b * T + pos) * NZ + ZKS + g * 64) * 0.125f - slope * (float)(t - pos);
                ps[n * 64 + lane] = s; }
            LDS_WAIT();
            softmax_lds(ps, n * 64, lane);
            float o = 0.f; n = 0;
            for (unsigned long long mm = selmask; mm; mm &= mm - 1, ++n) { const int j = __builtin_ctzll(mm);
                const int lim = (64 * j + 63 <= t) ? 64 : (t - 64 * j + 1);
                const bf16* vb = Z + (size_t)(b * T + 64 * j) * NZ + ZVS + g * 64 + lane;
                for (int i = 0; i < lim; ++i) o += ps[n * 64 + i] * bf2f(vb[(size_t)i * NZ]); }
            oacc[r] += sigmoidf_(bf2f(Z[zo + ZGL + h * 3 + 1])) * o;
            LDS_WAIT();
        }
#pragma unroll
        for (int r = 0; r < 4; ++r) {
            const int h = 4 * g + r; const float slope = exp2f(-0.5f * (float)(h + 1));
#pragma unroll
            for (int ch = 0; ch < 8; ++ch) { const int pos = t - 511 + ch * 64 + lane; float s = -INFINITY;
                if (pos >= 0) s = dot64(qs + r * 64, Z + (size_t)(b * T + pos) * NZ + ZKW + g * 64) * 0.125f - slope * (float)(t - pos);
                ps[ch * 64 + lane] = s; }
            LDS_WAIT();
            softmax_lds(ps, 512, lane);
            float o = 0.f;
            const int i0 = t >= 511 ? 0 : 511 - t;
            const bf16* vb = Z + ZVW + g * 64 + lane;
            for (int i = i0; i < 512; ++i) o += ps[i] * bf2f(vb[(size_t)(b * T + t - 511 + i) * NZ]);
            oacc[r] += sigmoidf_(bf2f(Z[zo + ZGL + h * 3 + 2])) * o;
            CAT[(size_t)m * D + h * 64 + lane] = (bf16)f2bf(oacc[r]);
            LDS_WAIT();
        }
    }
}

namespace nsa {
typedef short bf16x8 __attribute__((ext_vector_type(8)));
typedef float f32x16 __attribute__((ext_vector_type(16)));
typedef __bf16 bf2_t __attribute__((ext_vector_type(2)));
typedef float f2_t __attribute__((ext_vector_type(2)));
__device__ __forceinline__ unsigned pkbf(float a, float b) { f2_t v; v.x = a; v.y = b; return __builtin_bit_cast(unsigned, __builtin_convertvector(v, bf2_t)); }
constexpr int KP = 144, TILE_B = 64 * KP;
constexpr int IMP_LD = 65;
constexpr int L_IMP = 8 * TILE_B;
constexpr int L_INVL = L_IMP + 4 * 64 * IMP_LD * 4;
constexpr int L_SEL = L_INVL + 1024;
constexpr int L_UNI = L_SEL + 512;
constexpr int L_UNIT = L_UNI + 64;
static_assert(L_UNIT + 64 <= LDS_MISC, "attention LDS map");
constexpr float LOG2E = 1.4426950408889634f, SCL = 0.125f * LOG2E, NEGBIG = -1e30f;

struct StageRegs { u32x4 k, v; };
__device__ __forceinline__ void stage_load(StageRegs& r, const bf16* kb, const bf16* vb, size_t pitch, int tid) {
    const int key = tid >> 3, ch = tid & 7;
    r.k = *(const u32x4*)(kb + (size_t)key * pitch + ch * 8);
    r.v = *(const u32x4*)(vb + (size_t)key * pitch + ch * 8);
}
__device__ __forceinline__ void stage_store(const StageRegs& r, LAS unsigned char* lds, int slot, int tid) {
    const int key = tid >> 3, ch = tid & 7;
    *(LAS u32x4*)(lds + slot * TILE_B + key * KP + ch * 16) = r.k;
    const int kl = key & 15, vpos = (key & 48) + (kl & 3) + 4 * (kl >> 3) + 8 * ((kl >> 2) & 1);
    LAS unsigned char* vp = lds + (4 + slot) * TILE_B + (ch * 8) * KP + vpos * 2;
#pragma unroll
    for (int e = 0; e < 8; ++e) { const unsigned w = r.v[e >> 1]; *(LAS unsigned short*)(vp + e * KP) = (unsigned short)((e & 1) ? (w >> 16) : (w & 0xffffu)); }
}
template <int MODE>
__device__ __forceinline__ void tile_core(const LAS unsigned char* Kl, const LAS unsigned char* Vl, const bf16x8 (&qf)[4], const float (&bias)[16], float sl32, f32x16 (&O)[2], float& m, float& l,
                                          float off, bool need_mask, bool use_lo, int lo, int hi, bool lv, int lane, float (&p)[2][16]) {
    const int n = lane & 31, h = lane >> 5;
    f32x16 st[2];
#pragma unroll
    for (int kt = 0; kt < 2; ++kt) {
#pragma unroll
        for (int i = 0; i < 16; ++i) st[kt][i] = 0.f;
#pragma unroll
        for (int s = 0; s < 4; ++s) { const bf16x8 a = *(const LAS bf16x8*)(Kl + (32 * kt + n) * KP + (16 * s + 8 * h) * 2); st[kt] = __builtin_amdgcn_mfma_f32_32x32x16_bf16(a, qf[s], st[kt], 0, 0, 0); }
    }
#pragma unroll
    for (int kt = 0; kt < 2; ++kt)
#pragma unroll
        for (int i = 0; i < 16; ++i) p[kt][i] = fmaf(st[kt][i], SCL, bias[i]);
    if (need_mask) {
#pragma unroll
        for (int kt = 0; kt < 2; ++kt)
#pragma unroll
            for (int i = 0; i < 16; ++i) { const int c = 32 * kt + (i & 3) + 8 * (i >> 2); p[kt][i] = (c <= hi) ? p[kt][i] : -INFINITY; }
        if (use_lo) {
#pragma unroll
            for (int kt = 0; kt < 2; ++kt)
#pragma unroll
                for (int i = 0; i < 16; ++i) { const int c = 32 * kt + (i & 3) + 8 * (i >> 2); p[kt][i] = (c >= lo) ? p[kt][i] : -INFINITY; }
        }
    }
    float mrel;
    if constexpr (MODE != 1) {
        float tm0 = p[0][0], tm1 = p[1][0];
#pragma unroll
        for (int i = 1; i < 16; ++i) { tm0 = fmaxf(tm0, p[0][i]); tm1 = fmaxf(tm1, p[1][i]); }
        float tm = fmaxf(tm0, tm1 + sl32);
        tm = lv ? tm : -INFINITY;
        { const auto sw_ = __builtin_amdgcn_permlane32_swap(__float_as_uint(tm), __float_as_uint(tm), false, false); tm = fmaxf(__uint_as_float(sw_[0]), __uint_as_float(sw_[1])); }
        const float mn = fmaxf(m, tm + off);
        if constexpr (MODE == 0) { m = mn; return; }
        if (__ballot(mn - m > 8.0f) != 0ull) { const float alpha = __builtin_amdgcn_exp2f(m - mn); m = mn; l *= alpha; O[0] = O[0] * alpha; O[1] = O[1] * alpha; }
        mrel = lv ? m - off : INFINITY;
    } else mrel = m - off;
    float ps = 0.f;
#pragma unroll
    for (int kt = 0; kt < 2; ++kt)
#pragma unroll
        for (int i = 0; i < 16; ++i) { p[kt][i] = __builtin_amdgcn_exp2f(p[kt][i] - (kt ? mrel - sl32 : mrel)); ps += p[kt][i]; }
    l += ps;
#pragma unroll
    for (int g16 = 0; g16 < 4; ++g16) {
        const int kt = g16 >> 1, s8 = (g16 & 1) * 8;
        u32x4 pw; pw.x = pkbf(p[kt][s8 + 0], p[kt][s8 + 1]); pw.y = pkbf(p[kt][s8 + 2], p[kt][s8 + 3]); pw.z = pkbf(p[kt][s8 + 4], p[kt][s8 + 5]); pw.w = pkbf(p[kt][s8 + 6], p[kt][s8 + 7]);
        const bf16x8 pb = __builtin_bit_cast(bf16x8, pw);
#pragma unroll
        for (int dt = 0; dt < 2; ++dt) { const bf16x8 a = *(const LAS bf16x8*)(Vl + (32 * dt + n) * KP + (16 * g16 + 8 * h) * 2); O[dt] = __builtin_amdgcn_mfma_f32_32x32x16_bf16(a, pb, O[dt], 0, 0, 0); }
    }
}
__device__ __forceinline__ void set_bias(float (&bias)[16], float sl, int h) {
#pragma unroll
    for (int i = 0; i < 16; ++i) bias[i] = sl * (float)((i & 3) + 8 * (i >> 2) + 4 * h);
}

__device__ __forceinline__ void attn_phase(Frame& F, int rep) {
    unsigned char* ws = F.ws;
    const bf16* Z = (const bf16*)(ws + WS_Z);
    const bf16* KC = (const bf16*)(ws + WS_KCMP); const bf16* VC = (const bf16*)(ws + WS_VCMP);
    bf16* CAT = (bf16*)(ws + WS_CAT);
    LAS unsigned char* lds = F.lds;
    LAS float* imph = (LAS float*)(lds + L_IMP); LAS float* invl = (LAS float*)(lds + L_INVL);
    LAS unsigned long long* selm = (LAS unsigned long long*)(lds + L_SEL); LAS unsigned long long* unis = (LAS unsigned long long*)(lds + L_UNI);
    unsigned* ctr = (unsigned*)(ws + WS_CTL) + CW_ATTNQ + 64 * rep;
    const int tid = F.tid, lane = F.lane, wave = F.wave, n = lane & 31, h = lane >> 5, r = wave >> 1, th = wave & 1, tq = 32 * th + n;
    for (;;) {
        __syncthreads();
        if (tid == 0) *(LAS int*)(lds + L_UNIT) = (int)atomicAdd(ctr, 1u);
        __syncthreads();
        const int u = *(LAS int*)(lds + L_UNIT);
        if (u >= NB * 4 * 64) break;
        const int qt = 63 - (u >> 4), b = (u >> 2) & 3, g = u & 3, t0 = 64 * qt, head = 4 * g + r, t = t0 + tq;
        const size_t zrow = (size_t)(b * T + t) * NZ;
        bf16x8 qf[4];
#pragma unroll
        for (int s = 0; s < 4; ++s) qf[s] = *(const bf16x8*)(Z + zrow + ZQ + head * 64 + 16 * s + 8 * h);
        const float slope2 = exp2f(-0.5f * (float)(head + 1)) * LOG2E;
        const float g0 = sigmoidf_(bf2f(Z[zrow + ZGL + head * 3 + 0])), g1 = sigmoidf_(bf2f(Z[zrow + ZGL + head * 3 + 1])), g2 = sigmoidf_(bf2f(Z[zrow + ZGL + head * 3 + 2]));
        const int ncmax = (4 * qt + 3) < NCMP ? (4 * qt + 3) : NCMP, ntc = (ncmax + 63) >> 6;
#pragma unroll 1
        for (int t2 = 0; t2 < ntc; t2 += 2) { StageRegs sc[2];
#pragma unroll
          for (int i = 0; i < 2; ++i) if (t2 + i < ntc) { const size_t ro = ((size_t)(b * 256 + 64 * (t2 + i)) * 4 + g) * 64; stage_load(sc[i], KC + ro, VC + ro, 256, tid); }
#pragma unroll
          for (int i = 0; i < 2; ++i) if (t2 + i < ntc) stage_store(sc[i], lds, t2 + i, tid); }
        __syncthreads();
        float bias[16], p[2][16];
        f32x16 O[2];
        set_bias(bias, slope2 * 16.0f, h);
        float sl32 = slope2 * 512.0f;
        const int ncv = t >= 31 ? ((t - 31) >> 4) + 1 : 0;
        float m = NEGBIG, l = 0.f;
#pragma unroll
        for (int i = 0; i < 16; ++i) { O[0][i] = 0.f; O[1][i] = 0.f; }
        for (int tau = 0; tau < ntc; ++tau)
            tile_core<0>(lds + tau * TILE_B, lds + (4 + tau) * TILE_B, qf, bias, sl32, O, m, l, slope2 * (float)(1024 * tau + 31 - t), true, false, 0, ncv - 1 - 64 * tau - 4 * h, true, lane, p);
        float carry = 0.f;
        for (int tau = 0; tau < ntc; ++tau) {
            tile_core<1>(lds + tau * TILE_B, lds + (4 + tau) * TILE_B, qf, bias, sl32, O, m, l, slope2 * (float)(1024 * tau + 31 - t), true, false, 0, ncv - 1 - 64 * tau - 4 * h, true, lane, p);
            float recv[8];
#pragma unroll
            for (int f = 0; f < 8; ++f) recv[f] = __shfl_xor(16.0f * p[f >> 2][4 * (f & 3) + 3], 32);
#pragma unroll
            for (int f = 0; f < 8; ++f) { const int kt = f >> 2, q4 = f & 3;
                const float gsum = 32.0f * (p[kt][4 * q4] + p[kt][4 * q4 + 1] + p[kt][4 * q4 + 2]) + 16.0f * p[kt][4 * q4 + 3];
                const float prev0 = (f == 0) ? carry : recv[f == 0 ? 0 : f - 1];
                const float prev = h ? recv[f] : prev0;
                imph[(r * 64 + tq) * IMP_LD + 16 * tau + 8 * kt + 2 * q4 + h] = gsum + prev; }
            carry = recv[7];
        }
        { const float lt = l + __shfl_xor(l, 32); const float inv = 1.0f / fmaxf(lt, 1e-30f); if (h == 0) invl[r * 64 + tq] = inv; O[0] = O[0] * (inv * g0); O[1] = O[1] * (inv * g0); }
        __syncthreads();
        { unsigned long long uw = 0ull; const unsigned long long vmask = qt >= 63 ? ~0ull : ((1ull << (qt + 1)) - 1ull);
          for (int qq = 0; qq < 8; ++qq) { const int q = 8 * wave + qq;
              float v = 0.f;
#pragma unroll
              for (int rr = 0; rr < 4; ++rr) v += imph[(rr * 64 + q) * IMP_LD + lane] * invl[rr * 64 + q];
              if (lane == 0 || lane == qt || lane == qt - 1) v = INFINITY; else if (lane > qt) v = -INFINITY;
              int rank = 0;
#pragma unroll
              for (int jj = 0; jj < 64; ++jj) { const float vv = __shfl(v, jj); rank += (vv > v || (vv == v && jj < lane)) ? 1 : 0; }
              const unsigned long long mk = __ballot(rank < 16) & vmask;
              if (lane == 0) selm[q] = mk;
              uw |= mk; }
          if (lane == 0) unis[wave] = uw; }
        __syncthreads();
        unsigned long long uni = 0ull;
#pragma unroll
        for (int w8 = 0; w8 < 8; ++w8) uni |= unis[w8];
        uni = __builtin_amdgcn_readfirstlane((unsigned)uni) | ((unsigned long long)__builtin_amdgcn_readfirstlane((unsigned)(uni >> 32)) << 32);
        const unsigned long long selq = selm[tq];
        LAS float* oacc = (LAS float*)(lds + L_IMP) + wave * 2048 + lane;
#pragma unroll
        for (int i = 0; i < 16; ++i) { oacc[i * 64] = O[0][i]; oacc[(16 + i) * 64] = O[1][i]; }
        set_bias(bias, slope2, h); sl32 = slope2 * 32.0f;
        m = NEGBIG; l = 0.f;
#pragma unroll
        for (int i = 0; i < 16; ++i) { O[0][i] = 0.f; O[1][i] = 0.f; }
        {
            unsigned long long mm = uni; int j = __builtin_ctzll(mm); mm &= mm - 1; int cb = 0;
            { StageRegs sr; const bf16* kb = Z + (size_t)(b * T + 64 * j) * NZ + g * 64; stage_load(sr, kb + ZKS, kb + ZVS, NZ, tid); stage_store(sr, lds, 0, tid); }
            __syncthreads();
            for (;;) {
                const bool more = mm != 0ull; int jn = 0; StageRegs sr;
                if (more) { jn = __builtin_ctzll(mm); mm &= mm - 1; const bf16* kb = Z + (size_t)(b * T + 64 * jn) * NZ + g * 64; stage_load(sr, kb + ZKS, kb + ZVS, NZ, tid); }
                const bool lv = (selq >> j) & 1ull; const bool diag = (j == qt);
                tile_core<2>(lds + cb * TILE_B, lds + (4 + cb) * TILE_B, qf, bias, sl32, O, m, l, slope2 * (float)(64 * j - t), diag, false, 0, tq - 4 * h, lv, lane, p);
                if (more) stage_store(sr, lds, cb ^ 1, tid);
                __syncthreads();
                if (!more) break;
                j = jn; cb ^= 1;
            }
        }
        { const float lt = l + __shfl_xor(l, 32); const float inv = 1.0f / fmaxf(lt, 1e-30f) * g1;
#pragma unroll
          for (int i = 0; i < 16; ++i) { oacc[i * 64] += O[0][i] * inv; oacc[(16 + i) * 64] += O[1][i] * inv; } }
        m = NEGBIG; l = 0.f;
#pragma unroll
        for (int i = 0; i < 16; ++i) { O[0][i] = 0.f; O[1][i] = 0.f; }
        {
            int j = qt >= 8 ? qt - 8 : 0; int cb = 0;
            { StageRegs sr; const bf16* kb = Z + (size_t)(b * T + 64 * j) * NZ + g * 64; stage_load(sr, kb + ZKW, kb + ZVW, NZ, tid); stage_store(sr, lds, 0, tid); }
            __syncthreads();
            for (;;) {
                const bool more = j < qt; StageRegs sr;
                if (more) { const bf16* kb = Z + (size_t)(b * T + 64 * (j + 1)) * NZ + g * 64; stage_load(sr, kb + ZKW, kb + ZVW, NZ, tid); }
                const bool left = (j == qt - 8), diag = (j == qt);
                const int lo = (left ? tq + 1 : -1000) - 4 * h, hi = (diag ? tq : 1000) - 4 * h;
                tile_core<2>(lds + cb * TILE_B, lds + (4 + cb) * TILE_B, qf, bias, sl32, O, m, l, slope2 * (float)(64 * j - t), left || diag, left, lo, hi, true, lane, p);
                if (more) stage_store(sr, lds, cb ^ 1, tid);
                __syncthreads();
                if (!more) break;
                ++j; cb ^= 1;
            }
        }
        { const float lt = l + __shfl_xor(l, 32); const float inv = 1.0f / fmaxf(lt, 1e-30f) * g2;
#pragma unroll
          for (int i = 0; i < 16; ++i) { O[0][i] = oacc[i * 64] + O[0][i] * inv; O[1][i] = oacc[(16 + i) * 64] + O[1][i] * inv; } }
        bf16* orow = CAT + (size_t)(b * T + t) * D + head * 64;
#pragma unroll
        for (int dt = 0; dt < 2; ++dt)
#pragma unroll
            for (int q4 = 0; q4 < 4; ++q4) { u32x2 w; w.x = pkbf(O[dt][4 * q4], O[dt][4 * q4 + 1]); w.y = pkbf(O[dt][4 * q4 + 2], O[dt][4 * q4 + 3]); *(u32x2*)(orow + 32 * dt + 8 * q4 + 4 * h) = w; }
    }
    __syncthreads();
}
}

__device__ __forceinline__ void p6_rwkv_out(Frame& F, const Args& a) {
    unsigned char* ws = F.ws;
    const float* Y = (const float*)(ws + WS_Y); const float* SC = (const float*)(ws + WS_SC); const float* G = (const float*)(ws + WS_G);
    const float* rk = a.in[I_RK]; const float* lng = a.in[I_LNG]; const float* lnb = a.in[I_LNB];
    bf16* CAT = (bf16*)(ws + WS_CAT);
    const int lane = F.lane, gw = F.bid * 8 + F.wave, NGW = F.G * 8;
    for (int it = gw; it < M * 2; it += NGW) {
        const int m = it >> 1, half = it & 1, t = m & (T - 1), b = m >> 12, col = (half * 64 + lane) * 8, h = col >> 6, j8 = col & 63;
        float y[8], bv[8], gg[8], lg8[8], lb8[8];
        ld8f(Y + (size_t)m * 1024 + col, y);
        unpack8(*(const u32x4*)((const bf16*)(ws + WS_ASIG) + (size_t)m * 1024 + col), bv); unpack8(*(const u32x4*)((const bf16*)(ws + WS_G) + (size_t)m * 1024 + col), gg);
        ld8f(lng + col, lg8); ld8f(lnb + col, lb8);
        float s1 = 0.f;
#pragma unroll
        for (int e = 0; e < 8; ++e) s1 += y[e];
        const float mean = dpp_sum8(s1) * (1.0f / 64.0f);
        float s2 = 0.f;
#pragma unroll
        for (int e = 0; e < 8; ++e) { y[e] -= mean; s2 += y[e] * y[e]; }
        const float rstd = rsqrtf(dpp_sum8(s2) * (1.0f / 64.0f) + GN_EPS);
        float o[8];
#pragma unroll
        for (int e = 0; e < 8; ++e) o[e] = (y[e] * rstd * lg8[e] + lb8[e] + bv[e]) * gg[e];
        *(u32x4*)(CAT + (size_t)m * D + 1024 + col) = pack8(o);
    }
}

__device__ __forceinline__ void p8_ln_router(Frame& F, const Args& a) {
    typedef short bf16x8_t __attribute__((ext_vector_type(8)));
    unsigned char* ws = F.ws;
    const bf16* PRE = (const bf16*)F.out; float* H1 = (float*)(ws + WS_H1); unsigned char* H1Q = (unsigned char*)(ws + WS_H1B);
    const float* g1 = a.in[I_LN1G]; const float* b1 = a.in[I_LN1B]; const float* rb = a.in[I_RB];
    const bf16* RWT = (const bf16*)(ws + WS_RWT);
    int* TOPE = (int*)(ws + WS_TOPE); float* TOPW = (float*)(ws + WS_TOPW); int* SLOT = (int*)(ws + WS_SLOT); int* HIST = (int*)(ws + WS_HIST);
    const int lane = F.lane, wave = F.wave, tid = F.tid;
    LAS float* part = (LAS float*)F.lds;
    LAS int* es = (LAS int*)(F.lds + 2 * 64 * 33 * 4);
    for (int ch = F.bid; ch < M / 64; ch += F.G) {
        {
            const int tb = 16 * (wave & 3), kh = wave >> 2, row = lane & 15, g = lane >> 4;
            const int m = ch * 64 + tb + row;
            const bf16* xp = PRE + (size_t)m * D + kh * 1024 + 8 * g;
            float s1 = 0.f, s2 = 0.f;
#pragma unroll
            for (int kb = 0; kb < 2; ++kb) {
                u32x4 xr[16];
#pragma unroll
                for (int ks = 0; ks < 16; ++ks) xr[ks] = *(const u32x4*)(xp + 32 * (16 * kb + ks));
#pragma unroll
                for (int ks = 0; ks < 16; ++ks) { float x[8]; unpack8(xr[ks], x);
#pragma unroll
                    for (int e = 0; e < 8; ++e) { s1 += x[e]; s2 += x[e] * x[e]; } } }
            { auto q = __builtin_amdgcn_permlane16_swap(__float_as_uint(s1), __float_as_uint(s1), false, false); s1 = __uint_as_float(q[0]) + __uint_as_float(q[1]);
              q = __builtin_amdgcn_permlane32_swap(__float_as_uint(s1), __float_as_uint(s1), false, false); s1 = __uint_as_float(q[0]) + __uint_as_float(q[1]);
              q = __builtin_amdgcn_permlane16_swap(__float_as_uint(s2), __float_as_uint(s2), false, false); s2 = __uint_as_float(q[0]) + __uint_as_float(q[1]);
              q = __builtin_amdgcn_permlane32_swap(__float_as_uint(s2), __float_as_uint(s2), false, false); s2 = __uint_as_float(q[0]) + __uint_as_float(q[1]); }
            LAS float* st = (LAS float*)(F.lds + 2 * 64 * 33 * 4 + 1024);
            if (g == 0) { st[(kh * 64 + tb + row) * 2] = s1; st[(kh * 64 + tb + row) * 2 + 1] = s2; }
            __syncthreads();
            const float t1 = st[(tb + row) * 2] + st[(64 + tb + row) * 2], t2 = st[(tb + row) * 2 + 1] + st[(64 + tb + row) * 2 + 1];
            const float mean = t1 * (1.0f / D), rstd = rsqrtf(fmaxf(t2 * (1.0f / D) - mean * mean, 0.f) + LN_EPS);
            f32x4 acc0 = (f32x4){0.f, 0.f, 0.f, 0.f}, acc1 = acc0;
            const bf16* w0 = RWT + (size_t)row * D + kh * 1024 + 8 * g;
            bf16* hp = (bf16*)H1 + (size_t)m * D + kh * 1024 + 8 * g; unsigned char* qp = H1Q + (size_t)m * D + kh * 1024 + 8 * g;
            const float* gp = g1 + kh * 1024 + 8 * g; const float* bp = b1 + kh * 1024 + 8 * g;
#pragma unroll 4
            for (int ks = 0; ks < 32; ++ks) {
                float x[8], g8[8], b8[8]; unpack8(*(const u32x4*)(xp + 32 * ks), x); ld8f(gp + 32 * ks, g8); ld8f(bp + 32 * ks, b8);
#pragma unroll
                for (int e = 0; e < 8; ++e) x[e] = (x[e] - mean) * rstd * g8[e] + b8[e];
                *(u32x4*)(hp + 32 * ks) = pack8(x);
                { u32x2 q; q.x = pk_fp8x4(x[0] * FP8_SA1, x[1] * FP8_SA1, x[2] * FP8_SA1, x[3] * FP8_SA1); q.y = pk_fp8x4(x[4] * FP8_SA1, x[5] * FP8_SA1, x[6] * FP8_SA1, x[7] * FP8_SA1); *(u32x2*)(qp + 32 * ks) = q; }
                float hi[8], lo[8];
#pragma unroll
                for (int e = 0; e < 8; ++e) { hi[e] = bf2f(f2bf(x[e])); lo[e] = x[e] - hi[e]; }
                const bf16x8_t ah = __builtin_bit_cast(bf16x8_t, pack8(hi)), al = __builtin_bit_cast(bf16x8_t, pack8(lo));
                const bf16x8_t b0h = *(const bf16x8_t*)(w0 + 32 * ks), b1h = *(const bf16x8_t*)(w0 + 16 * D + 32 * ks);
                const bf16x8_t b0l = *(const bf16x8_t*)(w0 + 32 * D + 32 * ks), b1l = *(const bf16x8_t*)(w0 + 48 * D + 32 * ks);
                acc0 = __builtin_amdgcn_mfma_f32_16x16x32_bf16(ah, b0h, acc0, 0, 0, 0); acc1 = __builtin_amdgcn_mfma_f32_16x16x32_bf16(ah, b1h, acc1, 0, 0, 0);
                acc0 = __builtin_amdgcn_mfma_f32_16x16x32_bf16(ah, b0l, acc0, 0, 0, 0); acc1 = __builtin_amdgcn_mfma_f32_16x16x32_bf16(ah, b1l, acc1, 0, 0, 0);
                acc0 = __builtin_amdgcn_mfma_f32_16x16x32_bf16(al, b0h, acc0, 0, 0, 0); acc1 = __builtin_amdgcn_mfma_f32_16x16x32_bf16(al, b1h, acc1, 0, 0, 0);
            }
#pragma unroll
            for (int q = 0; q < 4; ++q) { part[(kh * 64 + tb + 4 * g + q) * 33 + row] = acc0[q]; part[(kh * 64 + tb + 4 * g + q) * 33 + 16 + row] = acc1[q]; }
        }
        __syncthreads();
        for (int i = 0; i < 8; ++i) {
            const int tl_ = wave * 8 + i, m = ch * 64 + tl_;
            float lg = -INFINITY;
            if (lane < 32) lg = part[tl_ * 33 + lane] + part[(64 + tl_) * 33 + lane] + rb[lane];
            float tl[4]; int te[4];
#pragma unroll
            for (int k = 0; k < 4; ++k) { const float mx = wave_max(lg); const unsigned long long bm = __ballot(lg == mx); const int idx = __builtin_ctzll(bm); tl[k] = mx; te[k] = idx; if (lane == idx) lg = -INFINITY; }
            const float e1 = __expf(tl[1] - tl[0]), e2 = __expf(tl[2] - tl[0]), e3 = __expf(tl[3] - tl[0]); const float inv = 1.0f / (1.0f + e1 + e2 + e3);
            if (lane == 0) { *(int4*)(TOPE + (size_t)m * 4) = make_int4(te[0], te[1], te[2], te[3]); *(f32x4*)(TOPW + (size_t)m * 4) = (f32x4){inv, e1 * inv, e2 * inv, e3 * inv};
                es[tl_ * 4 + 0] = te[0]; es[tl_ * 4 + 1] = te[1]; es[tl_ * 4 + 2] = te[2]; es[tl_ * 4 + 3] = te[3]; }
        }
        __syncthreads();
        if (tid < 256) { const int e = es[tid]; int slot = 0; for (int q = 0; q < tid; ++q) slot += (es[q] == e) ? 1 : 0; SLOT[(size_t)ch * 256 + tid] = slot; }
        if (tid >= 256 && tid < 288) { const int e = tid - 256; int cnt = 0; for (int q = 0; q < 256; ++q) cnt += (es[q] == e) ? 1 : 0; HIST[ch * 32 + e] = cnt; }
        __syncthreads();
    }
}

__device__ __forceinline__ void p9_offsets(Frame& F) {
    unsigned char* ws = F.ws;
    const int* HIST = (const int*)(ws + WS_HIST); const int* TOPE = (const int*)(ws + WS_TOPE); const int* SLOT = (const int*)(ws + WS_SLOT);
    int* TOKROW = (int*)(ws + WS_TOKROW); int* ROWTOK = (int*)(ws + WS_ROWTOK); int* BLKE = (int*)(ws + WS_BLKE);
    LAS int* part = (LAS int*)F.lds;
    LAS int* tot = part + 512;
    LAS int* pre = tot + 32;
    LAS int* startp = pre + 32;
    LAS int* dsts = startp + 64;
    const int tid = F.tid, e = tid & 31, pg = tid >> 5;
    for (int ch = F.bid; ch < M / 64; ch += F.G) {
        __syncthreads();
        { int s = 0; for (int c = pg * 16; c < pg * 16 + 16; ++c) s += HIST[c * 32 + e]; part[pg * 32 + e] = s; }
        __syncthreads();
        if (tid < 32) { int s = 0; for (int q = 0; q < 16; ++q) s += part[q * 32 + tid]; tot[tid] = s; }
        __syncthreads();
        { int s = 0; for (int c = pg * 16; c < pg * 16 + 16; ++c) if (c < ch) s += HIST[c * 32 + e]; part[pg * 32 + e] = s; }
        __syncthreads();
        if (tid < 32) { int s = 0; for (int q = 0; q < 16; ++q) s += part[q * 32 + tid]; pre[tid] = s; }
        if (tid == 32) { int s = 0; for (int q = 0; q < 32; ++q) { startp[q] = s; s += (tot[q] + 255) / 256 * 256; } startp[32] = s; }
        __syncthreads();
        if (tid < 256) { const int m = ch * 64 + (tid >> 2); const int ee = TOPE[(size_t)m * 4 + (tid & 3)]; const int dest = startp[ee] + pre[ee] + SLOT[(size_t)ch * 256 + tid];
            ROWTOK[dest] = m; TOKROW[(size_t)m * 4 + (tid & 3)] = dest; dsts[tid] = dest; }
        __syncthreads();
        { const unsigned char* H1Q = (const unsigned char*)(ws + WS_H1B); unsigned char* XG = (unsigned char*)(ws + WS_XG);
#pragma unroll 1
          for (int tb = 0; tb < 8; tb += 8) {
              u32x4 v0[8], v1[8];
#pragma unroll
              for (int q = 0; q < 8; ++q) { const int m = ch * 64 + F.wave * 8 + tb + q; v0[q] = *(const u32x4*)(H1Q + (size_t)m * D + F.lane * 32); v1[q] = *(const u32x4*)(H1Q + (size_t)m * D + F.lane * 32 + 16); }
#pragma unroll
              for (int q = 0; q < 8; ++q)
#pragma unroll
                  for (int k = 0; k < 4; ++k) { const int dest = dsts[(F.wave * 8 + tb + q) * 4 + k];
                      *(u32x4*)(XG + (size_t)dest * D + F.lane * 32) = v0[q]; *(u32x4*)(XG + (size_t)dest * D + F.lane * 32 + 16) = v1[q]; }
          } }
        if (ch == 0) {
            const int nblk = startp[32] >> 8;
            if (tid < MAXBLK) { int be = -1; if (tid < nblk) { for (int q = 0; q < 32; ++q) if (startp[q] <= tid * 256 && tid * 256 < startp[q + 1]) be = q; } BLKE[tid] = be < 0 ? 0 : be; }
            if (tid == 0) BLKE[MAXBLK] = nblk;
        }
    }
    __syncthreads();
}

__device__ __forceinline__ void p12_combine_ln2(Frame& F, const Args& a) {
    unsigned char* ws = F.ws;
    const float* H1 = (const float*)(ws + WS_H1); const unsigned char* EO = (const unsigned char*)(ws + WS_EO); const int* TOKROW = (const int*)(ws + WS_TOKROW); const float* TOPW = (const float*)(ws + WS_TOPW);
    float* H2 = F.out; bf16* H2B = (bf16*)(ws + WS_H2B);
    const float* g2 = a.in[I_LN2G]; const float* b2 = a.in[I_LN2B];
    const int lane = F.lane, gw = F.bid * 8 + F.wave, NGW = F.G * 8;
    for (int m = gw; m < M; m += NGW) {
        const int4 rows = *(const int4*)(TOKROW + (size_t)m * 4); const f32x4 tw = *(const f32x4*)(TOPW + (size_t)m * 4);
        const int rr[4] = {rows.x, rows.y, rows.z, rows.w};
        float v[4][8]; float s = 0.f;
#pragma unroll
        for (int j = 0; j < 4; ++j) {
            const int c0 = 512 * j + 8 * lane;
            float h8[8]; unpack8(*(const u32x4*)((const bf16*)H1 + (size_t)m * D + c0), h8);
#pragma unroll
            for (int e = 0; e < 8; ++e) v[j][e] = ALPHA * h8[e];
#pragma unroll
            for (int k = 0; k < 4; ++k) { float e8[8]; unpack_fp8x8(*(const u32x2*)(EO + (size_t)rr[k] * D + c0), e8); const float wk = tw[k] * FP8_SO_INV;
#pragma unroll
                for (int e = 0; e < 8; ++e) v[j][e] += wk * e8[e]; }
#pragma unroll
            for (int e = 0; e < 8; ++e) s += v[j][e];
        }
        const float mean = wave_sum(s) * (1.0f / D); float s2 = 0.f;
#pragma unroll
        for (int j = 0; j < 4; ++j)
#pragma unroll
            for (int e = 0; e < 8; ++e) { v[j][e] -= mean; s2 += v[j][e] * v[j][e]; }
        const float rstd = rsqrtf(wave_sum(s2) * (1.0f / D) + LN_EPS);
#pragma unroll
        for (int j = 0; j < 4; ++j) { const int c0 = 512 * j + 8 * lane; float g8[8], b8[8], o[8]; ld8f(g2 + c0, g8); ld8f(b2 + c0, b8);
#pragma unroll
            for (int e = 0; e < 8; ++e) o[e] = v[j][e] * rstd * g8[e] + b8[e];
            { u32x2 q; q.x = pk_fp8x4(o[0] * FP8_SA1, o[1] * FP8_SA1, o[2] * FP8_SA1, o[3] * FP8_SA1); q.y = pk_fp8x4(o[4] * FP8_SA1, o[5] * FP8_SA1, o[6] * FP8_SA1, o[7] * FP8_SA1); *(u32x2*)((unsigned char*)(ws + WS_H2Q) + (size_t)m * D + c0) = q; }
            *(u32x4*)(H2B + (size_t)m * D + c0) = pack8(o); }
    }
}

__global__ void __launch_bounds__(512, 2) hymba_fwd(Args args) {
    extern __shared__ __attribute__((aligned(16))) unsigned char lds_raw[];
    Frame F;
    F.lds = (LAS unsigned char*)lds_raw; F.ws = args.ws; F.out = args.out;
    F.tid = threadIdx.x; F.lane = F.tid & 63; F.wave = __builtin_amdgcn_readfirstlane(F.tid >> 6); F.bid = blockIdx.x; F.G = gridDim.x;
    unsigned char* ws = args.ws;
    volatile LAS unsigned* MISC = (volatile LAS unsigned*)(F.lds + LDS_MISC);
    if (F.tid < 32) MISC[F.tid] = 0u;
    __syncthreads();
    XcdBarrier bar; bar.bar = (unsigned*)(ws + WS_CTL) + CW_BAR; bar.x = 0; bar.st = nullptr;
    const int lo = args.ph_lo, hi = args.ph_hi;
    const bool one_launch = (hi - lo) > 1;
    if (one_launch) bar = xcd_barrier_post((unsigned*)(ws + WS_CTL) + CW_BAR, MISC + 8);
#ifdef ONLYPH
#define IN(k) ((k) == ONLYPH && lo <= (k) && (k) < hi)
#else
#define IN(k) (lo <= (k) && (k) < hi)
#endif
#ifndef PROF_IDX
#define PROF_IDX -1
#endif
#ifndef PROF_SCALE
#define PROF_SCALE 4
#endif
    unsigned long long* prof = (unsigned long long*)(ws + WS_CTL + 512 * 1024);
#define STAMP(i) do { if (PROF_IDX >= 0 && F.bid == 0 && F.tid == 0) { __builtin_amdgcn_s_waitcnt(0); prof[(i)] = __builtin_amdgcn_s_memrealtime(); } } while (0)
#ifndef PROF_BLK
#define PROF_BLK 0
#endif
#ifndef PROF_A
#define PROF_A PROF_IDX
#endif
#ifndef PROF_B
#define PROF_B (PROF_IDX + 1)
#endif
#define ARRIVE(k) do { if (PROF_IDX >= 0 && F.bid == PROF_BLK && F.tid == 0) { __builtin_amdgcn_s_waitcnt(0); prof[32 + (k)] = __builtin_amdgcn_s_memrealtime(); } } while (0)
#define SEAM(k) do { if (IN(k) && IN((k) + 1)) { ARRIVE(k); xcd_barrier(bar); STAMP((k) + 1); } } while (0)
    STAMP(0);
#ifndef PROBE_MASK
#define PROBE_MASK 0ull
#endif
#ifndef PROBE_MODE
#define PROBE_MODE 3
#endif
#define REPS(k) for (int rp_ = 0; rp_ < ((((PROBE_MASK) >> (k)) & 1ull) ? 2 : 1); ++rp_)

    if (IN(0)) REPS(0) { p0_prologue(F, args); } SEAM(0);
    if (IN(1)) REPS(1) { GemmDesc g{(const bf16*)(ws + WS_XB), D, nullptr, (const bf16*)(ws + WS_WIN), D, M, NZ, D, nullptr, 0, nullptr, 127, 127, 0, 0}; EpiZ E{(bf16*)(ws + WS_Z), (bf16*)(ws + WS_ACK)}; gemm_run<false>(F, g, E); } SEAM(1);
    if (IN(3)) {
        const bool split = F.G >= 128;
        if (!split || F.bid < 64) { const int q0 = split ? (F.bid >> 4) : 0, q1 = split ? q0 + 1 : 4;
            for (int q = q0; q < q1; ++q) { const int kv = q >> 1, kh = q & 1;
                GemmDesc gc{(const bf16*)(ws + (kv ? WS_ACV : WS_ACK)) + kh * 1024, 1024, nullptr, (const bf16*)(ws + (kv ? WS_CW1V : WS_CW1K)) + kh * 1024, D, 4096, 256, D, nullptr, 0, nullptr, 127, 127, 1024, 0};
                EpiCmpPart Ec{(float*)(ws + (kv ? WS_HCMPV : WS_HCMPK)) + (size_t)kh * 4096 * 64};
                gemm_run_part(F, gc, Ec, split ? 16 : F.G, split ? (F.bid & 15) : F.bid); } }
        if (F.bid >= 64 && F.bid < 80) pe_bias_part(F, args);
        p3_rwkv_fused(F, args);
    } SEAM(3);
    #ifndef NAIVE_ATTN
#define NAIVE_ATTN 0
#endif
    if (IN(5)) { REPS(50) p5_scan_conv(F, args, rp_ == 0 ? 3 : PROBE_MODE);
#if PROF_IDX == 15
        if (one_launch) { xcd_barrier(bar); STAMP(16); if (F.bid == 0 && F.tid == 0) { __builtin_amdgcn_s_waitcnt(0); prof[15] = prof[5]; } }
#endif
        if (F.tid == 0) { const unsigned* p4c = (const unsigned*)(ws + WS_CTL) + CW_P4; while (__hip_atomic_load(p4c, __ATOMIC_RELAXED, __HIP_MEMORY_SCOPE_AGENT) < 4u * (unsigned)F.G) __builtin_amdgcn_s_sleep(2);
            __builtin_amdgcn_fence(__ATOMIC_ACQUIRE, "agent"); }
        __syncthreads();
#if NAIVE_ATTN
        p5_attn_naive(F);
#else
        REPS(51) nsa::attn_phase(F, rp_);
#endif
    } SEAM(5);
    if (IN(6)) REPS(6) { p6_rwkv_out(F, args); } SEAM(6);
    if (IN(7)) REPS(7) { GemmDesc g{(const bf16*)(ws + WS_CAT), D, nullptr, (const bf16*)(ws + WS_WOUT), D, M, D, D, nullptr, 0, nullptr, 127, 127, 0, 0}; EpiPre1 E{F.out, (const bf16*)(ws + WS_XB)}; gemm_run<false>(F, g, E); } SEAM(7);
    if (IN(8)) REPS(8) { p8_ln_router(F, args); } SEAM(8);
    if (IN(9)) REPS(9) { p9_offsets(F); } SEAM(9);
    if (IN(10)) REPS(10) { GemmDesc g{(const bf16*)(ws + WS_XG), D, nullptr, (const bf16*)(ws + WS_WGU), D, MAXROWS, 4096, D, (const int*)(ws + WS_BLKE), (size_t)4096 * D, (const int*)(ws + WS_BLKE) + MAXBLK, FP8_EA1, FP8_EW, 0, 0};
        EpiSwiglu E{(unsigned char*)(ws + WS_HACT), args.in[I_EBG], args.in[I_EBU]}; gemm_run<true, EpiSwiglu, true>(F, g, E); } SEAM(10);
    if (IN(11)) REPS(11) {
        { GemmDesc g{(const bf16*)(ws + WS_HACT), D, nullptr, (const bf16*)(ws + WS_WDN), D, MAXROWS, D, D, (const int*)(ws + WS_BLKE), (size_t)D * D, (const int*)(ws + WS_BLKE) + MAXBLK, FP8_EA2, FP8_EW, 0, 0};
          EpiDown E{(unsigned char*)(ws + WS_EO), args.in[I_EBD]}; gemm_run<false, EpiDown, true>(F, g, E); }
        { GemmDesc g{(const bf16*)(ws + WS_PB), 256, nullptr, (const bf16*)(ws + WS_WPL), 256, M, D, 256, nullptr, 0, nullptr, 127, 127, 0, 0}; EpiBf16 E{(bf16*)(ws + WS_PL), D}; gemm_run<false>(F, g, E); }
    } SEAM(11);
    if (IN(12)) REPS(12) { p12_combine_ln2(F, args); } SEAM(12);
    if (IN(13)) { GemmDesc g{(const bf16*)(ws + WS_H2Q), D, nullptr, (const bf16*)(ws + WS_WPG), D, M, D, D, nullptr, 0, nullptr, FP8_EA1, FP8_EW, 0, 0}; EpiFinal E{F.out, (const bf16*)(ws + WS_PL), (const bf16*)(ws + WS_H2B)}; gemm_run<false, EpiFinal, true>(F, g, E); }
    if (PROF_IDX >= 0 && one_launch) {
        xcd_barrier(bar); STAMP(14);
        if (F.bid == 0 && F.tid == 0) { asm volatile("s_waitcnt vmcnt(0)" ::: "memory");
#ifdef PROF_GEMM
            const unsigned long long pb_ = __hip_atomic_load(pg8::g_prof + (PROF_B), __ATOMIC_RELAXED, __HIP_MEMORY_SCOPE_AGENT), pa_ = (PROF_A) >= 40 ? __hip_atomic_load(pg8::g_prof + (PROF_A), __ATOMIC_RELAXED, __HIP_MEMORY_SCOPE_AGENT) : __hip_atomic_load(prof + (PROF_A), __ATOMIC_RELAXED, __HIP_MEMORY_SCOPE_AGENT);
            const unsigned long long d = (pb_ - pa_) * PROF_SCALE;
#else
            const unsigned long long d = (__hip_atomic_load(prof + (PROF_B), __ATOMIC_RELAXED, __HIP_MEMORY_SCOPE_AGENT) - __hip_atomic_load(prof + (PROF_A), __ATOMIC_RELAXED, __HIP_MEMORY_SCOPE_AGENT)) * PROF_SCALE;
#endif
            const unsigned long long t0 = __builtin_amdgcn_s_memrealtime(); while (__builtin_amdgcn_s_memrealtime() - t0 < d) __builtin_amdgcn_s_sleep(8); }
    }
#undef IN
#undef SEAM
}

extern "C" void kernel_launch(void* const* d_in, const int* in_sizes, int n_in, void* d_out, int out_size, void* d_ws, size_t ws_size, hipStream_t stream) {
    static int grid = 0;
    if (grid == 0) {
        if (n_in != 35 || out_size != M * D || ws_size < WS_END) { fprintf(stderr, "kernel_launch: unexpected problem (n_in %d, out %d, ws %zu < %zu)\n", n_in, out_size, ws_size, (size_t)WS_END); grid = -1; return; }
        int dev = 0, cus = 0, per_cu = 0;
        if (hipGetDevice(&dev) != hipSuccess || hipDeviceGetAttribute(&cus, hipDeviceAttributeMultiprocessorCount, dev) != hipSuccess) { grid = -1; return; }
        if (hipFuncSetAttribute((const void*)hymba_fwd, hipFuncAttributeMaxDynamicSharedMemorySize, LDS_BYTES) != hipSuccess) { fprintf(stderr, "kernel_launch: hipFuncSetAttribute failed\n"); grid = -1; return; }
        if (hipOccupancyMaxActiveBlocksPerMultiprocessor(&per_cu, (const void*)hymba_fwd, 512, LDS_BYTES) != hipSuccess || per_cu < 1) fprintf(stderr, "kernel_launch: occupancy query reports %d\n", per_cu);
        (void)hipGetLastError();
        grid = cus;
    }
    if (grid < 0) return;
    if (hipMemsetAsync((char*)d_ws + WS_CTL, 0, CTL_ZERO_BYTES, stream) != hipSuccess) return;
    Args a{};
    for (int i = 0; i < 35; ++i) a.in[i] = (const float*)d_in[i];
    a.out = (float*)d_out; a.ws = (unsigned char*)d_ws;
#if MK_LAUNCH_PER_PHASE
    for (int ph = 0; ph < NPHASE; ++ph) { a.ph_lo = ph; a.ph_hi = ph + 1; a.li = ph; hipLaunchKernelGGL(hymba_fwd, dim3(grid), dim3(512), LDS_BYTES, stream, a); }
#else
    a.ph_lo = 0; a.ph_hi = NPHASE; a.li = 0;
    hipLaunchKernelGGL(hymba_fwd, dim3(grid), dim3(512), LDS_BYTES, stream, a);
#endif
}
```
